# Optimizing an MI355X kernel written in HIP

```python
import math
import jax, jax.numpy as jnp
from jax import lax
import numpy as np

D_MODEL = 1024
BATCH = 4
SEQ = 8192
DEPTH = 2

CHUNK = 64
N_MIXERS = 2
N_ATTN_LAYERS = (DEPTH + 1) // 2
N_CONV_LAYERS = DEPTH // 2
N_HEADS = 8
HEAD_DIM = 64
V_DIM = 2 * HEAD_DIM
ROPE_THETA = 10000.0
Q_BLOCK = 128
CONV_WIDTH = 31
D_FF = -(-(8 * D_MODEL) // (3 * 256)) * 256
LN_EPS = 1e-5
DEEPNORM_ALPHA = (2.0 * DEPTH) ** 0.25
DEEPNORM_BETA = (8.0 * DEPTH) ** -0.25
MASK_VALUE = -1e30

kernel_name = "hybrid_diffattn_conformer_conv_deepnorm"


def layer_norm(x, g, b):
    xf = x.astype(jnp.float32)
    mu = jnp.mean(xf, axis=-1, keepdims=True)
    var = jnp.mean(jnp.square(xf - mu), axis=-1, keepdims=True)
    y = (xf - mu) * lax.rsqrt(var + LN_EPS)
    return (y * g.astype(jnp.float32) + b.astype(jnp.float32)).astype(x.dtype)


def rms_norm(x, g):
    xf = x.astype(jnp.float32)
    y = xf * lax.rsqrt(jnp.mean(jnp.square(xf), axis=-1, keepdims=True) + LN_EPS)
    return (y * g.astype(jnp.float32)).astype(x.dtype)


def rope_tables(seq_len, dim):
    pos = jnp.arange(seq_len, dtype=jnp.float32)
    inv_freq = ROPE_THETA ** (-jnp.arange(0, dim, 2, dtype=jnp.float32) / dim)
    ang = pos[:, None] * inv_freq[None, :]
    return jnp.cos(ang), jnp.sin(ang)


def apply_rope(x, cos, sin):
    half = x.shape[-1] // 2
    x1, x2 = x[..., :half], x[..., half:]
    c = cos[None, :, None, None, :].astype(x.dtype)
    s = sin[None, :, None, None, :].astype(x.dtype)
    return jnp.concatenate([x1 * c - x2 * s, x2 * c + x1 * s], axis=-1)


def diff_attention(x, w_qkv, w_o, lq1, lk1, lq2, lk2, subln_g, lambda_init):
    B, S, D = x.shape
    n_blocks = S // Q_BLOCK
    qkv = x @ w_qkv
    q, k, v = jnp.split(qkv, 3, axis=-1)
    q = q.reshape(B, S, N_HEADS, 2, HEAD_DIM)
    k = k.reshape(B, S, N_HEADS, 2, HEAD_DIM)
    v = v.reshape(B, S, N_HEADS, V_DIM).transpose(0, 2, 1, 3)
    cos, sin = rope_tables(S, HEAD_DIM)
    q = apply_rope(q, cos, sin) * (HEAD_DIM ** -0.5)
    k = apply_rope(k, cos, sin)
    q = q.transpose(0, 2, 3, 1, 4)
    k = k.transpose(0, 2, 3, 1, 4)
    q_blocks = jnp.moveaxis(q.reshape(B, N_HEADS, 2, n_blocks, Q_BLOCK, HEAD_DIM), 3, 0)

    lam = (jnp.exp(jnp.sum(lq1.astype(jnp.float32) * lk1.astype(jnp.float32)))
           - jnp.exp(jnp.sum(lq2.astype(jnp.float32) * lk2.astype(jnp.float32)))
           + lambda_init)
    key_chunk = jnp.arange(S) // CHUNK

    def block_fn(args):
        qb, blk = args
        s = jnp.einsum('bhmqd,bhmkd->bhmqk', qb, k).astype(jnp.float32)
        q_chunk = (blk * Q_BLOCK + jnp.arange(Q_BLOCK)) // CHUNK
        mask = key_chunk[None, :] <= q_chunk[:, None]
        s = jnp.where(mask[None, None, None], s, MASK_VALUE)
        p = jax.nn.softmax(s, axis=-1)
        attn = p[:, :, 0] - lam * p[:, :, 1]
        return jnp.einsum('bhqk,bhkv->bhqv', attn.astype(v.dtype), v)

    out = lax.map(block_fn, (q_blocks, jnp.arange(n_blocks)))
    out = out.transpose(1, 0, 3, 2, 4).reshape(B, S, N_HEADS, V_DIM)
    out = rms_norm(out, subln_g) * (1.0 - lambda_init)
    return out.reshape(B, S, N_HEADS * V_DIM) @ w_o


def conformer_conv(x, w_pw1, b_pw1, w_dw, b_dw, ln_g, ln_b, w_pw2, b_pw2):
    D = x.shape[-1]
    h = x @ w_pw1 + b_pw1
    a, gate = jnp.split(h, 2, axis=-1)
    h = a * jax.nn.sigmoid(gate)
    h = jnp.pad(h, ((0, 0), (CONV_WIDTH - 1, 0), (0, 0)))
    h = lax.conv_general_dilated(
        h, w_dw[:, None, :].astype(h.dtype), window_strides=(1,), padding='VALID',
        dimension_numbers=('NWC', 'WIO', 'NWC'), feature_group_count=D) + b_dw
    h = layer_norm(h, ln_g, ln_b)
    h = jax.nn.silu(h)
    return h @ w_pw2 + b_pw2


def swiglu_ffn(x, w_gate, w_up, w_down):
    return (jax.nn.silu(x @ w_gate) * (x @ w_up)) @ w_down


def setup_inputs(seed: int = 0) -> dict:
    key = jax.random.key(seed)
    ks = jax.random.split(key, 24)
    D = D_MODEL
    nrm = lambda k, shape, scale: jax.random.normal(k, shape, jnp.float32) * scale
    return {
        "x": nrm(ks[0], (BATCH, SEQ, D), 1.0),
        "attn_w_qkv": nrm(ks[1], (N_ATTN_LAYERS, D, 3 * D), D ** -0.5),
        "attn_w_o": nrm(ks[2], (N_ATTN_LAYERS, N_HEADS * V_DIM, D), DEEPNORM_BETA * D ** -0.5),
        "attn_lambda_q1": nrm(ks[3], (N_ATTN_LAYERS, HEAD_DIM), 0.1),
        "attn_lambda_k1": nrm(ks[4], (N_ATTN_LAYERS, HEAD_DIM), 0.1),
        "attn_lambda_q2": nrm(ks[5], (N_ATTN_LAYERS, HEAD_DIM), 0.1),
        "attn_lambda_k2": nrm(ks[6], (N_ATTN_LAYERS, HEAD_DIM), 0.1),
        "attn_subln_g": 1.0 + nrm(ks[7], (N_ATTN_LAYERS, V_DIM), 0.02),
        "conv_w_pw1": nrm(ks[8], (N_CONV_LAYERS, D, 2 * D), D ** -0.5),
        "conv_b_pw1": nrm(ks[9], (N_CONV_LAYERS, 2 * D), 0.02),
        "conv_w_dw": nrm(ks[10], (N_CONV_LAYERS, CONV_WIDTH, D), CONV_WIDTH ** -0.5),
        "conv_b_dw": nrm(ks[11], (N_CONV_LAYERS, D), 0.02),
        "conv_ln_g": 1.0 + nrm(ks[12], (N_CONV_LAYERS, D), 0.02),
        "conv_ln_b": nrm(ks[13], (N_CONV_LAYERS, D), 0.02),
        "conv_w_pw2": nrm(ks[14], (N_CONV_LAYERS, D, D), DEEPNORM_BETA * D ** -0.5),
        "conv_b_pw2": nrm(ks[15], (N_CONV_LAYERS, D), 0.02),
        "ffn_w_gate": nrm(ks[16], (DEPTH, D, D_FF), D ** -0.5),
        "ffn_w_up": nrm(ks[17], (DEPTH, D, D_FF), D ** -0.5),
        "ffn_w_down": nrm(ks[18], (DEPTH, D_FF, D), DEEPNORM_BETA * D_FF ** -0.5),
        "ln_g": 1.0 + nrm(ks[19], (DEPTH, 2, D), 0.02),
        "ln_b": nrm(ks[20], (DEPTH, 2, D), 0.02),
    }


def reference(x, attn_w_qkv, attn_w_o, attn_lambda_q1, attn_lambda_k1, attn_lambda_q2,
              attn_lambda_k2, attn_subln_g, conv_w_pw1, conv_b_pw1, conv_w_dw, conv_b_dw,
              conv_ln_g, conv_ln_b, conv_w_pw2, conv_b_pw2, ffn_w_gate, ffn_w_up,
              ffn_w_down, ln_g, ln_b):
    for i in range(DEPTH):
        j = i // N_MIXERS
        if i % N_MIXERS == 0:
            lambda_init = 0.8 - 0.6 * math.exp(-0.3 * i)
            y = diff_attention(x, attn_w_qkv[j], attn_w_o[j], attn_lambda_q1[j],
                               attn_lambda_k1[j], attn_lambda_q2[j], attn_lambda_k2[j],
                               attn_subln_g[j], lambda_init)
        else:
            y = conformer_conv(x, conv_w_pw1[j], conv_b_pw1[j], conv_w_dw[j], conv_b_dw[j],
                               conv_ln_g[j], conv_ln_b[j], conv_w_pw2[j], conv_b_pw2[j])
        x = layer_norm(DEEPNORM_ALPHA * x + y, ln_g[i, 0], ln_b[i, 0])
        f = swiglu_ffn(x, ffn_w_gate[i], ffn_w_up[i], ffn_w_down[i])
        x = layer_norm(DEEPNORM_ALPHA * x + f, ln_g[i, 1], ln_b[i, 1])
    return x
```

```cpp
#include <hip/hip_runtime.h>
#include <hip/hip_cooperative_groups.h>
#include <cstdio>
#include <cstdint>
namespace cg = cooperative_groups;
namespace pg8 {
#define PG8_LAS __attribute__((address_space(3)))
typedef unsigned short bf16_t;
typedef short bf16x8 __attribute__((ext_vector_type(8)));
typedef float f32x4 __attribute__((ext_vector_type(4)));
typedef unsigned u32x4 __attribute__((ext_vector_type(4)));
constexpr int BM = 256, BK = 64, HALF = 128, HTB = HALF * BK * 2  , STAGE_BYTES = 8 * HTB, NXCD = 8, WGM = 8;

__host__ __device__ __forceinline__ int lds_byte(int r, int c) { const int st = (r >> 4) * 2 + (c >> 5), rr = r & 15, cc = c & 31, ob = rr * 64 + cc * 2; return st * 1024 + (ob ^ (((ob >> 9) & 1) << 5)); }
__host__ __device__ __forceinline__ void stage_rc(int b, int& R, int& C) { const int st = b / 1024, sb = b % 1024, swz = sb ^ (((sb >> 9) & 1) << 5); R = (st >> 1) * 16 + swz / 64; C = (st & 1) * 32 + (swz % 64) / 2; }
__host__ __device__ __forceinline__ int perm32(int rho) { const int n = rho >> 4, i = rho & 15; return 8 * (i >> 2) + 4 * n + (i & 3); }

struct Unit { int pm, pn; };
struct Gemm { const bf16_t* A; const bf16_t* Bt; int M, N, K; };

struct StaticOrder {
    int nM, nN, nwg, G, c;
    __host__ __device__ void init(int M, int N, int G_, int c_) { nM = M / BM; nN = N / BM; nwg = nM * nN; G = G_; c = c_; }
    __host__ __device__ bool next(int i, Unit& u) const {
        const long L = (long)i * G + c; if (L >= nwg) return false;
        int wgid = (int)L; { const int q = nwg / NXCD, r = nwg % NXCD, xcd = wgid % NXCD, off = wgid / NXCD; wgid = (xcd < r ? xcd * (q + 1) : r * (q + 1) + (xcd - r) * q) + off; }
        const int nig = WGM * nN, gid = wgid / nig, fm = gid * WGM, gsz = (nM - fm) < WGM ? (nM - fm) : WGM;
        u.pm = fm + ((wgid % nig) % gsz); u.pn = (wgid % nig) / gsz; return true;
    }
    __device__ __forceinline__ void a_ready(const Unit&) const {}
    __device__ __forceinline__ void done(const Unit&) const {}
};

__device__ __forceinline__ unsigned cvt_pk_bf16(float lo, float hi) { unsigned r; asm volatile("v_cvt_pk_bf16_f32 %0, %1, %2" : "=v"(r) : "v"(lo), "v"(hi)); return r; }
__device__ __forceinline__ void glds_s(const void* sbase, unsigned voff, unsigned ldsdst) {
    unsigned keep;
    asm volatile("s_mov_b32 %0, m0\n\ts_mov_b32 m0, %3\n\ts_nop 0\n\tglobal_load_lds_dwordx4 %1, %2\n\ts_mov_b32 m0, %0" : "=&s"(keep) : "v"(voff), "s"(sbase), "s"(ldsdst) : "memory");
}
typedef float f32x2 __attribute__((ext_vector_type(2)));
__device__ __forceinline__ f32x2 gelu_pk(f32x2 v) {
    const f32x2 av = __builtin_elementwise_abs(v), d = av * 0.2316418882f + 1.0f;
    f32x2 t; t.x = __builtin_amdgcn_rcpf(d.x); t.y = __builtin_amdgcn_rcpf(d.y);
    f32x2 q = t * 0.5307027145f + (-0.7265760135f); q = q * t + 0.7107068705f; q = q * t + (-0.142248368f); q = q * t + 0.127414796f; q = q * t;
    const f32x2 s = (v * v) * (-0.72134752044f);
    f32x2 e; e.x = __builtin_amdgcn_exp2f(s.x); e.y = __builtin_amdgcn_exp2f(s.y);
    const f32x2 m = v * (q * e), r = v - m;
    f32x2 o; o.x = v.x < 0.f ? m.x : r.x; o.y = v.y < 0.f ? m.y : r.y; return o;
}

template <int ACT  > struct EpiBf16 {
    static constexpr bool PERM = true, AFTER_DRAIN = false; static_assert(ACT == 0 || ACT == 1, "EpiBf16: ACT is 0 (none) or 1 (gelu_pk)");
    bf16_t* O; int ldc; const float* bias; int split_cols; size_t split_stride; float scale0;
    __device__ __forceinline__ void operator()(const f32x4 (&acc)[2][2][4][2], const Unit& u, int wr, int wc, int fr_in, int fq_in) const {
        int fr = fr_in, fq = fq_in; asm volatile("" : "+v"(fr), "+v"(fq));
        const int row0 = u.pm * BM + wr * 64 + fr; int colt = u.pn * BM; bf16_t* base = O;
        float sc = 1.f; if (split_cols) { const int t = colt / split_cols; base += (size_t)t * split_stride; colt -= t * split_cols; if (t == 0) sc = scale0; }
        const int col0 = colt + wc * 32 + 8 * fq, bcol0 = u.pn * BM + wc * 32 + 8 * fq;
        f32x4 bv[2][2];
#pragma unroll
        for (int bj = 0; bj < 2; ++bj)
#pragma unroll
            for (int n = 0; n < 2; ++n) bv[bj][n] = bias ? *(const f32x4*)(bias + bcol0 + bj * HALF + 4 * n) : (f32x4){0.f, 0.f, 0.f, 0.f};
#pragma unroll
        for (int ai = 0; ai < 2; ++ai)
#pragma unroll
            for (int m = 0; m < 4; ++m) { bf16_t* rowp = base + (size_t)(row0 + ai * HALF + m * 16) * ldc + col0;
#pragma unroll
                for (int bj = 0; bj < 2; ++bj) { f32x4 v0 = acc[ai][bj][m][0] + bv[bj][0], v1 = acc[ai][bj][m][1] + bv[bj][1];
                    if (ACT == 1) { f32x2 a = gelu_pk((f32x2){v0[0], v0[1]}), b = gelu_pk((f32x2){v0[2], v0[3]}), c = gelu_pk((f32x2){v1[0], v1[1]}), d = gelu_pk((f32x2){v1[2], v1[3]});
                        v0 = (f32x4){a.x, a.y, b.x, b.y}; v1 = (f32x4){c.x, c.y, d.x, d.y}; }
                    v0 = v0 * sc; v1 = v1 * sc; u32x4 w; w.x = cvt_pk_bf16(v0[0], v0[1]); w.y = cvt_pk_bf16(v0[2], v0[3]); w.z = cvt_pk_bf16(v1[0], v1[1]); w.w = cvt_pk_bf16(v1[2], v1[3]);
                    *(u32x4*)(rowp + bj * HALF) = w; } }
    }
};
__device__ __forceinline__ u32x4 pack8(const f32x4 v0, const f32x4 v1) { u32x4 w; w.x = cvt_pk_bf16(v0[0], v0[1]); w.y = cvt_pk_bf16(v0[2], v0[3]); w.z = cvt_pk_bf16(v1[0], v1[1]); w.w = cvt_pk_bf16(v1[2], v1[3]); return w; }
__device__ __forceinline__ f32x4 sigm4(const f32x4 g) {
    f32x4 r;
#pragma unroll
    for (int i = 0; i < 4; ++i) r[i] = __builtin_amdgcn_rcpf(1.0f + __builtin_amdgcn_exp2f(g[i] * -1.4426950408889634f));
    return r;
}
struct EpiQKV {
    static constexpr bool PERM = true, AFTER_DRAIN = false;
    bf16_t* Q; bf16_t* Kb; bf16_t* V; const float* tab; float qscale;
    __device__ __forceinline__ void operator()(const f32x4 (&acc)[2][2][4][2], const Unit& u, int wr, int wc, int fr_in, int fq_in) const {
        int fr = fr_in, fq = fq_in; asm volatile("" : "+v"(fr), "+v"(fq));
        const int row0 = u.pm * BM + wr * 64 + fr;
        if (u.pn >= 8) {
            const int col0 = (u.pn - 8) * BM + wc * 32 + 8 * fq;
#pragma unroll
            for (int ai = 0; ai < 2; ++ai)
#pragma unroll
                for (int m = 0; m < 4; ++m) { bf16_t* rowp = V + (size_t)(row0 + ai * HALF + m * 16) * 1024 + col0;
#pragma unroll
                    for (int bj = 0; bj < 2; ++bj) *(u32x4*)(rowp + bj * HALF) = pack8(acc[ai][bj][m][0], acc[ai][bj][m][1]); }
        } else {
            bf16_t* dst = (u.pn >> 2) ? Kb : Q; const float sc = (u.pn >> 2) ? 1.0f : qscale;
            const int colbase = 64 * (4 * (u.pn & 3) + wc) + 8 * fq;
#pragma unroll
            for (int ai = 0; ai < 2; ++ai)
#pragma unroll
                for (int m = 0; m < 4; ++m) { const int row = row0 + ai * HALF + m * 16; const float* tp = tab + (size_t)(row & 8191) * 64 + 8 * fq;
                    const f32x4 c0 = *(const f32x4*)(tp), c1 = *(const f32x4*)(tp + 4), s0 = *(const f32x4*)(tp + 32), s1 = *(const f32x4*)(tp + 36);
                    const f32x4 x10 = acc[ai][0][m][0], x11 = acc[ai][0][m][1], x20 = acc[ai][1][m][0], x21 = acc[ai][1][m][1];
                    const f32x4 o10 = (x10 * c0 - x20 * s0) * sc, o11 = (x11 * c1 - x21 * s1) * sc, o20 = (x20 * c0 + x10 * s0) * sc, o21 = (x21 * c1 + x11 * s1) * sc;
                    bf16_t* rowp = dst + (size_t)row * 1024 + colbase;
                    *(u32x4*)(rowp) = pack8(o10, o11); *(u32x4*)(rowp + 32) = pack8(o20, o21); asm volatile("" ::: "memory"); }
        }
    }
};
struct EpiSwiGLU {
    static constexpr bool PERM = true, AFTER_DRAIN = false;
    bf16_t* H; int ldc;
    __device__ __forceinline__ void operator()(const f32x4 (&acc)[2][2][4][2], const Unit& u, int wr, int wc, int fr_in, int fq_in) const {
        int fr = fr_in, fq = fq_in; asm volatile("" : "+v"(fr), "+v"(fq));
        const int row0 = u.pm * BM + wr * 64 + fr, col0 = u.pn * HALF + wc * 32 + 8 * fq;
#pragma unroll
        for (int ai = 0; ai < 2; ++ai)
#pragma unroll
            for (int m = 0; m < 4; ++m) { bf16_t* rowp = H + (size_t)(row0 + ai * HALF + m * 16) * ldc + col0;
                const f32x4 g0 = acc[ai][0][m][0], g1 = acc[ai][0][m][1];
                const f32x4 h0 = g0 * sigm4(g0) * acc[ai][1][m][0], h1 = g1 * sigm4(g1) * acc[ai][1][m][1];
                *(u32x4*)(rowp) = pack8(h0, h1); __builtin_amdgcn_sched_barrier(0); }
    }
};
struct EpiGLU {
    static constexpr bool PERM = true, AFTER_DRAIN = false;
    bf16_t* G; const float* bias;
    __device__ __forceinline__ void operator()(const f32x4 (&acc)[2][2][4][2], const Unit& u, int wr, int wc, int fr_in, int fq_in) const {
        int fr = fr_in, fq = fq_in; asm volatile("" : "+v"(fr), "+v"(fq));
        const int row0 = u.pm * BM + wr * 64 + fr, col0 = u.pn * HALF + wc * 32 + 8 * fq;
#pragma unroll
        for (int ai = 0; ai < 2; ++ai)
#pragma unroll
            for (int m = 0; m < 4; ++m) { bf16_t* rowp = G + (size_t)(row0 + ai * HALF + m * 16) * 1024 + col0;
                const f32x4 ba0 = *(const f32x4*)(bias + col0), ba1 = *(const f32x4*)(bias + col0 + 4), bg0 = *(const f32x4*)(bias + 1024 + col0), bg1 = *(const f32x4*)(bias + 1024 + col0 + 4);
                const f32x4 h0 = (acc[ai][0][m][0] + ba0) * sigm4(acc[ai][1][m][0] + bg0), h1 = (acc[ai][0][m][1] + ba1) * sigm4(acc[ai][1][m][1] + bg1);
                *(u32x4*)(rowp) = pack8(h0, h1); asm volatile("" ::: "memory"); __builtin_amdgcn_sched_barrier(0); }
    }
};
template <int MODE> struct EpiResid {
    static constexpr bool PERM = false, AFTER_DRAIN = false;
    const float* xin; float* out; const float* st; const float* g; const float* b; const float* bias; float alpha;
    __device__ __forceinline__ void operator()(const f32x4 (&acc)[2][2][4][2], const Unit& u, int wr, int wc, int fr_in, int fq_in) const {
        int fr = fr_in, fq = fq_in; asm volatile("" : "+v"(fr), "+v"(fq));
        const int col0 = u.pn * BM + wc * 32 + 4 * fq;
#pragma unroll
        for (int bj = 0; bj < 2; ++bj)
#pragma unroll
            for (int n = 0; n < 2; ++n) { const int c = col0 + bj * HALF + n * 16;
                const f32x4 cv = bias ? *(const f32x4*)(bias + c) : (f32x4){0.f, 0.f, 0.f, 0.f};
                f32x4 gv = cv, bv = cv; if (MODE == 1) { gv = *(const f32x4*)(g + c); bv = *(const f32x4*)(b + c); }
#pragma unroll
                for (int ai = 0; ai < 2; ++ai)
#pragma unroll
                    for (int m = 0; m < 4; ++m) { const int row = u.pm * BM + ai * HALF + wr * 64 + m * 16 + fr; const size_t off = (size_t)row * 1024 + c;
                        f32x4 xv = *(const f32x4*)(xin + off);
                        if (MODE == 1) { const float mean = st[2 * row], rstd = st[2 * row + 1]; xv = (xv - mean) * rstd * gv + bv; }
                        *(f32x4*)(out + off) = xv * alpha + acc[ai][bj][m][n] + cv;
                        if (m & 1) asm volatile("" ::: "memory"); }
            }
    }
};

template <class Epi, class Sched, bool ALIGN_EPI = false, bool SP2 = false>
__device__ __forceinline__ void gemm_phase(PG8_LAS unsigned char* lds, const Gemm g, const Sched& S, const Epi& E) {
    int tid_l = threadIdx.x; asm volatile("" : "+v"(tid_l));
    const int tid = tid_l, wid = __builtin_amdgcn_readfirstlane(tid >> 6), lane = tid & 63, wr = wid >> 2, wc = wid & 3, fr = lane & 15, fq = lane >> 4;
    const int K = g.K, nt = K / BK;
    unsigned voffA[2], voffB[2];
#pragma unroll
    for (int i = 0; i < 2; ++i) { int R, C; stage_rc(tid * 16 + i * 8192, R, C); const int Rb = Epi::PERM ? ((R & ~31) + perm32(R & 31)) : R;
        voffA[i] = (unsigned)(R * K + C) * 2u; voffB[i] = (unsigned)(Rb * K + C) * 2u; }
    const size_t kstep = (size_t)(BK * 2);
    const size_t hstep = (size_t)HALF * K * 2;
    const size_t tstep = 2 * hstep;
    const unsigned ldsbase_ = (unsigned)(uintptr_t)lds;
    const unsigned ldsw = (unsigned)wid * 1024u;
    const int aoff = lds_byte(wr * 64 + fr, fq * 8), boff = lds_byte(wc * 32 + fr, fq * 8);
#define PG8_SA(b, h) (((b) * 2 + (h)) * HTB)
#define PG8_SB(b, h) ((4 + (b) * 2 + (h)) * HTB)
#define PG8_STAGE(bufoff, gbase, voff) do { _Pragma("unroll") for (int _i = 0; _i < 2; ++_i) \
        glds_s((const void*)(gbase), (voff)[_i], ldsbase_ + (unsigned)(bufoff) + ldsw + (unsigned)_i * 8192u); } while (0)
#define PG8_LDA(dst, b, h) do { _Pragma("unroll") for (int m = 0; m < 4; ++m) _Pragma("unroll") for (int k = 0; k < 2; ++k) dst[m][k] = *(const PG8_LAS bf16x8*)(lds + PG8_SA(b, h) + aoff + m * 2048 + k * 1024); } while (0)
#define PG8_LDB(dst, b, h) do { _Pragma("unroll") for (int n = 0; n < 2; ++n) _Pragma("unroll") for (int k = 0; k < 2; ++k) dst[n][k] = *(const PG8_LAS bf16x8*)(lds + PG8_SB(b, h) + boff + n * 2048 + k * 1024); } while (0)
#define PG8_MMA(ai, bj, At, Bt) do { __builtin_amdgcn_s_setprio(1); _Pragma("unroll") for (int m = 0; m < 4; ++m) _Pragma("unroll") for (int n = 0; n < 2; ++n) _Pragma("unroll") for (int k = 0; k < 2; ++k) \
        acc[ai][bj][m][n] = __builtin_amdgcn_mfma_f32_16x16x32_bf16(Bt[n][k], At[m][k], acc[ai][bj][m][n], 0, 0, 0); __builtin_amdgcn_s_setprio(0); } while (0)
#define PG8_WAIT_V(n) asm volatile("s_waitcnt vmcnt(" #n ")" ::: "memory")
#define PG8_WAIT_L(n) asm volatile("s_waitcnt lgkmcnt(" #n ")" ::: "memory")
#define PG8_BAR __builtin_amdgcn_s_barrier()
#define PG8_SCHED __builtin_amdgcn_sched_barrier(0)
    Unit cur, nxt; int ui = 0;
    if (!S.next(0, cur)) return;
    f32x4 acc[2][2][4][2];
#pragma unroll
    for (int a = 0; a < 2; ++a)
#pragma unroll
        for (int b = 0; b < 2; ++b)
#pragma unroll
            for (int m = 0; m < 4; ++m)
#pragma unroll
                for (int n = 0; n < 2; ++n) acc[a][b][m][n] = (f32x4){0.f, 0.f, 0.f, 0.f};
    bf16x8 At[4][2], B0[2][2], B1[2][2];
    const char* cA = (const char*)g.A + (size_t)cur.pm * tstep; const char* cB = (const char*)g.Bt + (size_t)cur.pn * tstep;
    S.a_ready(cur);
    if constexpr (SP2) {
        PG8_STAGE(PG8_SB(0, 0), cB, voffB); PG8_SCHED; PG8_STAGE(PG8_SB(0, 1), cB + hstep, voffB); PG8_SCHED; PG8_STAGE(PG8_SA(0, 0), cA, voffA); PG8_SCHED; PG8_STAGE(PG8_SA(0, 1), cA + hstep, voffA); PG8_SCHED;
        if (wr == 1) PG8_BAR;
        PG8_WAIT_V(2); PG8_BAR; PG8_SCHED;
        PG8_STAGE(PG8_SB(1, 0), cB + kstep, voffB); PG8_SCHED; PG8_STAGE(PG8_SA(1, 0), cA + kstep, voffA); PG8_SCHED; PG8_STAGE(PG8_SB(1, 1), cB + hstep + kstep, voffB); PG8_SCHED;
        PG8_WAIT_V(6); PG8_BAR; PG8_SCHED;
    } else {
        PG8_STAGE(PG8_SB(0, 0), cB, voffB); PG8_STAGE(PG8_SA(0, 0), cA, voffA); PG8_STAGE(PG8_SB(0, 1), cB + hstep, voffB); PG8_STAGE(PG8_SA(0, 1), cA + hstep, voffA);
        if (wr == 1) PG8_BAR;
        PG8_WAIT_V(4); PG8_BAR;
        PG8_STAGE(PG8_SB(1, 0), cB + kstep, voffB); PG8_STAGE(PG8_SA(1, 0), cA + kstep, voffA); PG8_STAGE(PG8_SB(1, 1), cB + hstep + kstep, voffB);
        PG8_WAIT_V(6); PG8_BAR;
    }
    for (;;) {
        const bool has_next = S.next(ui + 1, nxt);
        const char* nA = has_next ? (const char*)g.A + (size_t)nxt.pm * tstep : cA; const char* nB = has_next ? (const char*)g.Bt + (size_t)nxt.pn * tstep : cB;
        for (int t = 0; t < nt; t += 2) {
            const bool last = (t == nt - 2);
            const char* a1 = cA + (size_t)(t + 1) * kstep;
            const char* a2 = last ? nA : cA + (size_t)(t + 2) * kstep; const char* b2 = last ? nB : cB + (size_t)(t + 2) * kstep;
            const char* a3 = a2 + kstep; const char* b3 = b2 + kstep;
            if (last && has_next) S.a_ready(nxt);
            if constexpr (SP2) {
            PG8_LDB(B0, 0, 0); PG8_LDB(B1, 0, 1); PG8_SCHED; PG8_LDA(At, 0, 0); PG8_STAGE(PG8_SA(1, 1), a1 + hstep, voffA);
            PG8_WAIT_V(8); PG8_WAIT_L(0); PG8_BAR; PG8_MMA(0, 0, At, B0); PG8_MMA(0, 1, At, B1); PG8_BAR; PG8_SCHED;
            PG8_LDA(At, 0, 1); PG8_STAGE(PG8_SB(0, 0), b2, voffB); PG8_STAGE(PG8_SB(0, 1), b2 + hstep, voffB); PG8_STAGE(PG8_SA(0, 0), a2, voffA);
            PG8_WAIT_V(8); PG8_WAIT_L(0); PG8_BAR; PG8_MMA(1, 0, At, B0); PG8_MMA(1, 1, At, B1); PG8_BAR; PG8_SCHED;
            PG8_LDB(B0, 1, 0); PG8_LDB(B1, 1, 1); PG8_SCHED; PG8_LDA(At, 1, 0); PG8_STAGE(PG8_SA(0, 1), a2 + hstep, voffA);
            PG8_WAIT_V(8); PG8_WAIT_L(0); PG8_BAR; PG8_MMA(0, 0, At, B0); PG8_MMA(0, 1, At, B1); PG8_BAR; PG8_SCHED;
            PG8_LDA(At, 1, 1); PG8_STAGE(PG8_SB(1, 0), b3, voffB); PG8_STAGE(PG8_SB(1, 1), b3 + hstep, voffB); PG8_STAGE(PG8_SA(1, 0), a3, voffA);
            PG8_WAIT_V(8); PG8_WAIT_L(0); PG8_BAR; PG8_MMA(1, 0, At, B0); PG8_MMA(1, 1, At, B1); PG8_BAR; PG8_SCHED;
            } else {
            PG8_LDB(B0, 0, 0); PG8_SCHED; PG8_LDA(At, 0, 0); PG8_STAGE(PG8_SA(1, 1), a1 + hstep, voffA);
            PG8_WAIT_L(8); PG8_BAR; PG8_WAIT_L(0); PG8_MMA(0, 0, At, B0); PG8_BAR; PG8_SCHED;
            PG8_LDB(B1, 0, 1); PG8_STAGE(PG8_SB(0, 0), b2, voffB);
            PG8_BAR; PG8_WAIT_L(0); PG8_MMA(0, 1, At, B1); PG8_BAR;
            PG8_LDA(At, 0, 1); PG8_STAGE(PG8_SA(0, 0), a2, voffA);
            PG8_BAR; PG8_WAIT_L(0); PG8_MMA(1, 0, At, B0); PG8_BAR; PG8_SCHED;
            PG8_STAGE(PG8_SB(0, 1), b2 + hstep, voffB);
            PG8_WAIT_V(6); PG8_BAR; PG8_MMA(1, 1, At, B1); PG8_BAR;
            PG8_LDB(B0, 1, 0); PG8_SCHED; PG8_LDA(At, 1, 0); PG8_STAGE(PG8_SA(0, 1), a2 + hstep, voffA);
            PG8_WAIT_L(8); PG8_BAR; PG8_WAIT_L(0); PG8_MMA(0, 0, At, B0); PG8_BAR; PG8_SCHED;
            PG8_LDB(B1, 1, 1); PG8_STAGE(PG8_SB(1, 0), b3, voffB);
            PG8_BAR; PG8_WAIT_L(0); PG8_MMA(0, 1, At, B1); PG8_BAR;
            PG8_LDA(At, 1, 1); PG8_STAGE(PG8_SA(1, 0), a3, voffA);
            PG8_BAR; PG8_WAIT_L(0); PG8_MMA(1, 0, At, B0); PG8_BAR; PG8_SCHED;
            PG8_STAGE(PG8_SB(1, 1), b3 + hstep, voffB);
            PG8_WAIT_V(6); PG8_BAR; PG8_MMA(1, 1, At, B1); PG8_BAR;
            }
        }
        if constexpr (ALIGN_EPI) { if (wr == 0) PG8_BAR; }
        if constexpr (!Epi::AFTER_DRAIN) { E(acc, cur, wr, wc, fr, fq); S.done(cur); }
        if (!has_next) break;
#pragma unroll
        for (int a = 0; a < 2; ++a)
#pragma unroll
            for (int b = 0; b < 2; ++b)
#pragma unroll
                for (int m = 0; m < 4; ++m)
#pragma unroll
                    for (int n = 0; n < 2; ++n) acc[a][b][m][n] = (f32x4){0.f, 0.f, 0.f, 0.f};
        cur = nxt; cA = nA; cB = nB; ++ui;
        if constexpr (ALIGN_EPI) { if (wr == 1) PG8_BAR; }
    }
    PG8_WAIT_V(0);
    if constexpr (!ALIGN_EPI) { if (wr == 0) PG8_BAR; }
    PG8_BAR;
    if constexpr (Epi::AFTER_DRAIN) { E.fused(acc, cur, wr, wc, fr, fq, lds, wid, lane); S.done(cur); }
#undef PG8_SA
#undef PG8_SB
#undef PG8_STAGE
#undef PG8_LDA
#undef PG8_LDB
#undef PG8_MMA
#undef PG8_WAIT_V
#undef PG8_WAIT_L
#undef PG8_BAR
#undef PG8_SCHED
}
}

namespace att {
#define ALAS __attribute__((address_space(3)))
typedef unsigned short bf16_t;
typedef short bf16x8 __attribute__((ext_vector_type(8)));
typedef short s16x4 __attribute__((ext_vector_type(4)));
typedef short v4i16_t __attribute__((ext_vector_type(4)));
typedef float f32x16 __attribute__((ext_vector_type(16)));
typedef float f32x4 __attribute__((ext_vector_type(4)));
typedef unsigned u32x4 __attribute__((ext_vector_type(4)));
constexpr int SEQ = 8192, PITCH = 1024;
constexpr int KBYTES = 8192, VBYTES = 16384, BUFB = KBYTES + VBYTES, WSF_OFF = 2 * BUFB, STG_OFF = WSF_OFF + 8 * 64 * 4, LDS_BYTES = STG_OFF + 8 * 8192;
__device__ __forceinline__ int crow(int r, int hi) { return (r & 3) + 8 * (r >> 2) + 4 * hi; }
__device__ __forceinline__ unsigned f2bf(float f) { unsigned u = __builtin_bit_cast(unsigned, f); return (u + 0x7fffu + ((u >> 16) & 1u)) >> 16; }
__device__ __forceinline__ s16x4 vtr(const ALAS unsigned char* p) { return __builtin_bit_cast(s16x4, __builtin_amdgcn_ds_read_tr16_b64_v4i16((ALAS v4i16_t*)p)); }
__device__ __forceinline__ float swapsum(float v) { auto rr = __builtin_amdgcn_permlane32_swap(__float_as_uint(v), __float_as_uint(v), false, false); return __uint_as_float(rr[0]) + __uint_as_float(rr[1]); }
__device__ __forceinline__ float swapmax(float v) { auto rr = __builtin_amdgcn_permlane32_swap(__float_as_uint(v), __float_as_uint(v), false, false); return fmaxf(__uint_as_float(rr[0]), __uint_as_float(rr[1])); }
#define ATT_GLDS(g, l) __builtin_amdgcn_global_load_lds((const unsigned*)(g), (ALAS unsigned*)(l), 16, 0, 0)
#define ATT_LWAIT() asm volatile("s_waitcnt lgkmcnt(0)" ::: "memory")

__device__ __forceinline__ void attn_unit(int b, int h, int qb, const bf16_t* Q, const bf16_t* K, const bf16_t* V, bf16_t* O, float* scr, ALAS unsigned char* shm, float lam, float outscale, const float* subg) {
    int tid_l = threadIdx.x; asm volatile("" : "+v"(tid_l));
    const int tid = tid_l, lane = tid & 63, r32 = lane & 31, hi = lane >> 5; const int wid = __builtin_amdgcn_readfirstlane(tid >> 6);
    const size_t rowbase = (size_t)b * SEQ; const int q0 = qb * 256;
    const int NT = 4 * qb + 4, cw = 4 * qb + (wid >> 1);
    const unsigned shm0 = (unsigned)(uintptr_t)shm;
    ALAS float* wsf = (ALAS float*)(shm + WSF_OFF) + wid * 64;
    float* myscr = scr + ((((rowbase + q0) >> 5) + wid) * 8 + h) * 4096;
    f32x16 o[4];
    for (int m = 0; m < 2; ++m) {
        const bf16_t* Qw = Q + (rowbase + q0 + wid * 32) * PITCH + h * 128 + m * 64;
        const bf16_t* ksrc = K + rowbase * PITCH + h * 128 + m * 64 + wid * 8;
        const bf16_t* vsrc = V + (rowbase + 16 * (wid & 3)) * PITCH + h * 128 + (wid >> 2) * 32;
        const unsigned koff = (unsigned)lane * (PITCH * 2), voff = (unsigned)(lane >> 2) * (PITCH * 2) + (unsigned)(lane & 3) * 16u;
        bf16x8 qr[4];
#pragma unroll
        for (int d0 = 0; d0 < 4; ++d0) qr[d0] = *(const bf16x8*)(Qw + (size_t)r32 * PITCH + d0 * 16 + hi * 8);
        float mhat = -1e30f, l = 0.f;
#pragma unroll
        for (int d0 = 0; d0 < 4; ++d0)
#pragma unroll
            for (int r = 0; r < 16; ++r) o[d0][r] = 0.f;
#define ATT_DMA(t, bufoff) do { const size_t go_ = (size_t)(t) * 64 * PITCH; pg8::glds_s(ksrc + go_, koff, shm0 + (unsigned)(bufoff) + (unsigned)wid * 1024u); \
            pg8::glds_s(vsrc + go_, voff, shm0 + (unsigned)(bufoff) + KBYTES + (unsigned)wid * 1024u); pg8::glds_s(vsrc + go_ + 64, voff, shm0 + (unsigned)(bufoff) + KBYTES + (unsigned)(wid + 8) * 1024u); } while (0)
        ATT_DMA(0, 0);
        for (int j = 0; j < NT; ++j) {
            asm volatile("s_waitcnt vmcnt(0)" ::: "memory");
            __syncthreads();
            const int bo = (j & 1) * BUFB;
            if (j + 1 < NT) ATT_DMA(j + 1, BUFB - bo);
            if (j <= cw) {
                const ALAS unsigned char* kb = shm + bo + hi * 1024 + r32 * 16;
                f32x16 p0, p1;
#pragma unroll
                for (int r = 0; r < 16; ++r) { p0[r] = 0.f; p1[r] = 0.f; }
#pragma unroll
                for (int d0 = 0; d0 < 4; ++d0) {
                    const bf16x8 b0 = *(const ALAS bf16x8*)(kb + d0 * 2048), b1 = *(const ALAS bf16x8*)(kb + d0 * 2048 + 512);
                    p0 = __builtin_amdgcn_mfma_f32_32x32x16_bf16(b0, qr[d0], p0, 0, 0, 0);
                    p1 = __builtin_amdgcn_mfma_f32_32x32x16_bf16(b1, qr[d0], p1, 0, 0, 0);
                }
                float rm = fmaxf(p0[0], p1[0]);
#pragma unroll
                for (int r = 1; r < 16; ++r) rm = fmaxf(rm, fmaxf(p0[r], p1[r]));
                rm = swapmax(rm);
                if (__any(rm > mhat + 8.0f)) {
                    const float mnew = fmaxf(mhat, rm), f = __builtin_amdgcn_exp2f(mhat - mnew); mhat = mnew; l *= f;
                    ATT_LWAIT();
                    if (hi == 0) wsf[r32] = f;
                    ATT_LWAIT();
#pragma unroll
                    for (int r = 0; r < 16; ++r) { const float fr_ = wsf[crow(r, hi)];
#pragma unroll
                        for (int d0 = 0; d0 < 4; ++d0) o[d0][r] *= fr_; }
                    ATT_LWAIT();
                }
                float sacc = 0.f;
#pragma unroll
                for (int r = 0; r < 16; ++r) { p0[r] = __builtin_amdgcn_exp2f(p0[r] - mhat); p1[r] = __builtin_amdgcn_exp2f(p1[r] - mhat); sacc += p0[r] + p1[r]; }
                l += sacc;
                bf16x8 pw[4];
#pragma unroll
                for (int ks = 0; ks < 4; ++ks) { u32x4 w;
#pragma unroll
                    for (int i = 0; i < 4; ++i) { const int r = 8 * (ks & 1) + 2 * i; const float a = (ks < 2) ? p0[r] : p1[r], c = (ks < 2) ? p0[r + 1] : p1[r + 1]; w[i] = pg8::cvt_pk_bf16(a, c); }
                    pw[ks] = __builtin_bit_cast(bf16x8, w); }
                const ALAS unsigned char* vp = shm + bo + KBYTES + ((lane >> 4) & 1) * 32 + (lane & 3) * 8 + (4 * hi + ((lane & 15) >> 2)) * 64;
#pragma unroll
                for (int d0 = 0; d0 < 4; ++d0)
#pragma unroll
                    for (int ks = 0; ks < 4; ++ks) {
                        const s16x4 lo = vtr(vp + d0 * 4096 + ks * 1024), hh = vtr(vp + d0 * 4096 + ks * 1024 + 512);
                        const bf16x8 vf = (bf16x8){lo[0], lo[1], lo[2], lo[3], hh[0], hh[1], hh[2], hh[3]};
                        o[d0] = __builtin_amdgcn_mfma_f32_32x32x16_bf16(pw[ks], vf, o[d0], 0, 0, 0);
                    }
            }
        }
#undef ATT_DMA
        const float lt = swapsum(l);
        ATT_LWAIT();
        if (hi == 0) wsf[32 + r32] = 1.0f / lt;
        ATT_LWAIT();
        float rli[16];
#pragma unroll
        for (int r = 0; r < 16; ++r) rli[r] = wsf[32 + crow(r, hi)];
        ATT_LWAIT();
        float* sp = myscr + lane * 4; asm volatile("" : "+v"(sp));
        if (m == 0) {
#pragma unroll
            for (int d0 = 0; d0 < 4; ++d0) {
#pragma unroll
                for (int r4 = 0; r4 < 4; ++r4) { f32x4 v;
#pragma unroll
                    for (int i = 0; i < 4; ++i) v[i] = o[d0][4 * r4 + i] * rli[4 * r4 + i];
                    *(f32x4*)(sp + (d0 * 4 + r4) * 256) = v; }
                asm volatile("" ::: "memory"); }
        } else {
            float ss[16];
#pragma unroll
            for (int r = 0; r < 16; ++r) ss[r] = 0.f;
#pragma unroll
            for (int d0 = 0; d0 < 4; ++d0) {
#pragma unroll
                for (int r4 = 0; r4 < 4; ++r4) { const f32x4 v0 = *(const f32x4*)(sp + (d0 * 4 + r4) * 256);
#pragma unroll
                    for (int i = 0; i < 4; ++i) { const int r = 4 * r4 + i; const float v = v0[i] - lam * (o[d0][r] * rli[r]); o[d0][r] = v; ss[r] += v * v; } }
                asm volatile("" ::: "memory"); }
#pragma unroll
            for (int r = 0; r < 16; ++r) {
#pragma unroll
                for (int k = 1; k < 32; k <<= 1) ss[r] += __shfl_xor(ss[r], k);
                ss[r] = __builtin_amdgcn_rsqf(ss[r] * (1.0f / 128.0f) + 1e-5f) * outscale;
            }
            ALAS unsigned char* stw = shm + STG_OFF + wid * 8192;
            ALAS unsigned short* stg = (ALAS unsigned short*)stw + (4 * hi) * 128 + r32;
#pragma unroll
            for (int d0 = 0; d0 < 4; ++d0) { const float gg = subg[32 * d0 + r32];
#pragma unroll
                for (int r = 0; r < 16; ++r) stg[((r & 3) + 8 * (r >> 2)) * 128 + 32 * d0] = (unsigned short)f2bf(o[d0][r] * ss[r] * gg); }
            ATT_LWAIT();
            bf16_t* Ow = O + (rowbase + q0 + wid * 32 + (lane >> 4)) * PITCH + h * 128 + (lane & 15) * 8; asm volatile("" : "+v"(Ow));
#pragma unroll
            for (int i = 0; i < 8; ++i) { const u32x4 v = *(const ALAS u32x4*)(stw + i * 1024 + lane * 16); *(u32x4*)(Ow + (size_t)i * 4 * PITCH) = v; }
            ATT_LWAIT();
        }
    }
}
}

#ifndef PHMASK
#define PHMASK 0xFFFF
#endif
constexpr int NWAVES = 8;
constexpr int M = 32768, D = 1024, FF = 2816, SEQ = 8192;
constexpr float LN_EPS = 1e-5f;
constexpr float ALPHA = 1.4142135623730951f;
constexpr size_t MiB = 1u << 20;
constexpr size_t WS_ST = 1 * MiB;
constexpr size_t WS_TAB = 2 * MiB;
constexpr size_t WS_WQKV = 4 * MiB, WS_WO = 10 * MiB, WS_PW1 = 12 * MiB, WS_PW2 = 16 * MiB, WS_GU0 = 18 * MiB, WS_GU1 = 29 * MiB, WS_DN0 = 40 * MiB, WS_DN1 = 46 * MiB;
constexpr size_t WS_XN = 64 * MiB;
constexpr size_t WS_Q = 128 * MiB, WS_K = 192 * MiB, WS_V = 256 * MiB;
constexpr size_t WS_H = 128 * MiB;
constexpr size_t WS_G = 128 * MiB, WS_C = 192 * MiB;
constexpr size_t WS_Z = 320 * MiB;
constexpr size_t WS_END = 448 * MiB;
constexpr int LDS_BYTES = 147456;

#define LAS __attribute__((address_space(3)))
typedef unsigned short bf16;
typedef unsigned v4u __attribute__((ext_vector_type(4)));
typedef unsigned v2u __attribute__((ext_vector_type(2)));
typedef float f32x4 __attribute__((ext_vector_type(4)));
#define LDS_WAIT() asm volatile("s_waitcnt lgkmcnt(0)" ::: "memory")
__device__ __forceinline__ unsigned f2bf(float f) { unsigned u = __builtin_bit_cast(unsigned, f); return (u + 0x7fffu + ((u >> 16) & 1u)) >> 16; }
__device__ __forceinline__ unsigned pk2(float lo, float hi) { return f2bf(lo) | (f2bf(hi) << 16); }
__device__ __forceinline__ float wave_sum(float v) {
#pragma unroll
    for (int o = 1; o < 64; o <<= 1) v += __shfl_xor(v, o);
    return v;
}
__device__ __forceinline__ int map_row(int mode, int n) {
    if (mode == 1) {
        if (n >= 2048) return n;
        const int region = n >> 10, within = n & 1023, slice = within >> 6, d = within & 63;
        return 256 * (region * 4 + (slice >> 2)) + 128 * (d >> 5) + 32 * (slice & 3) + (d & 31);
    }
    if (mode == 2) { const int half = n >> 10, j = n & 1023; return 256 * (j >> 7) + 128 * half + (j & 127); }
    if (mode == 3) return 256 * (n >> 7) + (n & 127);
    if (mode == 4) return 256 * (n >> 7) + 128 + (n & 127);
    return n;
}
__device__ __forceinline__ void transpose_item(const float* W, int K, int N, bf16* WT, int mode, LAS float* scr, int item, int lane) {
    const int nblk = N / 32, kb = item / nblk, nb = item % nblk, k0 = 64 * kb, n0 = 32 * nb;
#pragma unroll 8
    for (int i = 0; i < 32; ++i) { const int kk = 2 * i + (lane >> 5); scr[kk * 33 + (lane & 31)] = W[(size_t)(k0 + kk) * N + n0 + (lane & 31)]; }
    LDS_WAIT(); asm volatile("" ::: "memory");
    const int c = lane & 7;
#pragma unroll
    for (int j = 0; j < 4; ++j) { const int n = (lane >> 3) + 8 * j; const LAS float* s = scr + (8 * c) * 33 + n;
        v4u o; o.x = pk2(s[0 * 33], s[1 * 33]); o.y = pk2(s[2 * 33], s[3 * 33]); o.z = pk2(s[4 * 33], s[5 * 33]); o.w = pk2(s[6 * 33], s[7 * 33]);
        *(v4u*)(WT + (size_t)map_row(mode, n0 + n) * K + k0 + 8 * c) = o; }
    LDS_WAIT(); asm volatile("" ::: "memory");
}

struct Args { const float* in[21]; float* out; unsigned char* ws; };

__device__ __forceinline__ void ln_phase(const float* Z, bf16* XN, float* ST, const float* g, const float* b, float* OUT, int gw, int NGW, int lane) {
    asm volatile("" : "+v"(lane));
    f32x4 gv[4], bv[4];
#pragma unroll
    for (int j = 0; j < 4; ++j) { gv[j] = *((const f32x4*)g + lane + 64 * j); bv[j] = *((const f32x4*)b + lane + 64 * j); }
    for (int row = gw; row < M; row += NGW) {
        const f32x4* zr = (const f32x4*)(Z + (size_t)row * D) + lane;
        f32x4 v[4]; float s = 0.f;
#pragma unroll
        for (int j = 0; j < 4; ++j) { v[j] = zr[64 * j]; s += (v[j].x + v[j].y) + (v[j].z + v[j].w); }
        const float mean = wave_sum(s) * (1.f / D); float s2 = 0.f;
#pragma unroll
        for (int j = 0; j < 4; ++j) { v[j] = v[j] - mean; s2 += (v[j].x * v[j].x + v[j].y * v[j].y) + (v[j].z * v[j].z + v[j].w * v[j].w); }
        const float rstd = 1.f / sqrtf(wave_sum(s2) * (1.f / D) + LN_EPS);
        if (OUT) {
            f32x4* orow = (f32x4*)(OUT + (size_t)row * D) + lane;
#pragma unroll
            for (int j = 0; j < 4; ++j) orow[64 * j] = v[j] * rstd * gv[j] + bv[j];
        } else {
            if (lane == 0) { ST[2 * row] = mean; ST[2 * row + 1] = rstd; }
            v2u* o8 = (v2u*)(XN + (size_t)row * D) + lane;
#pragma unroll
            for (int j = 0; j < 4; ++j) { const f32x4 y = v[j] * rstd * gv[j] + bv[j]; v2u w; w.x = pk2(y.x, y.y); w.y = pk2(y.z, y.w); o8[64 * j] = w; }
        }
    }
}

__global__ void __launch_bounds__(NWAVES * 64, 2) fwd_kernel(Args args) {
    extern __shared__ __attribute__((aligned(16))) unsigned char lds[];
    cg::grid_group grid = cg::this_grid();
    LAS unsigned char* L = (LAS unsigned char*)lds;
    const int tid = threadIdx.x, lane = tid & 63, wave = __builtin_amdgcn_readfirstlane(tid >> 6);
    const int G = gridDim.x, bx = blockIdx.x;
    const int vcu = (G % 8 == 0) ? (bx % 8) * (G / 8) + bx / 8 : bx;
    const int gw = vcu * NWAVES + wave, NGW = G * NWAVES;
    unsigned char* ws = args.ws;
    const float* x = args.in[0];
    const float *w_qkv = args.in[1], *w_o = args.in[2], *lq1 = args.in[3], *lk1 = args.in[4], *lq2 = args.in[5], *lk2 = args.in[6], *subln_g = args.in[7];
    const float *w_pw1 = args.in[8], *b_pw1 = args.in[9], *w_dw = args.in[10], *b_dw = args.in[11], *cln_g = args.in[12], *cln_b = args.in[13], *w_pw2 = args.in[14], *b_pw2 = args.in[15];
    const float *w_gate = args.in[16], *w_up = args.in[17], *w_down = args.in[18], *ln_g = args.in[19], *ln_b = args.in[20];
    float* ST = (float*)(ws + WS_ST); float* TAB = (float*)(ws + WS_TAB);
    bf16 *Wqkv_t = (bf16*)(ws + WS_WQKV), *Wo_t = (bf16*)(ws + WS_WO), *Wpw1_t = (bf16*)(ws + WS_PW1), *Wpw2_t = (bf16*)(ws + WS_PW2);
    bf16 *Wgu0 = (bf16*)(ws + WS_GU0), *Wgu1 = (bf16*)(ws + WS_GU1), *Wdn0 = (bf16*)(ws + WS_DN0), *Wdn1 = (bf16*)(ws + WS_DN1);
    bf16 *XN = (bf16*)(ws + WS_XN), *QB = (bf16*)(ws + WS_Q), *KB = (bf16*)(ws + WS_K), *VB = (bf16*)(ws + WS_V), *HB = (bf16*)(ws + WS_H), *GB = (bf16*)(ws + WS_G), *CB = (bf16*)(ws + WS_C);
    float* Z = (float*)(ws + WS_Z);

    {
        LAS float* scr = (LAS float*)(L + wave * 16384);
        constexpr int I_QKV = 16 * 96, I_O = 16 * 32, I_PW1 = 16 * 64, I_PW2 = 16 * 32, I_GU = 16 * 88, I_DN = 44 * 32;
        constexpr int NITEMS = I_QKV + I_O + I_PW1 + I_PW2 + 4 * I_GU + 2 * I_DN;
        for (int it = gw; it < NITEMS; it += NGW) {
            int r = it;
            if (r < I_QKV) { transpose_item(w_qkv, D, 3 * D, Wqkv_t, 1, scr, r, lane); continue; } r -= I_QKV;
            if (r < I_O) { transpose_item(w_o, D, D, Wo_t, 0, scr, r, lane); continue; } r -= I_O;
            if (r < I_PW1) { transpose_item(w_pw1, D, 2 * D, Wpw1_t, 2, scr, r, lane); continue; } r -= I_PW1;
            if (r < I_PW2) { transpose_item(w_pw2, D, D, Wpw2_t, 0, scr, r, lane); continue; } r -= I_PW2;
            if (r < I_GU) { transpose_item(w_gate, D, FF, Wgu0, 3, scr, r, lane); continue; } r -= I_GU;
            if (r < I_GU) { transpose_item(w_up, D, FF, Wgu0, 4, scr, r, lane); continue; } r -= I_GU;
            if (r < I_GU) { transpose_item(w_gate + (size_t)D * FF, D, FF, Wgu1, 3, scr, r, lane); continue; } r -= I_GU;
            if (r < I_GU) { transpose_item(w_up + (size_t)D * FF, D, FF, Wgu1, 4, scr, r, lane); continue; } r -= I_GU;
            if (r < I_DN) { transpose_item(w_down, FF, D, Wdn0, 0, scr, r, lane); continue; } r -= I_DN;
            transpose_item(w_down + (size_t)FF * D, FF, D, Wdn1, 0, scr, r, lane);
        }
        for (int row = gw; row < M; row += NGW) {
            const f32x4* xr = (const f32x4*)(x + (size_t)row * D) + lane; v2u* o8 = (v2u*)(XN + (size_t)row * D) + lane;
#pragma unroll
            for (int j = 0; j < 4; ++j) { const f32x4 y = xr[64 * j]; v2u w; w.x = pk2(y.x, y.y); w.y = pk2(y.z, y.w); o8[64 * j] = w; }
        }
        for (int e = bx * (NWAVES * 64) + tid; e < SEQ * 32; e += G * NWAVES * 64) {
            const int pos = e >> 5, i = e & 31, i8 = i & 7, i3 = i >> 3;
            double c = (i8 == 0) ? 1.0 : (i8 == 1) ? 0.7498942093324559 : (i8 == 2) ? 0.5623413251903491 : (i8 == 3) ? 0.4216965034285822 : (i8 == 4) ? 0.31622776601683794 : (i8 == 5) ? 0.23713737056616552 : (i8 == 6) ? 0.1778279410038923 : 0.1333521432163324;
            c *= (i3 == 0) ? 1.0 : (i3 == 1) ? 0.1 : (i3 == 2) ? 0.01 : 0.001;
            const double rev = (double)pos * c * 0.15915494309189535;
            const float fr = (float)(rev - __builtin_floor(rev));
            TAB[pos * 64 + i] = __builtin_amdgcn_cosf(fr); TAB[pos * 64 + 32 + i] = __builtin_amdgcn_sinf(fr);
        }
    }
    grid.sync();

    if (PHMASK & (1 << 1)) {
        pg8::Gemm g{XN, Wqkv_t, M, 3 * D, D}; pg8::StaticOrder S; S.init(M, 3 * D, G, bx);
        pg8::EpiQKV E{QB, KB, VB, TAB, 0.125f * 1.4426950408889634f};
        pg8::gemm_phase<pg8::EpiQKV, pg8::StaticOrder, true, true>(L, g, S, E);
    }
    grid.sync();

    if (PHMASK & (1 << 2)) {
        const float d1 = wave_sum(lq1[lane] * lk1[lane]), d2 = wave_sum(lq2[lane] * lk2[lane]);
        const float lam = __expf(d1) - __expf(d2) + 0.2f;
        for (int idx = vcu; idx < 1024; idx += G) {
            const int v = idx & 255, i = idx >> 8, bh = v >> 3, s = v & 7;
            const int qb = (i == 0) ? 31 - s : (i == 1) ? 16 + s : (i == 2) ? 15 - s : s;
            att::attn_unit(bh >> 3, bh & 7, qb, QB, KB, VB, XN, Z, L, lam, 0.8f, subln_g);
        }
    }
    grid.sync();

    if (PHMASK & (1 << 3)) {
        pg8::Gemm g{XN, Wo_t, M, D, D}; pg8::StaticOrder S; S.init(M, D, G, bx);
        pg8::EpiResid<0> E{x, Z, nullptr, nullptr, nullptr, nullptr, ALPHA};
        pg8::gemm_phase<pg8::EpiResid<0>, pg8::StaticOrder, true, true>(L, g, S, E);
    }
    grid.sync();
    ln_phase(Z, XN, ST, ln_g, ln_b, nullptr, gw, NGW, lane);
    grid.sync();

    for (int layer = 0; layer < 2; ++layer) {
        if (layer == 1) {
            if (PHMASK & (1 << 8)) {
                pg8::Gemm g{XN, Wpw1_t, M, 2 * D, D}; pg8::StaticOrder S; S.init(M, 2 * D, G, bx);
                pg8::EpiGLU E{GB, b_pw1};
                pg8::gemm_phase<pg8::EpiGLU, pg8::StaticOrder, true, true>(L, g, S, E);
            }
            grid.sync();
            if (PHMASK & (1 << 9)) {
                int ctid = threadIdx.x; asm volatile("" : "+v"(ctid));
                const int clane = ctid & 63, cwave = __builtin_amdgcn_readfirstlane(ctid >> 6);
                LAS unsigned* tile = (LAS unsigned*)L;
                LAS float* red = (LAS float*)(L + 126976);
                LAS float* stat = red + 512;
                float w0[31], w1[31];
#pragma unroll
                for (int t = 0; t < 31; ++t) { w0[t] = w_dw[t * D + 2 * ctid]; w1[t] = w_dw[t * D + 2 * ctid + 1]; }
                const float bd0 = b_dw[2 * ctid], bd1 = b_dw[2 * ctid + 1], g0 = cln_g[2 * ctid], g1 = cln_g[2 * ctid + 1], bb0 = cln_b[2 * ctid], bb1 = cln_b[2 * ctid + 1];
                for (int unit = vcu; unit < M / 32; unit += G) {
                    const int row0 = unit * 32, s0 = row0 & (SEQ - 1);
                    __syncthreads();
                    for (int p = ctid; p < 62 * 128; p += NWAVES * 64) { const int rr = p >> 7, ch = p & 127;
                        v4u v = (v4u){0u, 0u, 0u, 0u}; if (s0 - 30 + rr >= 0) v = *(const v4u*)(GB + (size_t)(row0 - 30 + rr) * D + ch * 8);
                        *(LAS v4u*)(L + rr * 2048 + ch * 16) = v; }
                    __syncthreads();
#pragma unroll 1
                    for (int r = 0; r < 32; ++r) {
                        float y0 = bd0, y1 = bd1; const LAS unsigned* tp = tile + r * 512 + ctid;
#pragma unroll
                        for (int t = 0; t < 31; ++t) { const unsigned u = tp[t * 512]; y0 += w0[t] * __uint_as_float(u << 16); y1 += w1[t] * __uint_as_float(u & 0xffff0000u); }
                        const float s = wave_sum(y0 + y1), q = wave_sum(y0 * y0 + y1 * y1);
                        if (clane == 0) { red[(cwave * 32 + r) * 2] = s; red[(cwave * 32 + r) * 2 + 1] = q; }
                    }
                    __syncthreads();
                    if (ctid < 32) { float s = 0.f, q = 0.f;
#pragma unroll
                        for (int w = 0; w < 8; ++w) { s += red[(w * 32 + ctid) * 2]; q += red[(w * 32 + ctid) * 2 + 1]; }
                        const float mean = s * (1.f / D), var = q * (1.f / D) - mean * mean;
                        stat[2 * ctid] = mean; stat[2 * ctid + 1] = 1.f / sqrtf(fmaxf(var, 0.f) + LN_EPS); }
                    __syncthreads();
#pragma unroll 1
                    for (int r = 0; r < 32; ++r) {
                        float y0 = bd0, y1 = bd1; const LAS unsigned* tp = tile + r * 512 + ctid;
#pragma unroll
                        for (int t = 0; t < 31; ++t) { const unsigned u = tp[t * 512]; y0 += w0[t] * __uint_as_float(u << 16); y1 += w1[t] * __uint_as_float(u & 0xffff0000u); }
                        const float mean = stat[2 * r], rstd = stat[2 * r + 1];
                        float n0 = (y0 - mean) * rstd * g0 + bb0, n1 = (y1 - mean) * rstd * g1 + bb1;
                        n0 = n0 * __builtin_amdgcn_rcpf(1.0f + __builtin_amdgcn_exp2f(n0 * -1.4426950408889634f));
                        n1 = n1 * __builtin_amdgcn_rcpf(1.0f + __builtin_amdgcn_exp2f(n1 * -1.4426950408889634f));
                        *(unsigned*)(CB + (size_t)(row0 + r) * D + 2 * ctid) = pk2(n0, n1);
                    }
                }
                __syncthreads();
            }
            grid.sync();
            if (PHMASK & (1 << 10)) {
                pg8::Gemm g{CB, Wpw2_t, M, D, D}; pg8::StaticOrder S; S.init(M, D, G, bx);
                pg8::EpiResid<1> E{Z, Z, ST, ln_g + 1 * D, ln_b + 1 * D, b_pw2, ALPHA};
                pg8::gemm_phase<pg8::EpiResid<1>, pg8::StaticOrder, true, true>(L, g, S, E);
            }
            grid.sync();
            ln_phase(Z, XN, ST, ln_g + 2 * D, ln_b + 2 * D, nullptr, gw, NGW, lane);
            grid.sync();
        }
        if (PHMASK & (1 << 5)) {
            pg8::Gemm g{XN, layer ? Wgu1 : Wgu0, M, 2 * FF, D}; pg8::StaticOrder S; S.init(M, 2 * FF, G, bx);
            pg8::EpiSwiGLU E{HB, FF};
            pg8::gemm_phase<pg8::EpiSwiGLU, pg8::StaticOrder, true, true>(L, g, S, E);
        }
        grid.sync();
        if (PHMASK & (1 << 6)) {
            pg8::Gemm g{HB, layer ? Wdn1 : Wdn0, M, D, FF}; pg8::StaticOrder S; S.init(M, D, G, bx);
            pg8::EpiResid<1> E{Z, Z, ST, ln_g + (2 * layer) * D, ln_b + (2 * layer) * D, nullptr, ALPHA};
            pg8::gemm_phase<pg8::EpiResid<1>, pg8::StaticOrder, true, true>(L, g, S, E);
        }
        grid.sync();
        if (layer == 0) { ln_phase(Z, XN, ST, ln_g + 1 * D, ln_b + 1 * D, nullptr, gw, NGW, lane); grid.sync(); }
        else ln_phase(Z, nullptr, ST, ln_g + 3 * D, ln_b + 3 * D, args.out, gw, NGW, lane);
    }
}

extern "C" void kernel_launch(void* const* d_in, const int* in_sizes, int n_in, void* d_out, int out_size, void* d_ws, size_t ws_size, hipStream_t stream) {
    static int grid = 0;
    if (grid == 0) {
        if (n_in != 21 || out_size != M * D || ws_size < WS_END) { fprintf(stderr, "kernel_launch: unexpected shapes (n_in %d out %d ws %zu)\n", n_in, out_size, ws_size); grid = -1; return; }
        int dev = 0, cus = 0, per_cu = 0;
        hipGetDevice(&dev); hipDeviceGetAttribute(&cus, hipDeviceAttributeMultiprocessorCount, dev);
        if (hipFuncSetAttribute((const void*)fwd_kernel, hipFuncAttributeMaxDynamicSharedMemorySize, LDS_BYTES) != hipSuccess) { fprintf(stderr, "kernel_launch: hipFuncSetAttribute failed\n"); grid = -1; return; }
        hipOccupancyMaxActiveBlocksPerMultiprocessor(&per_cu, (const void*)fwd_kernel, NWAVES * 64, LDS_BYTES);
        (void)hipGetLastError();
        grid = cus * (per_cu > 0 ? 1 : 1);
        if (grid > 256) grid = 256;
        grid &= ~7;
        fprintf(stderr, "kernel_launch: cus %d per_cu %d grid %d\n", cus, per_cu, grid);
    }
    if (grid <= 0) return;
    Args a{};
    for (int i = 0; i < 21; ++i) a.in[i] = (const float*)d_in[i];
    a.out = (float*)d_out; a.ws = (unsigned char*)d_ws;
    void* kargs[] = {&a};
    hipError_t e = hipLaunchCooperativeKernel((const void*)fwd_kernel, dim3(grid), dim3(NWAVES * 64), kargs, LDS_BYTES, stream);
    if (e != hipSuccess) fprintf(stderr, "kernel_launch: cooperative launch failed: %s (grid %d)\n", hipGetErrorString(e), grid);
}
```

```cpp
#include <hip/hip_runtime.h>
#include <hip/hip_cooperative_groups.h>
#include <cstdio>
#include <cstdint>
namespace cg = cooperative_groups;
namespace pg8 {
#define PG8_LAS __attribute__((address_space(3)))
typedef unsigned short bf16_t;
typedef short bf16x8 __attribute__((ext_vector_type(8)));
typedef float f32x4 __attribute__((ext_vector_type(4)));
typedef unsigned u32x4 __attribute__((ext_vector_type(4)));
constexpr int BM = 256, BK = 64, HALF = 128, HTB = HALF * BK * 2  , STAGE_BYTES = 8 * HTB, NXCD = 8, WGM = 8;

__host__ __device__ __forceinline__ int lds_byte(int r, int c) { const int st = (r >> 4) * 2 + (c >> 5), rr = r & 15, cc = c & 31, ob = rr * 64 + cc * 2; return st * 1024 + (ob ^ (((ob >> 9) & 1) << 5)); }
__host__ __device__ __forceinline__ void stage_rc(int b, int& R, int& C) { const int st = b / 1024, sb = b % 1024, swz = sb ^ (((sb >> 9) & 1) << 5); R = (st >> 1) * 16 + swz / 64; C = (st & 1) * 32 + (swz % 64) / 2; }
__host__ __device__ __forceinline__ int perm32(int rho) { const int n = rho >> 4, i = rho & 15; return 8 * (i >> 2) + 4 * n + (i & 3); }

struct Unit { int pm, pn; };
struct Gemm { const bf16_t* A; const bf16_t* Bt; int M, N, K; };

struct StaticOrder {
    int nM, nN, nwg, G, c;
    __host__ __device__ void init(int M, int N, int G_, int c_) { nM = M / BM; nN = N / BM; nwg = nM * nN; G = G_; c = c_; }
    __host__ __device__ bool next(int i, Unit& u) const {
        const long L = (long)i * G + c; if (L >= nwg) return false;
        int wgid = (int)L; { const int q = nwg / NXCD, r = nwg % NXCD, xcd = wgid % NXCD, off = wgid / NXCD; wgid = (xcd < r ? xcd * (q + 1) : r * (q + 1) + (xcd - r) * q) + off; }
        const int nig = WGM * nN, gid = wgid / nig, fm = gid * WGM, gsz = (nM - fm) < WGM ? (nM - fm) : WGM;
        u.pm = fm + ((wgid % nig) % gsz); u.pn = (wgid % nig) / gsz; return true;
    }
    __device__ __forceinline__ void a_ready(const Unit&) const {}
    __device__ __forceinline__ void done(const Unit&) const {}
};

__device__ __forceinline__ unsigned cvt_pk_bf16(float lo, float hi) { unsigned r; asm volatile("v_cvt_pk_bf16_f32 %0, %1, %2" : "=v"(r) : "v"(lo), "v"(hi)); return r; }
__device__ __forceinline__ void glds_s(const void* sbase, unsigned voff, unsigned ldsdst) {
    unsigned keep;
    asm volatile("s_mov_b32 %0, m0\n\ts_mov_b32 m0, %3\n\ts_nop 0\n\tglobal_load_lds_dwordx4 %1, %2\n\ts_mov_b32 m0, %0" : "=&s"(keep) : "v"(voff), "s"(sbase), "s"(ldsdst) : "memory");
}
typedef float f32x2 __attribute__((ext_vector_type(2)));
__device__ __forceinline__ f32x2 gelu_pk(f32x2 v) {
    const f32x2 av = __builtin_elementwise_abs(v), d = av * 0.2316418882f + 1.0f;
    f32x2 t; t.x = __builtin_amdgcn_rcpf(d.x); t.y = __builtin_amdgcn_rcpf(d.y);
    f32x2 q = t * 0.5307027145f + (-0.7265760135f); q = q * t + 0.7107068705f; q = q * t + (-0.142248368f); q = q * t + 0.127414796f; q = q * t;
    const f32x2 s = (v * v) * (-0.72134752044f);
    f32x2 e; e.x = __builtin_amdgcn_exp2f(s.x); e.y = __builtin_amdgcn_exp2f(s.y);
    const f32x2 m = v * (q * e), r = v - m;
    f32x2 o; o.x = v.x < 0.f ? m.x : r.x; o.y = v.y < 0.f ? m.y : r.y; return o;
}

template <int ACT  > struct EpiBf16 {
    static constexpr bool PERM = true, AFTER_DRAIN = false; static_assert(ACT == 0 || ACT == 1, "EpiBf16: ACT is 0 (none) or 1 (gelu_pk)");
    bf16_t* O; int ldc; const float* bias; int split_cols; size_t split_stride; float scale0;
    __device__ __forceinline__ void operator()(const f32x4 (&acc)[2][2][4][2], const Unit& u, int wr, int wc, int fr_in, int fq_in) const {
        int fr = fr_in, fq = fq_in; asm volatile("" : "+v"(fr), "+v"(fq));
        const int row0 = u.pm * BM + wr * 64 + fr; int colt = u.pn * BM; bf16_t* base = O;
        float sc = 1.f; if (split_cols) { const int t = colt / split_cols; base += (size_t)t * split_stride; colt -= t * split_cols; if (t == 0) sc = scale0; }
        const int col0 = colt + wc * 32 + 8 * fq, bcol0 = u.pn * BM + wc * 32 + 8 * fq;
        f32x4 bv[2][2];
#pragma unroll
        for (int bj = 0; bj < 2; ++bj)
#pragma unroll
            for (int n = 0; n < 2; ++n) bv[bj][n] = bias ? *(const f32x4*)(bias + bcol0 + bj * HALF + 4 * n) : (f32x4){0.f, 0.f, 0.f, 0.f};
#pragma unroll
        for (int ai = 0; ai < 2; ++ai)
#pragma unroll
            for (int m = 0; m < 4; ++m) { bf16_t* rowp = base + (size_t)(row0 + ai * HALF + m * 16) * ldc + col0;
#pragma unroll
                for (int bj = 0; bj < 2; ++bj) { f32x4 v0 = acc[ai][bj][m][0] + bv[bj][0], v1 = acc[ai][bj][m][1] + bv[bj][1];
                    if (ACT == 1) { f32x2 a = gelu_pk((f32x2){v0[0], v0[1]}), b = gelu_pk((f32x2){v0[2], v0[3]}), c = gelu_pk((f32x2){v1[0], v1[1]}), d = gelu_pk((f32x2){v1[2], v1[3]});
                        v0 = (f32x4){a.x, a.y, b.x, b.y}; v1 = (f32x4){c.x, c.y, d.x, d.y}; }
                    v0 = v0 * sc; v1 = v1 * sc; u32x4 w; w.x = cvt_pk_bf16(v0[0], v0[1]); w.y = cvt_pk_bf16(v0[2], v0[3]); w.z = cvt_pk_bf16(v1[0], v1[1]); w.w = cvt_pk_bf16(v1[2], v1[3]);
                    *(u32x4*)(rowp + bj * HALF) = w; } }
    }
};
__device__ __forceinline__ u32x4 pack8(const f32x4 v0, const f32x4 v1) { u32x4 w; w.x = cvt_pk_bf16(v0[0], v0[1]); w.y = cvt_pk_bf16(v0[2], v0[3]); w.z = cvt_pk_bf16(v1[0], v1[1]); w.w = cvt_pk_bf16(v1[2], v1[3]); return w; }
__device__ __forceinline__ f32x4 sigm4(const f32x4 g) {
    f32x4 r;
#pragma unroll
    for (int i = 0; i < 4; ++i) r[i] = __builtin_amdgcn_rcpf(1.0f + __builtin_amdgcn_exp2f(g[i] * -1.4426950408889634f));
    return r;
}
struct EpiQKV {
    static constexpr bool PERM = true, AFTER_DRAIN = false;
    bf16_t* Q; bf16_t* Kb; bf16_t* V; const float* tab; float qscale;
    __device__ __forceinline__ void operator()(const f32x4 (&acc)[2][2][4][2], const Unit& u, int wr, int wc, int fr_in, int fq_in) const {
        int fr = fr_in, fq = fq_in; asm volatile("" : "+v"(fr), "+v"(fq));
        const int row0 = u.pm * BM + wr * 64 + fr;
        if (u.pn >= 8) {
            const int col0 = (u.pn - 8) * BM + wc * 32 + 8 * fq;
#pragma unroll
            for (int ai = 0; ai < 2; ++ai)
#pragma unroll
                for (int m = 0; m < 4; ++m) { bf16_t* rowp = V + (size_t)(row0 + ai * HALF + m * 16) * 1024 + col0;
#pragma unroll
                    for (int bj = 0; bj < 2; ++bj) *(u32x4*)(rowp + bj * HALF) = pack8(acc[ai][bj][m][0], acc[ai][bj][m][1]); }
        } else {
            bf16_t* dst = (u.pn >> 2) ? Kb : Q; const float sc = (u.pn >> 2) ? 1.0f : qscale;
            const int colbase = 64 * (4 * (u.pn & 3) + wc) + 8 * fq;
#pragma unroll
            for (int ai = 0; ai < 2; ++ai)
#pragma unroll
                for (int m = 0; m < 4; ++m) { const int row = row0 + ai * HALF + m * 16; const float* tp = tab + (size_t)(row & 8191) * 64 + 8 * fq;
                    const f32x4 c0 = *(const f32x4*)(tp), c1 = *(const f32x4*)(tp + 4), s0 = *(const f32x4*)(tp + 32), s1 = *(const f32x4*)(tp + 36);
                    const f32x4 x10 = acc[ai][0][m][0], x11 = acc[ai][0][m][1], x20 = acc[ai][1][m][0], x21 = acc[ai][1][m][1];
                    const f32x4 o10 = (x10 * c0 - x20 * s0) * sc, o11 = (x11 * c1 - x21 * s1) * sc, o20 = (x20 * c0 + x10 * s0) * sc, o21 = (x21 * c1 + x11 * s1) * sc;
                    bf16_t* rowp = dst + (size_t)row * 1024 + colbase;
                    *(u32x4*)(rowp) = pack8(o10, o11); *(u32x4*)(rowp + 32) = pack8(o20, o21); asm volatile("" ::: "memory"); }
        }
    }
};
struct EpiSwiGLU {
    static constexpr bool PERM = true, AFTER_DRAIN = false;
    bf16_t* H; int ldc;
    __device__ __forceinline__ void operator()(const f32x4 (&acc)[2][2][4][2], const Unit& u, int wr, int wc, int fr_in, int fq_in) const {
        int fr = fr_in, fq = fq_in; asm volatile("" : "+v"(fr), "+v"(fq));
        const int row0 = u.pm * BM + wr * 64 + fr, col0 = u.pn * HALF + wc * 32 + 8 * fq;
#pragma unroll
        for (int ai = 0; ai < 2; ++ai)
#pragma unroll
            for (int m = 0; m < 4; ++m) { bf16_t* rowp = H + (size_t)(row0 + ai * HALF + m * 16) * ldc + col0;
                const f32x4 g0 = acc[ai][0][m][0], g1 = acc[ai][0][m][1];
                const f32x4 h0 = g0 * sigm4(g0) * acc[ai][1][m][0], h1 = g1 * sigm4(g1) * acc[ai][1][m][1];
                *(u32x4*)(rowp) = pack8(h0, h1); __builtin_amdgcn_sched_barrier(0); }
    }
};
struct EpiGLU {
    static constexpr bool PERM = true, AFTER_DRAIN = false;
    bf16_t* G; const float* bias;
    __device__ __forceinline__ void operator()(const f32x4 (&acc)[2][2][4][2], const Unit& u, int wr, int wc, int fr_in, int fq_in) const {
        int fr = fr_in, fq = fq_in; asm volatile("" : "+v"(fr), "+v"(fq));
        const int row0 = u.pm * BM + wr * 64 + fr, col0 = u.pn * HALF + wc * 32 + 8 * fq;
#pragma unroll
        for (int ai = 0; ai < 2; ++ai)
#pragma unroll
            for (int m = 0; m < 4; ++m) { bf16_t* rowp = G + (size_t)(row0 + ai * HALF + m * 16) * 1024 + col0;
                const f32x4 ba0 = *(const f32x4*)(bias + col0), ba1 = *(const f32x4*)(bias + col0 + 4), bg0 = *(const f32x4*)(bias + 1024 + col0), bg1 = *(const f32x4*)(bias + 1024 + col0 + 4);
                const f32x4 h0 = (acc[ai][0][m][0] + ba0) * sigm4(acc[ai][1][m][0] + bg0), h1 = (acc[ai][0][m][1] + ba1) * sigm4(acc[ai][1][m][1] + bg1);
                *(u32x4*)(rowp) = pack8(h0, h1); asm volatile("" ::: "memory"); __builtin_amdgcn_sched_barrier(0); }
    }
};
template <int MODE> struct EpiResid {
    static constexpr bool PERM = false, AFTER_DRAIN = false;
    const float* xin; float* out; const float* st; const float* g; const float* b; const float* bias; float alpha;
    __device__ __forceinline__ void operator()(const f32x4 (&acc)[2][2][4][2], const Unit& u, int wr, int wc, int fr_in, int fq_in) const {
        int fr = fr_in, fq = fq_in; asm volatile("" : "+v"(fr), "+v"(fq));
        const int col0 = u.pn * BM + wc * 32 + 4 * fq;
#pragma unroll
        for (int bj = 0; bj < 2; ++bj)
#pragma unroll
            for (int n = 0; n < 2; ++n) { const int c = col0 + bj * HALF + n * 16;
                const f32x4 cv = bias ? *(const f32x4*)(bias + c) : (f32x4){0.f, 0.f, 0.f, 0.f};
                f32x4 gv = cv, bv = cv; if (MODE == 1) { gv = *(const f32x4*)(g + c); bv = *(const f32x4*)(b + c); }
#pragma unroll
                for (int ai = 0; ai < 2; ++ai)
#pragma unroll
                    for (int m = 0; m < 4; ++m) { const int row = u.pm * BM + ai * HALF + wr * 64 + m * 16 + fr; const size_t off = (size_t)row * 1024 + c;
                        f32x4 xv = *(const f32x4*)(xin + off);
                        if (MODE == 1) { const float mean = st[2 * row], rstd = st[2 * row + 1]; xv = (xv - mean) * rstd * gv + bv; }
                        *(f32x4*)(out + off) = xv * alpha + acc[ai][bj][m][n] + cv;
                        if (m & 1) asm volatile("" ::: "memory"); }
            }
    }
};

template <class Epi, class Sched, bool ALIGN_EPI = false, bool SP2 = false>
__device__ __forceinline__ void gemm_phase(PG8_LAS unsigned char* lds, const Gemm g, const Sched& S, const Epi& E) {
    int tid_l = threadIdx.x; asm volatile("" : "+v"(tid_l));
    const int tid = tid_l, wid = __builtin_amdgcn_readfirstlane(tid >> 6), lane = tid & 63, wr = wid >> 2, wc = wid & 3, fr = lane & 15, fq = lane >> 4;
    const int K = g.K, nt = K / BK;
    unsigned voffA[2], voffB[2];
#pragma unroll
    for (int i = 0; i < 2; ++i) { int R, C; stage_rc(tid * 16 + i * 8192, R, C); const int Rb = Epi::PERM ? ((R & ~31) + perm32(R & 31)) : R;
        voffA[i] = (unsigned)(R * K + C) * 2u; voffB[i] = (unsigned)(Rb * K + C) * 2u; }
    const size_t kstep = (size_t)(BK * 2);
    const size_t hstep = (size_t)HALF * K * 2;
    const size_t tstep = 2 * hstep;
    const unsigned ldsbase_ = (unsigned)(uintptr_t)lds;
    const unsigned ldsw = (unsigned)wid * 1024u;
    const int aoff = lds_byte(wr * 64 + fr, fq * 8), boff = lds_byte(wc * 32 + fr, fq * 8);
#define PG8_SA(b, h) (((b) * 2 + (h)) * HTB)
#define PG8_SB(b, h) ((4 + (b) * 2 + (h)) * HTB)
#define PG8_STAGE(bufoff, gbase, voff) do { _Pragma("unroll") for (int _i = 0; _i < 2; ++_i) \
        glds_s((const void*)(gbase), (voff)[_i], ldsbase_ + (unsigned)(bufoff) + ldsw + (unsigned)_i * 8192u); } while (0)
#define PG8_LDA(dst, b, h) do { _Pragma("unroll") for (int m = 0; m < 4; ++m) _Pragma("unroll") for (int k = 0; k < 2; ++k) dst[m][k] = *(const PG8_LAS bf16x8*)(lds + PG8_SA(b, h) + aoff + m * 2048 + k * 1024); } while (0)
#define PG8_LDB(dst, b, h) do { _Pragma("unroll") for (int n = 0; n < 2; ++n) _Pragma("unroll") for (int k = 0; k < 2; ++k) dst[n][k] = *(const PG8_LAS bf16x8*)(lds + PG8_SB(b, h) + boff + n * 2048 + k * 1024); } while (0)
#define PG8_MMA(ai, bj, At, Bt) do { __builtin_amdgcn_s_setprio(1); _Pragma("unroll") for (int m = 0; m < 4; ++m) _Pragma("unroll") for (int n = 0; n < 2; ++n) _Pragma("unroll") for (int k = 0; k < 2; ++k) \
        acc[ai][bj][m][n] = __builtin_amdgcn_mfma_f32_16x16x32_bf16(Bt[n][k], At[m][k], acc[ai][bj][m][n], 0, 0, 0); __builtin_amdgcn_s_setprio(0); } while (0)
#define PG8_WAIT_V(n) asm volatile("s_waitcnt vmcnt(" #n ")" ::: "memory")
#define PG8_WAIT_L(n) asm volatile("s_waitcnt lgkmcnt(" #n ")" ::: "memory")
#define PG8_BAR __builtin_amdgcn_s_barrier()
#define PG8_SCHED __builtin_amdgcn_sched_barrier(0)
    Unit cur, nxt; int ui = 0;
    if (!S.next(0, cur)) return;
    f32x4 acc[2][2][4][2];
#pragma unroll
    for (int a = 0; a < 2; ++a)
#pragma unroll
        for (int b = 0; b < 2; ++b)
#pragma unroll
            for (int m = 0; m < 4; ++m)
#pragma unroll
                for (int n = 0; n < 2; ++n) acc[a][b][m][n] = (f32x4){0.f, 0.f, 0.f, 0.f};
    bf16x8 At[4][2], B0[2][2], B1[2][2];
    const char* cA = (const char*)g.A + (size_t)cur.pm * tstep; const char* cB = (const char*)g.Bt + (size_t)cur.pn * tstep;
    S.a_ready(cur);
    if constexpr (SP2) {
        PG8_STAGE(PG8_SB(0, 0), cB, voffB); PG8_SCHED; PG8_STAGE(PG8_SB(0, 1), cB + hstep, voffB); PG8_SCHED; PG8_STAGE(PG8_SA(0, 0), cA, voffA); PG8_SCHED; PG8_STAGE(PG8_SA(0, 1), cA + hstep, voffA); PG8_SCHED;
        if (wr == 1) PG8_BAR;
        PG8_WAIT_V(2); PG8_BAR; PG8_SCHED;
        PG8_STAGE(PG8_SB(1, 0), cB + kstep, voffB); PG8_SCHED; PG8_STAGE(PG8_SA(1, 0), cA + kstep, voffA); PG8_SCHED; PG8_STAGE(PG8_SB(1, 1), cB + hstep + kstep, voffB); PG8_SCHED;
        PG8_WAIT_V(6); PG8_BAR; PG8_SCHED;
    } else {
        PG8_STAGE(PG8_SB(0, 0), cB, voffB); PG8_STAGE(PG8_SA(0, 0), cA, voffA); PG8_STAGE(PG8_SB(0, 1), cB + hstep, voffB); PG8_STAGE(PG8_SA(0, 1), cA + hstep, voffA);
        if (wr == 1) PG8_BAR;
        PG8_WAIT_V(4); PG8_BAR;
        PG8_STAGE(PG8_SB(1, 0), cB + kstep, voffB); PG8_STAGE(PG8_SA(1, 0), cA + kstep, voffA); PG8_STAGE(PG8_SB(1, 1), cB + hstep + kstep, voffB);
        PG8_WAIT_V(6); PG8_BAR;
    }
    for (;;) {
        const bool has_next = S.next(ui + 1, nxt);
        const char* nA = has_next ? (const char*)g.A + (size_t)nxt.pm * tstep : cA; const char* nB = has_next ? (const char*)g.Bt + (size_t)nxt.pn * tstep : cB;
        for (int t = 0; t < nt; t += 2) {
            const bool last = (t == nt - 2);
            const char* a1 = cA + (size_t)(t + 1) * kstep;
            const char* a2 = last ? nA : cA + (size_t)(t + 2) * kstep; const char* b2 = last ? nB : cB + (size_t)(t + 2) * kstep;
            const char* a3 = a2 + kstep; const char* b3 = b2 + kstep;
            if (last && has_next) S.a_ready(nxt);
            if constexpr (SP2) {
            PG8_LDB(B0, 0, 0); PG8_LDB(B1, 0, 1); PG8_SCHED; PG8_LDA(At, 0, 0); PG8_STAGE(PG8_SA(1, 1), a1 + hstep, voffA);
            PG8_WAIT_V(8); PG8_WAIT_L(0); PG8_BAR; PG8_MMA(0, 0, At, B0); PG8_MMA(0, 1, At, B1); PG8_BAR; PG8_SCHED;
            PG8_LDA(At, 0, 1); PG8_STAGE(PG8_SB(0, 0), b2, voffB); PG8_STAGE(PG8_SB(0, 1), b2 + hstep, voffB); PG8_STAGE(PG8_SA(0, 0), a2, voffA);
            PG8_WAIT_V(8); PG8_WAIT_L(0); PG8_BAR; PG8_MMA(1, 0, At, B0); PG8_MMA(1, 1, At, B1); PG8_BAR; PG8_SCHED;
            PG8_LDB(B0, 1, 0); PG8_LDB(B1, 1, 1); PG8_SCHED; PG8_LDA(At, 1, 0); PG8_STAGE(PG8_SA(0, 1), a2 + hstep, voffA);
            PG8_WAIT_V(8); PG8_WAIT_L(0); PG8_BAR; PG8_MMA(0, 0, At, B0); PG8_MMA(0, 1, At, B1); PG8_BAR; PG8_SCHED;
            PG8_LDA(At, 1, 1); PG8_STAGE(PG8_SB(1, 0), b3, voffB); PG8_STAGE(PG8_SB(1, 1), b3 + hstep, voffB); PG8_STAGE(PG8_SA(1, 0), a3, voffA);
            PG8_WAIT_V(8); PG8_WAIT_L(0); PG8_BAR; PG8_MMA(1, 0, At, B0); PG8_MMA(1, 1, At, B1); PG8_BAR; PG8_SCHED;
            } else {
            PG8_LDB(B0, 0, 0); PG8_SCHED; PG8_LDA(At, 0, 0); PG8_STAGE(PG8_SA(1, 1), a1 + hstep, voffA);
            PG8_WAIT_L(8); PG8_BAR; PG8_WAIT_L(0); PG8_MMA(0, 0, At, B0); PG8_BAR; PG8_SCHED;
            PG8_LDB(B1, 0, 1); PG8_STAGE(PG8_SB(0, 0), b2, voffB);
            PG8_BAR; PG8_WAIT_L(0); PG8_MMA(0, 1, At, B1); PG8_BAR;
            PG8_LDA(At, 0, 1); PG8_STAGE(PG8_SA(0, 0), a2, voffA);
            PG8_BAR; PG8_WAIT_L(0); PG8_MMA(1, 0, At, B0); PG8_BAR; PG8_SCHED;
            PG8_STAGE(PG8_SB(0, 1), b2 + hstep, voffB);
            PG8_WAIT_V(6); PG8_BAR; PG8_MMA(1, 1, At, B1); PG8_BAR;
            PG8_LDB(B0, 1, 0); PG8_SCHED; PG8_LDA(At, 1, 0); PG8_STAGE(PG8_SA(0, 1), a2 + hstep, voffA);
            PG8_WAIT_L(8); PG8_BAR; PG8_WAIT_L(0); PG8_MMA(0, 0, At, B0); PG8_BAR; PG8_SCHED;
            PG8_LDB(B1, 1, 1); PG8_STAGE(PG8_SB(1, 0), b3, voffB);
            PG8_BAR; PG8_WAIT_L(0); PG8_MMA(0, 1, At, B1); PG8_BAR;
            PG8_LDA(At, 1, 1); PG8_STAGE(PG8_SA(1, 0), a3, voffA);
            PG8_BAR; PG8_WAIT_L(0); PG8_MMA(1, 0, At, B0); PG8_BAR; PG8_SCHED;
            PG8_STAGE(PG8_SB(1, 1), b3 + hstep, voffB);
            PG8_WAIT_V(6); PG8_BAR; PG8_MMA(1, 1, At, B1); PG8_BAR;
            }
        }
        if constexpr (ALIGN_EPI) { if (wr == 0) PG8_BAR; }
        if constexpr (!Epi::AFTER_DRAIN) { E(acc, cur, wr, wc, fr, fq); S.done(cur); }
        if (!has_next) break;
#pragma unroll
        for (int a = 0; a < 2; ++a)
#pragma unroll
            for (int b = 0; b < 2; ++b)
#pragma unroll
                for (int m = 0; m < 4; ++m)
#pragma unroll
                    for (int n = 0; n < 2; ++n) acc[a][b][m][n] = (f32x4){0.f, 0.f, 0.f, 0.f};
        cur = nxt; cA = nA; cB = nB; ++ui;
        if constexpr (ALIGN_EPI) { if (wr == 1) PG8_BAR; }
    }
    PG8_WAIT_V(0);
    if constexpr (!ALIGN_EPI) { if (wr == 0) PG8_BAR; }
    PG8_BAR;
    if constexpr (Epi::AFTER_DRAIN) { E.fused(acc, cur, wr, wc, fr, fq, lds, wid, lane); S.done(cur); }
#undef PG8_SA
#undef PG8_SB
#undef PG8_STAGE
#undef PG8_LDA
#undef PG8_LDB
#undef PG8_MMA
#undef PG8_WAIT_V
#undef PG8_WAIT_L
#undef PG8_BAR
#undef PG8_SCHED
}
}

namespace att {
#define ALAS __attribute__((address_space(3)))
typedef unsigned short bf16_t;
typedef short bf16x8 __attribute__((ext_vector_type(8)));
typedef short s16x4 __attribute__((ext_vector_type(4)));
typedef short v4i16_t __attribute__((ext_vector_type(4)));
typedef float f32x16 __attribute__((ext_vector_type(16)));
typedef float f32x4 __attribute__((ext_vector_type(4)));
typedef unsigned u32x4 __attribute__((ext_vector_type(4)));
constexpr int SEQ = 8192, PITCH = 1024;
constexpr int KBYTES = 8192, VBYTES = 16384, BUFB = KBYTES + VBYTES, WSF_OFF = 2 * BUFB, STG_OFF = WSF_OFF + 8 * 64 * 4, LDS_BYTES = STG_OFF + 8 * 8192;
__device__ __forceinline__ int crow(int r, int hi) { return (r & 3) + 8 * (r >> 2) + 4 * hi; }
__device__ __forceinline__ unsigned f2bf(float f) { unsigned u = __builtin_bit_cast(unsigned, f); return (u + 0x7fffu + ((u >> 16) & 1u)) >> 16; }
__device__ __forceinline__ s16x4 vtr(const ALAS unsigned char* p) { return __builtin_bit_cast(s16x4, __builtin_amdgcn_ds_read_tr16_b64_v4i16((ALAS v4i16_t*)p)); }
__device__ __forceinline__ float swapsum(float v) { auto rr = __builtin_amdgcn_permlane32_swap(__float_as_uint(v), __float_as_uint(v), false, false); return __uint_as_float(rr[0]) + __uint_as_float(rr[1]); }
__device__ __forceinline__ float swapmax(float v) { auto rr = __builtin_amdgcn_permlane32_swap(__float_as_uint(v), __float_as_uint(v), false, false); return fmaxf(__uint_as_float(rr[0]), __uint_as_float(rr[1])); }
#define ATT_GLDS(g, l) __builtin_amdgcn_global_load_lds((const unsigned*)(g), (ALAS unsigned*)(l), 16, 0, 0)
#define ATT_LWAIT() asm volatile("s_waitcnt lgkmcnt(0)" ::: "memory")

__device__ __forceinline__ void attn_unit(int b, int h, int qb, const bf16_t* Q, const bf16_t* K, const bf16_t* V, bf16_t* O, float* scr, ALAS unsigned char* shm, float lam, float outscale, const float* subg) {
    int tid_l = threadIdx.x; asm volatile("" : "+v"(tid_l));
    const int tid = tid_l, lane = tid & 63, r32 = lane & 31, hi = lane >> 5; const int wid = __builtin_amdgcn_readfirstlane(tid >> 6);
    const size_t rowbase = (size_t)b * SEQ; const int q0 = qb * 256;
    const int NT = 4 * qb + 4, cw = 4 * qb + (wid >> 1);
    const unsigned shm0 = (unsigned)(uintptr_t)shm;
    ALAS float* wsf = (ALAS float*)(shm + WSF_OFF) + wid * 64;
    float* myscr = scr + ((((rowbase + q0) >> 5) + wid) * 8 + h) * 4096;
    f32x16 o[4];
    for (int m = 0; m < 2; ++m) {
        const bf16_t* Qw = Q + (rowbase + q0 + wid * 32) * PITCH + h * 128 + m * 64;
        const bf16_t* ksrc = K + rowbase * PITCH + h * 128 + m * 64 + wid * 8;
        const bf16_t* vsrc = V + (rowbase + 16 * (wid & 3)) * PITCH + h * 128 + (wid >> 2) * 32;
        const unsigned koff = (unsigned)lane * (PITCH * 2), voff = (unsigned)(lane >> 2) * (PITCH * 2) + (unsigned)(lane & 3) * 16u;
        bf16x8 qr[4];
#pragma unroll
        for (int d0 = 0; d0 < 4; ++d0) qr[d0] = *(const bf16x8*)(Qw + (size_t)r32 * PITCH + d0 * 16 + hi * 8);
        float mhat = -1e30f, l = 0.f;
#pragma unroll
        for (int d0 = 0; d0 < 4; ++d0)
#pragma unroll
            for (int r = 0; r < 16; ++r) o[d0][r] = 0.f;
#define ATT_DMA(t, bufoff) do { const size_t go_ = (size_t)(t) * 64 * PITCH; pg8::glds_s(ksrc + go_, koff, shm0 + (unsigned)(bufoff) + (unsigned)wid * 1024u); \
            pg8::glds_s(vsrc + go_, voff, shm0 + (unsigned)(bufoff) + KBYTES + (unsigned)wid * 1024u); pg8::glds_s(vsrc + go_ + 64, voff, shm0 + (unsigned)(bufoff) + KBYTES + (unsigned)(wid + 8) * 1024u); } while (0)
        ATT_DMA(0, 0);
        for (int j = 0; j < NT; ++j) {
            asm volatile("s_waitcnt vmcnt(0)" ::: "memory");
            __syncthreads();
            const int bo = (j & 1) * BUFB;
            if (j + 1 < NT) ATT_DMA(j + 1, BUFB - bo);
            if (j <= cw) {
                const ALAS unsigned char* kb = shm + bo + hi * 1024 + r32 * 16;
                f32x16 p0, p1;
#pragma unroll
                for (int r = 0; r < 16; ++r) { p0[r] = 0.f; p1[r] = 0.f; }
#pragma unroll
                for (int d0 = 0; d0 < 4; ++d0) {
                    const bf16x8 b0 = *(const ALAS bf16x8*)(kb + d0 * 2048), b1 = *(const ALAS bf16x8*)(kb + d0 * 2048 + 512);
                    p0 = __builtin_amdgcn_mfma_f32_32x32x16_bf16(b0, qr[d0], p0, 0, 0, 0);
                    p1 = __builtin_amdgcn_mfma_f32_32x32x16_bf16(b1, qr[d0], p1, 0, 0, 0);
                }
                float rm = fmaxf(p0[0], p1[0]);
#pragma unroll
                for (int r = 1; r < 16; ++r) rm = fmaxf(rm, fmaxf(p0[r], p1[r]));
                rm = swapmax(rm);
                if (__any(rm > mhat + 8.0f)) {
                    const float mnew = fmaxf(mhat, rm), f = __builtin_amdgcn_exp2f(mhat - mnew); mhat = mnew; l *= f;
                    ATT_LWAIT();
                    if (hi == 0) wsf[r32] = f;
                    ATT_LWAIT();
#pragma unroll
                    for (int r = 0; r < 16; ++r) { const float fr_ = wsf[crow(r, hi)];
#pragma unroll
                        for (int d0 = 0; d0 < 4; ++d0) o[d0][r] *= fr_; }
                    ATT_LWAIT();
                }
                float sacc = 0.f;
#pragma unroll
                for (int r = 0; r < 16; ++r) { p0[r] = __builtin_amdgcn_exp2f(p0[r] - mhat); p1[r] = __builtin_amdgcn_exp2f(p1[r] - mhat); sacc += p0[r] + p1[r]; }
                l += sacc;
                bf16x8 pw[4];
#pragma unroll
                for (int ks = 0; ks < 4; ++ks) { u32x4 w;
#pragma unroll
                    for (int i = 0; i < 4; ++i) { const int r = 8 * (ks & 1) + 2 * i; const float a = (ks < 2) ? p0[r] : p1[r], c = (ks < 2) ? p0[r + 1] : p1[r + 1]; w[i] = pg8::cvt_pk_bf16(a, c); }
                    pw[ks] = __builtin_bit_cast(bf16x8, w); }
                const ALAS unsigned char* vp = shm + bo + KBYTES + ((lane >> 4) & 1) * 32 + (lane & 3) * 8 + (4 * hi + ((lane & 15) >> 2)) * 64;
#pragma unroll
                for (int d0 = 0; d0 < 4; ++d0)
#pragma unroll
                    for (int ks = 0; ks < 4; ++ks) {
                        const s16x4 lo = vtr(vp + d0 * 4096 + ks * 1024), hh = vtr(vp + d0 * 4096 + ks * 1024 + 512);
                        const bf16x8 vf = (bf16x8){lo[0], lo[1], lo[2], lo[3], hh[0], hh[1], hh[2], hh[3]};
                        o[d0] = __builtin_amdgcn_mfma_f32_32x32x16_bf16(pw[ks], vf, o[d0], 0, 0, 0);
                    }
            }
        }
#undef ATT_DMA
        const float lt = swapsum(l);
        ATT_LWAIT();
        if (hi == 0) wsf[32 + r32] = 1.0f / lt;
        ATT_LWAIT();
        float rli[16];
#pragma unroll
        for (int r = 0; r < 16; ++r) rli[r] = wsf[32 + crow(r, hi)];
        ATT_LWAIT();
        float* sp = myscr + lane * 4; asm volatile("" : "+v"(sp));
        if (m == 0) {
#pragma unroll
            for (int d0 = 0; d0 < 4; ++d0) {
#pragma unroll
                for (int r4 = 0; r4 < 4; ++r4) { f32x4 v;
#pragma unroll
                    for (int i = 0; i < 4; ++i) v[i] = o[d0][4 * r4 + i] * rli[4 * r4 + i];
                    *(f32x4*)(sp + (d0 * 4 + r4) * 256) = v; }
                asm volatile("" ::: "memory"); }
        } else {
            float ss[16];
#pragma unroll
            for (int r = 0; r < 16; ++r) ss[r] = 0.f;
#pragma unroll
            for (int d0 = 0; d0 < 4; ++d0) {
#pragma unroll
                for (int r4 = 0; r4 < 4; ++r4) { const f32x4 v0 = *(const f32x4*)(sp + (d0 * 4 + r4) * 256);
#pragma unroll
                    for (int i = 0; i < 4; ++i) { const int r = 4 * r4 + i; const float v = v0[i] - lam * (o[d0][r] * rli[r]); o[d0][r] = v; ss[r] += v * v; } }
                asm volatile("" ::: "memory"); }
#pragma unroll
            for (int r = 0; r < 16; ++r) {
#pragma unroll
                for (int k = 1; k < 32; k <<= 1) ss[r] += __shfl_xor(ss[r], k);
                ss[r] = __builtin_amdgcn_rsqf(ss[r] * (1.0f / 128.0f) + 1e-5f) * outscale;
            }
            ALAS unsigned char* stw = shm + STG_OFF + wid * 8192;
            ALAS unsigned short* stg = (ALAS unsigned short*)stw + (4 * hi) * 128 + r32;
#pragma unroll
            for (int d0 = 0; d0 < 4; ++d0) { const float gg = subg[32 * d0 + r32];
#pragma unroll
                for (int r = 0; r < 16; ++r) stg[((r & 3) + 8 * (r >> 2)) * 128 + 32 * d0] = (unsigned short)f2bf(o[d0][r] * ss[r] * gg); }
            ATT_LWAIT();
            bf16_t* Ow = O + (rowbase + q0 + wid * 32 + (lane >> 4)) * PITCH + h * 128 + (lane & 15) * 8; asm volatile("" : "+v"(Ow));
#pragma unroll
            for (int i = 0; i < 8; ++i) { const u32x4 v = *(const ALAS u32x4*)(stw + i * 1024 + lane * 16); *(u32x4*)(Ow + (size_t)i * 4 * PITCH) = v; }
            ATT_LWAIT();
        }
    }
}
}

#ifndef PHMASK
#define PHMASK 0xFFFF
#endif
constexpr int NWAVES = 8;
constexpr int M = 32768, D = 1024, FF = 2816, SEQ = 8192;
constexpr float LN_EPS = 1e-5f;
constexpr float ALPHA = 1.4142135623730951f;
constexpr size_t MiB = 1u << 20;
constexpr size_t WS_BAR = 0;
constexpr size_t WS_ST = 1 * MiB;
constexpr size_t WS_TAB = 2 * MiB;
constexpr size_t WS_WQKV = 4 * MiB, WS_WO = 10 * MiB, WS_PW1 = 12 * MiB, WS_PW2 = 16 * MiB, WS_GU0 = 18 * MiB, WS_GU1 = 29 * MiB, WS_DN0 = 40 * MiB, WS_DN1 = 46 * MiB;
constexpr size_t WS_XN = 64 * MiB;
constexpr size_t WS_Q = 128 * MiB, WS_K = 192 * MiB, WS_V = 256 * MiB;
constexpr size_t WS_H = 128 * MiB;
constexpr size_t WS_G = 128 * MiB, WS_C = 192 * MiB;
constexpr size_t WS_Z = 320 * MiB;
constexpr size_t WS_END = 448 * MiB;
constexpr int LDS_BYTES = 147456;

#define LAS __attribute__((address_space(3)))
typedef unsigned short bf16;
typedef unsigned v4u __attribute__((ext_vector_type(4)));
typedef unsigned v2u __attribute__((ext_vector_type(2)));
typedef float f32x4 __attribute__((ext_vector_type(4)));
#define LDS_WAIT() asm volatile("s_waitcnt lgkmcnt(0)" ::: "memory")
__device__ __forceinline__ unsigned f2bf(float f) { unsigned u = __builtin_bit_cast(unsigned, f); return (u + 0x7fffu + ((u >> 16) & 1u)) >> 16; }
__device__ __forceinline__ unsigned pk2(float lo, float hi) { return f2bf(lo) | (f2bf(hi) << 16); }
__device__ __forceinline__ float wave_sum(float v) {
#pragma unroll
    for (int o = 1; o < 64; o <<= 1) v += __shfl_xor(v, o);
    return v;
}
__device__ __forceinline__ int map_row(int mode, int n) {
    if (mode == 1) {
        if (n >= 2048) return n;
        const int region = n >> 10, within = n & 1023, slice = within >> 6, d = within & 63;
        return 256 * (region * 4 + (slice >> 2)) + 128 * (d >> 5) + 32 * (slice & 3) + (d & 31);
    }
    if (mode == 2) { const int half = n >> 10, j = n & 1023; return 256 * (j >> 7) + 128 * half + (j & 127); }
    if (mode == 3) return 256 * (n >> 7) + (n & 127);
    if (mode == 4) return 256 * (n >> 7) + 128 + (n & 127);
    return n;
}
__device__ __forceinline__ void transpose_item(const float* W, int K, int N, bf16* WT, int mode, LAS float* scr, int item, int lane) {
    const int nblk = N / 32, kb = item / nblk, nb = item % nblk, k0 = 64 * kb, n0 = 32 * nb;
#pragma unroll 8
    for (int i = 0; i < 32; ++i) { const int kk = 2 * i + (lane >> 5); scr[kk * 33 + (lane & 31)] = W[(size_t)(k0 + kk) * N + n0 + (lane & 31)]; }
    LDS_WAIT(); asm volatile("" ::: "memory");
    const int c = lane & 7;
#pragma unroll
    for (int j = 0; j < 4; ++j) { const int n = (lane >> 3) + 8 * j; const LAS float* s = scr + (8 * c) * 33 + n;
        v4u o; o.x = pk2(s[0 * 33], s[1 * 33]); o.y = pk2(s[2 * 33], s[3 * 33]); o.z = pk2(s[4 * 33], s[5 * 33]); o.w = pk2(s[6 * 33], s[7 * 33]);
        *(v4u*)(WT + (size_t)map_row(mode, n0 + n) * K + k0 + 8 * c) = o; }
    LDS_WAIT(); asm volatile("" ::: "memory");
}

#define XB_TMO      128
#define XB_XCNT(j)  (256  + 64 * (j))
#define XB_XSUB(j)  (1280 + 64 * (j))
#define XB_XGEN(j)  (2304 + 64 * (j))
#define XB_TOP      3328
#define XB_TOPGEN   3392
#define XCD_BAR_WORDS 3456
#define XB_SPIN_CAP (1u << 18)

__device__ __forceinline__ unsigned xb_ld(unsigned* p)              { return __hip_atomic_load(p, __ATOMIC_RELAXED, __HIP_MEMORY_SCOPE_AGENT); }
__device__ __forceinline__ unsigned xb_add(unsigned* p, unsigned v) { return __hip_atomic_fetch_add(p, v, __ATOMIC_RELAXED, __HIP_MEMORY_SCOPE_AGENT); }
__device__ __forceinline__ unsigned xb_xcc_id() { return (unsigned)__builtin_amdgcn_s_getreg((3 << 11) | 20) & 0xFu; }
#define XB_SPIN(cond, bar) do { unsigned _sp = 0; while (cond) { __builtin_amdgcn_s_sleep(1); \
    if ((++_sp & 255u) == 0u) { if (xb_ld(&(bar)[XB_TMO])) break; if (_sp > XB_SPIN_CAP) { atomicAdd(&(bar)[XB_TMO], 1u); break; } } } } while (0)

struct XcdBarrier {
    unsigned* bar; unsigned x;
    volatile LAS unsigned* st;
};

__device__ __forceinline__ XcdBarrier xcd_barrier_post(unsigned* bar, volatile LAS unsigned* st) {
    XcdBarrier b; b.bar = bar; b.x = xb_xcc_id(); b.st = st;
    if (threadIdx.x == 0) (void)xb_add(&bar[XB_XCNT(b.x)], 1u);
    return b;
}
__device__ __forceinline__ void xcd_barrier_complete(unsigned* bar, unsigned x, unsigned& nloc, unsigned& nx) {
    const unsigned G = gridDim.x * gridDim.y * gridDim.z;
    unsigned sum, cnt, mine, sp = 0u;
    for (;;) {
        sum = 0u; cnt = 0u; mine = 0u;
#pragma unroll
        for (unsigned j = 0; j < 16; ++j) { const unsigned c = xb_ld(&bar[XB_XCNT(j)]); sum += c; cnt += (c > 0u) ? 1u : 0u; mine = (j == x) ? c : mine; }
        if (sum == G) break;
        __builtin_amdgcn_s_sleep(1);
        if ((++sp & 255u) == 0u) { if (xb_ld(&bar[XB_TMO])) break; if (sp > XB_SPIN_CAP) { atomicAdd(&bar[XB_TMO], 1u); break; } }
    }
    nloc = mine > 0u ? mine : 1u; nx = cnt > 0u ? cnt : 1u;
}

__device__ __forceinline__ void xcd_barrier(const XcdBarrier& b) {
    asm volatile("s_waitcnt vmcnt(0)" ::: "memory");
    __syncthreads();
    if (threadIdx.x == 0) {
        unsigned* bar = b.bar;
        __builtin_amdgcn_s_waitcnt(0);
        unsigned nloc = b.st[0], nx = b.st[1];
        if (nloc == 0u) { xcd_barrier_complete(bar, b.x, nloc, nx); b.st[0] = nloc; b.st[1] = nx; }
        const unsigned old = xb_add(&bar[XB_XSUB(b.x)], 1u);
        const unsigned gen = old / nloc;
        if (old + 1u == (gen + 1u) * nloc) {
            __builtin_amdgcn_fence(__ATOMIC_RELEASE, "agent");
            asm volatile("s_waitcnt vmcnt(0)" ::: "memory");
            const unsigned og = xb_add(&bar[XB_TOP], 1u);
            const unsigned tg = og / nx;
            if (og + 1u == (tg + 1u) * nx) xb_add(&bar[XB_TOPGEN], 1u);
            else XB_SPIN(xb_ld(&bar[XB_TOPGEN]) == tg, bar);
            __builtin_amdgcn_fence(__ATOMIC_ACQUIRE, "agent");
            xb_add(&bar[XB_XGEN(b.x)], 1u);
            asm volatile("s_waitcnt vmcnt(0)" ::: "memory");
        } else {
            XB_SPIN(xb_ld(&bar[XB_XGEN(b.x)]) == gen, bar);
            __builtin_amdgcn_fence(__ATOMIC_ACQUIRE, "agent");
            asm volatile("s_waitcnt vmcnt(0)" ::: "memory");
        }
    }
    __syncthreads();
}

struct Args { const float* in[21]; float* out; unsigned char* ws; };

__device__ __forceinline__ void ln_phase(const float* Z, bf16* XN, float* ST, const float* g, const float* b, float* OUT, int gw, int NGW, int lane) {
    asm volatile("" : "+v"(lane));
    f32x4 gv[4], bv[4];
#pragma unroll
    for (int j = 0; j < 4; ++j) { gv[j] = *((const f32x4*)g + lane + 64 * j); bv[j] = *((const f32x4*)b + lane + 64 * j); }
    for (int row = gw; row < M; row += NGW) {
        const f32x4* zr = (const f32x4*)(Z + (size_t)row * D) + lane;
        f32x4 v[4]; float s = 0.f;
#pragma unroll
        for (int j = 0; j < 4; ++j) { v[j] = zr[64 * j]; s += (v[j].x + v[j].y) + (v[j].z + v[j].w); }
        const float mean = wave_sum(s) * (1.f / D); float s2 = 0.f;
#pragma unroll
        for (int j = 0; j < 4; ++j) { v[j] = v[j] - mean; s2 += (v[j].x * v[j].x + v[j].y * v[j].y) + (v[j].z * v[j].z + v[j].w * v[j].w); }
        const float rstd = 1.f / sqrtf(wave_sum(s2) * (1.f / D) + LN_EPS);
        if (OUT) {
            f32x4* orow = (f32x4*)(OUT + (size_t)row * D) + lane;
#pragma unroll
            for (int j = 0; j < 4; ++j) orow[64 * j] = v[j] * rstd * gv[j] + bv[j];
        } else {
            if (lane == 0) { ST[2 * row] = mean; ST[2 * row + 1] = rstd; }
            v2u* o8 = (v2u*)(XN + (size_t)row * D) + lane;
#pragma unroll
            for (int j = 0; j < 4; ++j) { const f32x4 y = v[j] * rstd * gv[j] + bv[j]; v2u w; w.x = pk2(y.x, y.y); w.y = pk2(y.z, y.w); o8[64 * j] = w; }
        }
    }
}

__global__ void __launch_bounds__(NWAVES * 64, 2) fwd_kernel(Args args) {
    extern __shared__ __attribute__((aligned(16))) unsigned char lds[];
    cg::grid_group grid = cg::this_grid();
    LAS unsigned char* L = (LAS unsigned char*)lds;
    const int tid = threadIdx.x, lane = tid & 63, wave = __builtin_amdgcn_readfirstlane(tid >> 6);
    const int G = gridDim.x, bx = blockIdx.x;
    const int vcu = (G % 8 == 0) ? (bx % 8) * (G / 8) + bx / 8 : bx;
    const int gw = vcu * NWAVES + wave, NGW = G * NWAVES;
    unsigned char* ws = args.ws;
    const float* x = args.in[0];
    const float *w_qkv = args.in[1], *w_o = args.in[2], *lq1 = args.in[3], *lk1 = args.in[4], *lq2 = args.in[5], *lk2 = args.in[6], *subln_g = args.in[7];
    const float *w_pw1 = args.in[8], *b_pw1 = args.in[9], *w_dw = args.in[10], *b_dw = args.in[11], *cln_g = args.in[12], *cln_b = args.in[13], *w_pw2 = args.in[14], *b_pw2 = args.in[15];
    const float *w_gate = args.in[16], *w_up = args.in[17], *w_down = args.in[18], *ln_g = args.in[19], *ln_b = args.in[20];
    float* ST = (float*)(ws + WS_ST); float* TAB = (float*)(ws + WS_TAB);
    bf16 *Wqkv_t = (bf16*)(ws + WS_WQKV), *Wo_t = (bf16*)(ws + WS_WO), *Wpw1_t = (bf16*)(ws + WS_PW1), *Wpw2_t = (bf16*)(ws + WS_PW2);
    bf16 *Wgu0 = (bf16*)(ws + WS_GU0), *Wgu1 = (bf16*)(ws + WS_GU1), *Wdn0 = (bf16*)(ws + WS_DN0), *Wdn1 = (bf16*)(ws + WS_DN1);
    bf16 *XN = (bf16*)(ws + WS_XN), *QB = (bf16*)(ws + WS_Q), *KB = (bf16*)(ws + WS_K), *VB = (bf16*)(ws + WS_V), *HB = (bf16*)(ws + WS_H), *GB = (bf16*)(ws + WS_G), *CB = (bf16*)(ws + WS_C);
    float* Z = (float*)(ws + WS_Z);

    volatile LAS unsigned* xbst = (volatile LAS unsigned*)(L + LDS_BYTES - 64);
    if (tid < 2) xbst[tid] = 0u;
    if (bx == 0) for (int u = tid; u < XCD_BAR_WORDS; u += NWAVES * 64) __hip_atomic_store((unsigned*)(ws + WS_BAR) + u, 0u, __ATOMIC_RELAXED, __HIP_MEMORY_SCOPE_AGENT);
    __syncthreads();
    {
        LAS float* scr = (LAS float*)(L + wave * 16384);
        constexpr int I_QKV = 16 * 96, I_O = 16 * 32, I_PW1 = 16 * 64, I_PW2 = 16 * 32, I_GU = 16 * 88, I_DN = 44 * 32;
        constexpr int NITEMS = I_QKV + I_O + I_PW1 + I_PW2 + 4 * I_GU + 2 * I_DN;
        for (int it = gw; it < NITEMS; it += NGW) {
            int r = it;
            if (r < I_QKV) { transpose_item(w_qkv, D, 3 * D, Wqkv_t, 1, scr, r, lane); continue; } r -= I_QKV;
            if (r < I_O) { transpose_item(w_o, D, D, Wo_t, 0, scr, r, lane); continue; } r -= I_O;
            if (r < I_PW1) { transpose_item(w_pw1, D, 2 * D, Wpw1_t, 2, scr, r, lane); continue; } r -= I_PW1;
            if (r < I_PW2) { transpose_item(w_pw2, D, D, Wpw2_t, 0, scr, r, lane); continue; } r -= I_PW2;
            if (r < I_GU) { transpose_item(w_gate, D, FF, Wgu0, 3, scr, r, lane); continue; } r -= I_GU;
            if (r < I_GU) { transpose_item(w_up, D, FF, Wgu0, 4, scr, r, lane); continue; } r -= I_GU;
            if (r < I_GU) { transpose_item(w_gate + (size_t)D * FF, D, FF, Wgu1, 3, scr, r, lane); continue; } r -= I_GU;
            if (r < I_GU) { transpose_item(w_up + (size_t)D * FF, D, FF, Wgu1, 4, scr, r, lane); continue; } r -= I_GU;
            if (r < I_DN) { transpose_item(w_down, FF, D, Wdn0, 0, scr, r, lane); continue; } r -= I_DN;
            transpose_item(w_down + (size_t)FF * D, FF, D, Wdn1, 0, scr, r, lane);
        }
        for (int row = gw; row < M; row += NGW) {
            const f32x4* xr = (const f32x4*)(x + (size_t)row * D) + lane; v2u* o8 = (v2u*)(XN + (size_t)row * D) + lane;
#pragma unroll
            for (int j = 0; j < 4; ++j) { const f32x4 y = xr[64 * j]; v2u w; w.x = pk2(y.x, y.y); w.y = pk2(y.z, y.w); o8[64 * j] = w; }
        }
        for (int e = bx * (NWAVES * 64) + tid; e < SEQ * 32; e += G * NWAVES * 64) {
            const int pos = e >> 5, i = e & 31, i8 = i & 7, i3 = i >> 3;
            double c = (i8 == 0) ? 1.0 : (i8 == 1) ? 0.7498942093324559 : (i8 == 2) ? 0.5623413251903491 : (i8 == 3) ? 0.4216965034285822 : (i8 == 4) ? 0.31622776601683794 : (i8 == 5) ? 0.23713737056616552 : (i8 == 6) ? 0.1778279410038923 : 0.1333521432163324;
            c *= (i3 == 0) ? 1.0 : (i3 == 1) ? 0.1 : (i3 == 2) ? 0.01 : 0.001;
            const double rev = (double)pos * c * 0.15915494309189535;
            const float fr = (float)(rev - __builtin_floor(rev));
            TAB[pos * 64 + i] = __builtin_amdgcn_cosf(fr); TAB[pos * 64 + 32 + i] = __builtin_amdgcn_sinf(fr);
        }
    }
    grid.sync();
    const XcdBarrier xbar = xcd_barrier_post((unsigned*)(ws + WS_BAR), xbst);

    if (PHMASK & (1 << 1)) {
        pg8::Gemm g{XN, Wqkv_t, M, 3 * D, D}; pg8::StaticOrder S; S.init(M, 3 * D, G, bx);
        pg8::EpiQKV E{QB, KB, VB, TAB, 0.125f * 1.4426950408889634f};
        pg8::gemm_phase<pg8::EpiQKV, pg8::StaticOrder, true, true>(L, g, S, E);
    }
    xcd_barrier(xbar);

    if (PHMASK & (1 << 2)) {
        const float d1 = wave_sum(lq1[lane] * lk1[lane]), d2 = wave_sum(lq2[lane] * lk2[lane]);
        const float lam = __expf(d1) - __expf(d2) + 0.2f;
        for (int idx = vcu; idx < 1024; idx += G) {
            const int v = idx & 255, i = idx >> 8, bh = v >> 3, s = v & 7;
            const int qb = (i == 0) ? 31 - s : (i == 1) ? 16 + s : (i == 2) ? 15 - s : s;
            att::attn_unit(bh >> 3, bh & 7, qb, QB, KB, VB, XN, Z, L, lam, 0.8f, subln_g);
        }
    }
    xcd_barrier(xbar);

    if (PHMASK & (1 << 3)) {
        pg8::Gemm g{XN, Wo_t, M, D, D}; pg8::StaticOrder S; S.init(M, D, G, bx);
        pg8::EpiResid<0> E{x, Z, nullptr, nullptr, nullptr, nullptr, ALPHA};
        pg8::gemm_phase<pg8::EpiResid<0>, pg8::StaticOrder, true, true>(L, g, S, E);
    }
    xcd_barrier(xbar);
    ln_phase(Z, XN, ST, ln_g, ln_b, nullptr, gw, NGW, lane);
    xcd_barrier(xbar);

    for (int layer = 0; layer < 2; ++layer) {
        if (layer == 1) {
            if (PHMASK & (1 << 8)) {
                pg8::Gemm g{XN, Wpw1_t, M, 2 * D, D}; pg8::StaticOrder S; S.init(M, 2 * D, G, bx);
                pg8::EpiGLU E{GB, b_pw1};
                pg8::gemm_phase<pg8::EpiGLU, pg8::StaticOrder, true, true>(L, g, S, E);
            }
            xcd_barrier(xbar);
            if (PHMASK & (1 << 9)) {
                int ctid = threadIdx.x; asm volatile("" : "+v"(ctid));
                const int clane = ctid & 63, cwave = __builtin_amdgcn_readfirstlane(ctid >> 6);
                LAS unsigned* tile = (LAS unsigned*)L;
                LAS float* red = (LAS float*)(L + 126976);
                LAS float* stat = red + 512;
                float w0[31], w1[31];
#pragma unroll
                for (int t = 0; t < 31; ++t) { w0[t] = w_dw[t * D + 2 * ctid]; w1[t] = w_dw[t * D + 2 * ctid + 1]; }
                const float bd0 = b_dw[2 * ctid], bd1 = b_dw[2 * ctid + 1], g0 = cln_g[2 * ctid], g1 = cln_g[2 * ctid + 1], bb0 = cln_b[2 * ctid], bb1 = cln_b[2 * ctid + 1];
                for (int unit = vcu; unit < M / 32; unit += G) {
                    const int row0 = unit * 32, s0 = row0 & (SEQ - 1);
                    __syncthreads();
                    for (int p = ctid; p < 62 * 128; p += NWAVES * 64) { const int rr = p >> 7, ch = p & 127;
                        v4u v = (v4u){0u, 0u, 0u, 0u}; if (s0 - 30 + rr >= 0) v = *(const v4u*)(GB + (size_t)(row0 - 30 + rr) * D + ch * 8);
                        *(LAS v4u*)(L + rr * 2048 + ch * 16) = v; }
                    __syncthreads();
#pragma unroll 1
                    for (int r = 0; r < 32; ++r) {
                        float y0 = bd0, y1 = bd1; const LAS unsigned* tp = tile + r * 512 + ctid;
#pragma unroll
                        for (int t = 0; t < 31; ++t) { const unsigned u = tp[t * 512]; y0 += w0[t] * __uint_as_float(u << 16); y1 += w1[t] * __uint_as_float(u & 0xffff0000u); }
                        const float s = wave_sum(y0 + y1), q = wave_sum(y0 * y0 + y1 * y1);
                        if (clane == 0) { red[(cwave * 32 + r) * 2] = s; red[(cwave * 32 + r) * 2 + 1] = q; }
                    }
                    __syncthreads();
                    if (ctid < 32) { float s = 0.f, q = 0.f;
#pragma unroll
                        for (int w = 0; w < 8; ++w) { s += red[(w * 32 + ctid) * 2]; q += red[(w * 32 + ctid) * 2 + 1]; }
                        const float mean = s * (1.f / D), var = q * (1.f / D) - mean * mean;
                        stat[2 * ctid] = mean; stat[2 * ctid + 1] = 1.f / sqrtf(fmaxf(var, 0.f) + LN_EPS); }
                    __syncthreads();
#pragma unroll 1
                    for (int r = 0; r < 32; ++r) {
                        float y0 = bd0, y1 = bd1; const LAS unsigned* tp = tile + r * 512 + ctid;
#pragma unroll
                        for (int t = 0; t < 31; ++t) { const unsigned u = tp[t * 512]; y0 += w0[t] * __uint_as_float(u << 16); y1 += w1[t] * __uint_as_float(u & 0xffff0000u); }
                        const float mean = stat[2 * r], rstd = stat[2 * r + 1];
                        float n0 = (y0 - mean) * rstd * g0 + bb0, n1 = (y1 - mean) * rstd * g1 + bb1;
                        n0 = n0 * __builtin_amdgcn_rcpf(1.0f + __builtin_amdgcn_exp2f(n0 * -1.4426950408889634f));
                        n1 = n1 * __builtin_amdgcn_rcpf(1.0f + __builtin_amdgcn_exp2f(n1 * -1.4426950408889634f));
                        *(unsigned*)(CB + (size_t)(row0 + r) * D + 2 * ctid) = pk2(n0, n1);
                    }
                }
                __syncthreads();
            }
            xcd_barrier(xbar);
            if (PHMASK & (1 << 10)) {
                pg8::Gemm g{CB, Wpw2_t, M, D, D}; pg8::StaticOrder S; S.init(M, D, G, bx);
                pg8::EpiResid<1> E{Z, Z, ST, ln_g + 1 * D, ln_b + 1 * D, b_pw2, ALPHA};
                pg8::gemm_phase<pg8::EpiResid<1>, pg8::StaticOrder, true, true>(L, g, S, E);
            }
            xcd_barrier(xbar);
            ln_phase(Z, XN, ST, ln_g + 2 * D, ln_b + 2 * D, nullptr, gw, NGW, lane);
            xcd_barrier(xbar);
        }
        if (PHMASK & (1 << 5)) {
            pg8::Gemm g{XN, layer ? Wgu1 : Wgu0, M, 2 * FF, D}; pg8::StaticOrder S; S.init(M, 2 * FF, G, bx);
            pg8::EpiSwiGLU E{HB, FF};
            pg8::gemm_phase<pg8::EpiSwiGLU, pg8::StaticOrder, true, true>(L, g, S, E);
        }
        xcd_barrier(xbar);
        if (PHMASK & (1 << 6)) {
            pg8::Gemm g{HB, layer ? Wdn1 : Wdn0, M, D, FF}; pg8::StaticOrder S; S.init(M, D, G, bx);
            pg8::EpiResid<1> E{Z, Z, ST, ln_g + (2 * layer) * D, ln_b + (2 * layer) * D, nullptr, ALPHA};
            pg8::gemm_phase<pg8::EpiResid<1>, pg8::StaticOrder, true, true>(L, g, S, E);
        }
        xcd_barrier(xbar);
        if (layer == 0) { ln_phase(Z, XN, ST, ln_g + 1 * D, ln_b + 1 * D, nullptr, gw, NGW, lane); xcd_barrier(xbar); }
        else ln_phase(Z, nullptr, ST, ln_g + 3 * D, ln_b + 3 * D, args.out, gw, NGW, lane);
    }
}

extern "C" void kernel_launch(void* const* d_in, const int* in_sizes, int n_in, void* d_out, int out_size, void* d_ws, size_t ws_size, hipStream_t stream) {
    static int grid = 0;
    if (grid == 0) {
        if (n_in != 21 || out_size != M * D || ws_size < WS_END) { fprintf(stderr, "kernel_launch: unexpected shapes (n_in %d out %d ws %zu)\n", n_in, out_size, ws_size); grid = -1; return; }
        int dev = 0, cus = 0, per_cu = 0;
        hipGetDevice(&dev); hipDeviceGetAttribute(&cus, hipDeviceAttributeMultiprocessorCount, dev);
        if (hipFuncSetAttribute((const void*)fwd_kernel, hipFuncAttributeMaxDynamicSharedMemorySize, LDS_BYTES) != hipSuccess) { fprintf(stderr, "kernel_launch: hipFuncSetAttribute failed\n"); grid = -1; return; }
        hipOccupancyMaxActiveBlocksPerMultiprocessor(&per_cu, (const void*)fwd_kernel, NWAVES * 64, LDS_BYTES);
        (void)hipGetLastError();
        grid = cus * (per_cu > 0 ? 1 : 1);
        if (grid > 256) grid = 256;
        grid &= ~7;
        fprintf(stderr, "kernel_launch: cus %d per_cu %d grid %d\n", cus, per_cu, grid);
    }
    if (grid <= 0) return;
    Args a{};
    for (int i = 0; i < 21; ++i) a.in[i] = (const float*)d_in[i];
    a.out = (float*)d_out; a.ws = (unsigned char*)d_ws;
    void* kargs[] = {&a};
    hipError_t e = hipLaunchCooperativeKernel((const void*)fwd_kernel, dim3(grid), dim3(NWAVES * 64), kargs, LDS_BYTES, stream);
    if (e != hipSuccess) fprintf(stderr, "kernel_launch: cooperative launch failed: %s (grid %d)\n", hipGetErrorString(e), grid);
}
```

```cpp
#include <hip/hip_runtime.h>
#include <hip/hip_cooperative_groups.h>
#include <cstdio>
#include <cstdint>
namespace cg = cooperative_groups;
namespace pg8 {
#define PG8_LAS __attribute__((address_space(3)))
typedef unsigned short bf16_t;
typedef short bf16x8 __attribute__((ext_vector_type(8)));
typedef float f32x4 __attribute__((ext_vector_type(4)));
typedef unsigned u32x4 __attribute__((ext_vector_type(4)));
constexpr int BM = 256, BK = 64, HALF = 128, HTB = HALF * BK * 2  , STAGE_BYTES = 8 * HTB, NXCD = 8, WGM = 8;

__host__ __device__ __forceinline__ int lds_byte(int r, int c) { const int st = (r >> 4) * 2 + (c >> 5), rr = r & 15, cc = c & 31, ob = rr * 64 + cc * 2; return st * 1024 + (ob ^ (((ob >> 9) & 1) << 5)); }
__host__ __device__ __forceinline__ void stage_rc(int b, int& R, int& C) { const int st = b / 1024, sb = b % 1024, swz = sb ^ (((sb >> 9) & 1) << 5); R = (st >> 1) * 16 + swz / 64; C = (st & 1) * 32 + (swz % 64) / 2; }
__host__ __device__ __forceinline__ int perm32(int rho) { const int n = rho >> 4, i = rho & 15; return 8 * (i >> 2) + 4 * n + (i & 3); }

struct Unit { int pm, pn; };
struct Gemm { const bf16_t* A; const bf16_t* Bt; int M, N, K; };

struct StaticOrder {
    int nM, nN, nwg, G, c;
    __host__ __device__ void init(int M, int N, int G_, int c_) { nM = M / BM; nN = N / BM; nwg = nM * nN; G = G_; c = c_; }
    __host__ __device__ bool next(int i, Unit& u) const {
        const long L = (long)i * G + c; if (L >= nwg) return false;
        int wgid = (int)L; { const int q = nwg / NXCD, r = nwg % NXCD, xcd = wgid % NXCD, off = wgid / NXCD; wgid = (xcd < r ? xcd * (q + 1) : r * (q + 1) + (xcd - r) * q) + off; }
        const int nig = WGM * nN, gid = wgid / nig, fm = gid * WGM, gsz = (nM - fm) < WGM ? (nM - fm) : WGM;
        u.pm = fm + ((wgid % nig) % gsz); u.pn = (wgid % nig) / gsz; return true;
    }
    __device__ __forceinline__ void a_ready(const Unit&) const {}
    __device__ __forceinline__ void done(const Unit&) const {}
};

__device__ __forceinline__ unsigned cvt_pk_bf16(float lo, float hi) { unsigned r; asm volatile("v_cvt_pk_bf16_f32 %0, %1, %2" : "=v"(r) : "v"(lo), "v"(hi)); return r; }
__device__ __forceinline__ void glds_s(const void* sbase, unsigned voff, unsigned ldsdst) {
    unsigned keep;
    asm volatile("s_mov_b32 %0, m0\n\ts_mov_b32 m0, %3\n\ts_nop 0\n\tglobal_load_lds_dwordx4 %1, %2\n\ts_mov_b32 m0, %0" : "=&s"(keep) : "v"(voff), "s"(sbase), "s"(ldsdst) : "memory");
}
typedef float f32x2 __attribute__((ext_vector_type(2)));
__device__ __forceinline__ f32x2 gelu_pk(f32x2 v) {
    const f32x2 av = __builtin_elementwise_abs(v), d = av * 0.2316418882f + 1.0f;
    f32x2 t; t.x = __builtin_amdgcn_rcpf(d.x); t.y = __builtin_amdgcn_rcpf(d.y);
    f32x2 q = t * 0.5307027145f + (-0.7265760135f); q = q * t + 0.7107068705f; q = q * t + (-0.142248368f); q = q * t + 0.127414796f; q = q * t;
    const f32x2 s = (v * v) * (-0.72134752044f);
    f32x2 e; e.x = __builtin_amdgcn_exp2f(s.x); e.y = __builtin_amdgcn_exp2f(s.y);
    const f32x2 m = v * (q * e), r = v - m;
    f32x2 o; o.x = v.x < 0.f ? m.x : r.x; o.y = v.y < 0.f ? m.y : r.y; return o;
}

template <int ACT  > struct EpiBf16 {
    static constexpr bool PERM = true, AFTER_DRAIN = false; static_assert(ACT == 0 || ACT == 1, "EpiBf16: ACT is 0 (none) or 1 (gelu_pk)");
    bf16_t* O; int ldc; const float* bias; int split_cols; size_t split_stride; float scale0;
    __device__ __forceinline__ void operator()(const f32x4 (&acc)[2][2][4][2], const Unit& u, int wr, int wc, int fr_in, int fq_in) const {
        int fr = fr_in, fq = fq_in; asm volatile("" : "+v"(fr), "+v"(fq));
        const int row0 = u.pm * BM + wr * 64 + fr; int colt = u.pn * BM; bf16_t* base = O;
        float sc = 1.f; if (split_cols) { const int t = colt / split_cols; base += (size_t)t * split_stride; colt -= t * split_cols; if (t == 0) sc = scale0; }
        const int col0 = colt + wc * 32 + 8 * fq, bcol0 = u.pn * BM + wc * 32 + 8 * fq;
        f32x4 bv[2][2];
#pragma unroll
        for (int bj = 0; bj < 2; ++bj)
#pragma unroll
            for (int n = 0; n < 2; ++n) bv[bj][n] = bias ? *(const f32x4*)(bias + bcol0 + bj * HALF + 4 * n) : (f32x4){0.f, 0.f, 0.f, 0.f};
#pragma unroll
        for (int ai = 0; ai < 2; ++ai)
#pragma unroll
            for (int m = 0; m < 4; ++m) { bf16_t* rowp = base + (size_t)(row0 + ai * HALF + m * 16) * ldc + col0;
#pragma unroll
                for (int bj = 0; bj < 2; ++bj) { f32x4 v0 = acc[ai][bj][m][0] + bv[bj][0], v1 = acc[ai][bj][m][1] + bv[bj][1];
                    if (ACT == 1) { f32x2 a = gelu_pk((f32x2){v0[0], v0[1]}), b = gelu_pk((f32x2){v0[2], v0[3]}), c = gelu_pk((f32x2){v1[0], v1[1]}), d = gelu_pk((f32x2){v1[2], v1[3]});
                        v0 = (f32x4){a.x, a.y, b.x, b.y}; v1 = (f32x4){c.x, c.y, d.x, d.y}; }
                    v0 = v0 * sc; v1 = v1 * sc; u32x4 w; w.x = cvt_pk_bf16(v0[0], v0[1]); w.y = cvt_pk_bf16(v0[2], v0[3]); w.z = cvt_pk_bf16(v1[0], v1[1]); w.w = cvt_pk_bf16(v1[2], v1[3]);
                    *(u32x4*)(rowp + bj * HALF) = w; } }
    }
};
__device__ __forceinline__ u32x4 pack8(const f32x4 v0, const f32x4 v1) { u32x4 w; w.x = cvt_pk_bf16(v0[0], v0[1]); w.y = cvt_pk_bf16(v0[2], v0[3]); w.z = cvt_pk_bf16(v1[0], v1[1]); w.w = cvt_pk_bf16(v1[2], v1[3]); return w; }
__device__ __forceinline__ f32x4 sigm4(const f32x4 g) {
    f32x4 r;
#pragma unroll
    for (int i = 0; i < 4; ++i) r[i] = __builtin_amdgcn_rcpf(1.0f + __builtin_amdgcn_exp2f(g[i] * -1.4426950408889634f));
    return r;
}
struct EpiQKV {
    static constexpr bool PERM = true, AFTER_DRAIN = false;
    bf16_t* Q; bf16_t* Kb; bf16_t* V; const float* tab; float qscale;
    __device__ __forceinline__ void operator()(const f32x4 (&acc)[2][2][4][2], const Unit& u, int wr, int wc, int fr_in, int fq_in) const {
        int fr = fr_in, fq = fq_in; asm volatile("" : "+v"(fr), "+v"(fq));
        const int row0 = u.pm * BM + wr * 64 + fr;
        if (u.pn >= 8) {
            const int col0 = (u.pn - 8) * BM + wc * 32 + 8 * fq;
#pragma unroll
            for (int ai = 0; ai < 2; ++ai)
#pragma unroll
                for (int m = 0; m < 4; ++m) { bf16_t* rowp = V + (size_t)(row0 + ai * HALF + m * 16) * 1024 + col0;
#pragma unroll
                    for (int bj = 0; bj < 2; ++bj) *(u32x4*)(rowp + bj * HALF) = pack8(acc[ai][bj][m][0], acc[ai][bj][m][1]); }
        } else {
            bf16_t* dst = (u.pn >> 2) ? Kb : Q; const float sc = (u.pn >> 2) ? 1.0f : qscale;
            const int colbase = 64 * (4 * (u.pn & 3) + wc) + 8 * fq;
#pragma unroll
            for (int ai = 0; ai < 2; ++ai)
#pragma unroll
                for (int m = 0; m < 4; ++m) { const int row = row0 + ai * HALF + m * 16; const float* tp = tab + (size_t)(row & 8191) * 64 + 8 * fq;
                    const f32x4 c0 = *(const f32x4*)(tp), c1 = *(const f32x4*)(tp + 4), s0 = *(const f32x4*)(tp + 32), s1 = *(const f32x4*)(tp + 36);
                    const f32x4 x10 = acc[ai][0][m][0], x11 = acc[ai][0][m][1], x20 = acc[ai][1][m][0], x21 = acc[ai][1][m][1];
                    const f32x4 o10 = (x10 * c0 - x20 * s0) * sc, o11 = (x11 * c1 - x21 * s1) * sc, o20 = (x20 * c0 + x10 * s0) * sc, o21 = (x21 * c1 + x11 * s1) * sc;
                    bf16_t* rowp = dst + (size_t)row * 1024 + colbase;
                    *(u32x4*)(rowp) = pack8(o10, o11); *(u32x4*)(rowp + 32) = pack8(o20, o21); asm volatile("" ::: "memory"); }
        }
    }
};
struct EpiSwiGLU {
    static constexpr bool PERM = true, AFTER_DRAIN = false;
    bf16_t* H; int ldc;
    __device__ __forceinline__ void operator()(const f32x4 (&acc)[2][2][4][2], const Unit& u, int wr, int wc, int fr_in, int fq_in) const {
        int fr = fr_in, fq = fq_in; asm volatile("" : "+v"(fr), "+v"(fq));
        const int row0 = u.pm * BM + wr * 64 + fr, col0 = u.pn * HALF + wc * 32 + 8 * fq;
#pragma unroll
        for (int ai = 0; ai < 2; ++ai)
#pragma unroll
            for (int m = 0; m < 4; ++m) { bf16_t* rowp = H + (size_t)(row0 + ai * HALF + m * 16) * ldc + col0;
                const f32x4 g0 = acc[ai][0][m][0], g1 = acc[ai][0][m][1];
                const f32x4 h0 = g0 * sigm4(g0) * acc[ai][1][m][0], h1 = g1 * sigm4(g1) * acc[ai][1][m][1];
                *(u32x4*)(rowp) = pack8(h0, h1); __builtin_amdgcn_sched_barrier(0); }
    }
};
struct EpiGLU {
    static constexpr bool PERM = true, AFTER_DRAIN = false;
    bf16_t* G; const float* bias;
    __device__ __forceinline__ void operator()(const f32x4 (&acc)[2][2][4][2], const Unit& u, int wr, int wc, int fr_in, int fq_in) const {
        int fr = fr_in, fq = fq_in; asm volatile("" : "+v"(fr), "+v"(fq));
        const int row0 = u.pm * BM + wr * 64 + fr, col0 = u.pn * HALF + wc * 32 + 8 * fq;
#pragma unroll
        for (int ai = 0; ai < 2; ++ai)
#pragma unroll
            for (int m = 0; m < 4; ++m) { bf16_t* rowp = G + (size_t)(row0 + ai * HALF + m * 16) * 1024 + col0;
                const f32x4 ba0 = *(const f32x4*)(bias + col0), ba1 = *(const f32x4*)(bias + col0 + 4), bg0 = *(const f32x4*)(bias + 1024 + col0), bg1 = *(const f32x4*)(bias + 1024 + col0 + 4);
                const f32x4 h0 = (acc[ai][0][m][0] + ba0) * sigm4(acc[ai][1][m][0] + bg0), h1 = (acc[ai][0][m][1] + ba1) * sigm4(acc[ai][1][m][1] + bg1);
                *(u32x4*)(rowp) = pack8(h0, h1); asm volatile("" ::: "memory"); __builtin_amdgcn_sched_barrier(0); }
    }
};
template <int MODE> struct EpiResid {
    static constexpr bool PERM = false, AFTER_DRAIN = false;
    const float* xin; float* out; const float* st; const float* g; const float* b; const float* bias; float alpha;
    __device__ __forceinline__ void operator()(const f32x4 (&acc)[2][2][4][2], const Unit& u, int wr, int wc, int fr_in, int fq_in) const {
        int fr = fr_in, fq = fq_in; asm volatile("" : "+v"(fr), "+v"(fq));
        const int col0 = u.pn * BM + wc * 32 + 4 * fq;
#pragma unroll
        for (int bj = 0; bj < 2; ++bj)
#pragma unroll
            for (int n = 0; n < 2; ++n) { const int c = col0 + bj * HALF + n * 16;
                const f32x4 cv = bias ? *(const f32x4*)(bias + c) : (f32x4){0.f, 0.f, 0.f, 0.f};
                f32x4 gv = cv, bv = cv; if (MODE == 1) { gv = *(const f32x4*)(g + c); bv = *(const f32x4*)(b + c); }
#pragma unroll
                for (int ai = 0; ai < 2; ++ai)
#pragma unroll
                    for (int m = 0; m < 4; ++m) { const int row = u.pm * BM + ai * HALF + wr * 64 + m * 16 + fr; const size_t off = (size_t)row * 1024 + c;
                        f32x4 xv = *(const f32x4*)(xin + off);
                        if (MODE == 1) { const float mean = st[2 * row], rstd = st[2 * row + 1]; xv = (xv - mean) * rstd * gv + bv; }
                        *(f32x4*)(out + off) = xv * alpha + acc[ai][bj][m][n] + cv;
                        if (m & 1) asm volatile("" ::: "memory"); }
            }
    }
};

template <class Epi, class Sched, bool ALIGN_EPI = false, bool SP2 = false>
__device__ __forceinline__ void gemm_phase(PG8_LAS unsigned char* lds, const Gemm g, const Sched& S, const Epi& E) {
    int tid_l = threadIdx.x; asm volatile("" : "+v"(tid_l));
    const int tid = tid_l, wid = __builtin_amdgcn_readfirstlane(tid >> 6), lane = tid & 63, wr = wid >> 2, wc = wid & 3, fr = lane & 15, fq = lane >> 4;
    const int K = g.K, nt = K / BK;
    unsigned voffA[2], voffB[2];
#pragma unroll
    for (int i = 0; i < 2; ++i) { int R, C; stage_rc(tid * 16 + i * 8192, R, C); const int Rb = Epi::PERM ? ((R & ~31) + perm32(R & 31)) : R;
        voffA[i] = (unsigned)(R * K + C) * 2u; voffB[i] = (unsigned)(Rb * K + C) * 2u; }
    const size_t kstep = (size_t)(BK * 2);
    const size_t hstep = (size_t)HALF * K * 2;
    const size_t tstep = 2 * hstep;
    const unsigned ldsbase_ = (unsigned)(uintptr_t)lds;
    const unsigned ldsw = (unsigned)wid * 1024u;
    const int aoff = lds_byte(wr * 64 + fr, fq * 8), boff = lds_byte(wc * 32 + fr, fq * 8);
#define PG8_SA(b, h) (((b) * 2 + (h)) * HTB)
#define PG8_SB(b, h) ((4 + (b) * 2 + (h)) * HTB)
#define PG8_STAGE(bufoff, gbase, voff) do { _Pragma("unroll") for (int _i = 0; _i < 2; ++_i) \
        glds_s((const void*)(gbase), (voff)[_i], ldsbase_ + (unsigned)(bufoff) + ldsw + (unsigned)_i * 8192u); } while (0)
#define PG8_LDA(dst, b, h) do { _Pragma("unroll") for (int m = 0; m < 4; ++m) _Pragma("unroll") for (int k = 0; k < 2; ++k) dst[m][k] = *(const PG8_LAS bf16x8*)(lds + PG8_SA(b, h) + aoff + m * 2048 + k * 1024); } while (0)
#define PG8_LDB(dst, b, h) do { _Pragma("unroll") for (int n = 0; n < 2; ++n) _Pragma("unroll") for (int k = 0; k < 2; ++k) dst[n][k] = *(const PG8_LAS bf16x8*)(lds + PG8_SB(b, h) + boff + n * 2048 + k * 1024); } while (0)
#define PG8_MMA(ai, bj, At, Bt) do { __builtin_amdgcn_s_setprio(1); _Pragma("unroll") for (int m = 0; m < 4; ++m) _Pragma("unroll") for (int n = 0; n < 2; ++n) _Pragma("unroll") for (int k = 0; k < 2; ++k) \
        acc[ai][bj][m][n] = __builtin_amdgcn_mfma_f32_16x16x32_bf16(Bt[n][k], At[m][k], acc[ai][bj][m][n], 0, 0, 0); __builtin_amdgcn_s_setprio(0); } while (0)
#define PG8_WAIT_V(n) asm volatile("s_waitcnt vmcnt(" #n ")" ::: "memory")
#define PG8_WAIT_L(n) asm volatile("s_waitcnt lgkmcnt(" #n ")" ::: "memory")
#define PG8_BAR __builtin_amdgcn_s_barrier()
#define PG8_SCHED __builtin_amdgcn_sched_barrier(0)
    Unit cur, nxt; int ui = 0;
    if (!S.next(0, cur)) return;
    f32x4 acc[2][2][4][2];
#pragma unroll
    for (int a = 0; a < 2; ++a)
#pragma unroll
        for (int b = 0; b < 2; ++b)
#pragma unroll
            for (int m = 0; m < 4; ++m)
#pragma unroll
                for (int n = 0; n < 2; ++n) acc[a][b][m][n] = (f32x4){0.f, 0.f, 0.f, 0.f};
    bf16x8 At[4][2], B0[2][2], B1[2][2];
    const char* cA = (const char*)g.A + (size_t)cur.pm * tstep; const char* cB = (const char*)g.Bt + (size_t)cur.pn * tstep;
    S.a_ready(cur);
    if constexpr (SP2) {
        PG8_STAGE(PG8_SB(0, 0), cB, voffB); PG8_SCHED; PG8_STAGE(PG8_SB(0, 1), cB + hstep, voffB); PG8_SCHED; PG8_STAGE(PG8_SA(0, 0), cA, voffA); PG8_SCHED; PG8_STAGE(PG8_SA(0, 1), cA + hstep, voffA); PG8_SCHED;
        if (wr == 1) PG8_BAR;
        PG8_WAIT_V(2); PG8_BAR; PG8_SCHED;
        PG8_STAGE(PG8_SB(1, 0), cB + kstep, voffB); PG8_SCHED; PG8_STAGE(PG8_SA(1, 0), cA + kstep, voffA); PG8_SCHED; PG8_STAGE(PG8_SB(1, 1), cB + hstep + kstep, voffB); PG8_SCHED;
        PG8_WAIT_V(6); PG8_BAR; PG8_SCHED;
    } else {
        PG8_STAGE(PG8_SB(0, 0), cB, voffB); PG8_STAGE(PG8_SA(0, 0), cA, voffA); PG8_STAGE(PG8_SB(0, 1), cB + hstep, voffB); PG8_STAGE(PG8_SA(0, 1), cA + hstep, voffA);
        if (wr == 1) PG8_BAR;
        PG8_WAIT_V(4); PG8_BAR;
        PG8_STAGE(PG8_SB(1, 0), cB + kstep, voffB); PG8_STAGE(PG8_SA(1, 0), cA + kstep, voffA); PG8_STAGE(PG8_SB(1, 1), cB + hstep + kstep, voffB);
        PG8_WAIT_V(6); PG8_BAR;
    }
    for (;;) {
        const bool has_next = S.next(ui + 1, nxt);
        const char* nA = has_next ? (const char*)g.A + (size_t)nxt.pm * tstep : cA; const char* nB = has_next ? (const char*)g.Bt + (size_t)nxt.pn * tstep : cB;
        for (int t = 0; t < nt; t += 2) {
            const bool last = (t == nt - 2);
            const char* a1 = cA + (size_t)(t + 1) * kstep;
            const char* a2 = last ? nA : cA + (size_t)(t + 2) * kstep; const char* b2 = last ? nB : cB + (size_t)(t + 2) * kstep;
            const char* a3 = a2 + kstep; const char* b3 = b2 + kstep;
            if (last && has_next) S.a_ready(nxt);
            if constexpr (SP2) {
            PG8_LDB(B0, 0, 0); PG8_LDB(B1, 0, 1); PG8_SCHED; PG8_LDA(At, 0, 0); PG8_STAGE(PG8_SA(1, 1), a1 + hstep, voffA);
            PG8_WAIT_V(8); PG8_WAIT_L(0); PG8_BAR; PG8_MMA(0, 0, At, B0); PG8_MMA(0, 1, At, B1); PG8_BAR; PG8_SCHED;
            PG8_LDA(At, 0, 1); PG8_STAGE(PG8_SB(0, 0), b2, voffB); PG8_STAGE(PG8_SB(0, 1), b2 + hstep, voffB); PG8_STAGE(PG8_SA(0, 0), a2, voffA);
            PG8_WAIT_V(8); PG8_WAIT_L(0); PG8_BAR; PG8_MMA(1, 0, At, B0); PG8_MMA(1, 1, At, B1); PG8_BAR; PG8_SCHED;
            PG8_LDB(B0, 1, 0); PG8_LDB(B1, 1, 1); PG8_SCHED; PG8_LDA(At, 1, 0); PG8_STAGE(PG8_SA(0, 1), a2 + hstep, voffA);
            PG8_WAIT_V(8); PG8_WAIT_L(0); PG8_BAR; PG8_MMA(0, 0, At, B0); PG8_MMA(0, 1, At, B1); PG8_BAR; PG8_SCHED;
            PG8_LDA(At, 1, 1); PG8_STAGE(PG8_SB(1, 0), b3, voffB); PG8_STAGE(PG8_SB(1, 1), b3 + hstep, voffB); PG8_STAGE(PG8_SA(1, 0), a3, voffA);
            PG8_WAIT_V(8); PG8_WAIT_L(0); PG8_BAR; PG8_MMA(1, 0, At, B0); PG8_MMA(1, 1, At, B1); PG8_BAR; PG8_SCHED;
            } else {
            PG8_LDB(B0, 0, 0); PG8_SCHED; PG8_LDA(At, 0, 0); PG8_STAGE(PG8_SA(1, 1), a1 + hstep, voffA);
            PG8_WAIT_L(8); PG8_BAR; PG8_WAIT_L(0); PG8_MMA(0, 0, At, B0); PG8_BAR; PG8_SCHED;
            PG8_LDB(B1, 0, 1); PG8_STAGE(PG8_SB(0, 0), b2, voffB);
            PG8_BAR; PG8_WAIT_L(0); PG8_MMA(0, 1, At, B1); PG8_BAR;
            PG8_LDA(At, 0, 1); PG8_STAGE(PG8_SA(0, 0), a2, voffA);
            PG8_BAR; PG8_WAIT_L(0); PG8_MMA(1, 0, At, B0); PG8_BAR; PG8_SCHED;
            PG8_STAGE(PG8_SB(0, 1), b2 + hstep, voffB);
            PG8_WAIT_V(6); PG8_BAR; PG8_MMA(1, 1, At, B1); PG8_BAR;
            PG8_LDB(B0, 1, 0); PG8_SCHED; PG8_LDA(At, 1, 0); PG8_STAGE(PG8_SA(0, 1), a2 + hstep, voffA);
            PG8_WAIT_L(8); PG8_BAR; PG8_WAIT_L(0); PG8_MMA(0, 0, At, B0); PG8_BAR; PG8_SCHED;
            PG8_LDB(B1, 1, 1); PG8_STAGE(PG8_SB(1, 0), b3, voffB);
            PG8_BAR; PG8_WAIT_L(0); PG8_MMA(0, 1, At, B1); PG8_BAR;
            PG8_LDA(At, 1, 1); PG8_STAGE(PG8_SA(1, 0), a3, voffA);
            PG8_BAR; PG8_WAIT_L(0); PG8_MMA(1, 0, At, B0); PG8_BAR; PG8_SCHED;
            PG8_STAGE(PG8_SB(1, 1), b3 + hstep, voffB);
            PG8_WAIT_V(6); PG8_BAR; PG8_MMA(1, 1, At, B1); PG8_BAR;
            }
        }
        if constexpr (ALIGN_EPI) { if (wr == 0) PG8_BAR; }
        if constexpr (!Epi::AFTER_DRAIN) { E(acc, cur, wr, wc, fr, fq); S.done(cur); }
        if (!has_next) break;
#pragma unroll
        for (int a = 0; a < 2; ++a)
#pragma unroll
            for (int b = 0; b < 2; ++b)
#pragma unroll
                for (int m = 0; m < 4; ++m)
#pragma unroll
                    for (int n = 0; n < 2; ++n) acc[a][b][m][n] = (f32x4){0.f, 0.f, 0.f, 0.f};
        cur = nxt; cA = nA; cB = nB; ++ui;
        if constexpr (ALIGN_EPI) { if (wr == 1) PG8_BAR; }
    }
    PG8_WAIT_V(0);
    if constexpr (!ALIGN_EPI) { if (wr == 0) PG8_BAR; }
    PG8_BAR;
    if constexpr (Epi::AFTER_DRAIN) { E.fused(acc, cur, wr, wc, fr, fq, lds, wid, lane); S.done(cur); }
#undef PG8_SA
#undef PG8_SB
#undef PG8_STAGE
#undef PG8_LDA
#undef PG8_LDB
#undef PG8_MMA
#undef PG8_WAIT_V
#undef PG8_WAIT_L
#undef PG8_BAR
#undef PG8_SCHED
}
}

namespace att {
#define ALAS __attribute__((address_space(3)))
typedef unsigned short bf16_t;
typedef short bf16x8 __attribute__((ext_vector_type(8)));
typedef short s16x4 __attribute__((ext_vector_type(4)));
typedef short v4i16_t __attribute__((ext_vector_type(4)));
typedef float f32x16 __attribute__((ext_vector_type(16)));
typedef float f32x4 __attribute__((ext_vector_type(4)));
typedef unsigned u32x4 __attribute__((ext_vector_type(4)));
constexpr int SEQ = 8192, PITCH = 1024;
constexpr int KBYTES = 8192, VBYTES = 16384, VOFF0 = 3 * KBYTES, WSF_OFF = VOFF0 + 3 * VBYTES, STG_OFF = WSF_OFF + 8 * 64 * 4, LDS_BYTES = STG_OFF + 8 * 8192;
#ifndef ATT_GRP_SHIFT
#define ATT_GRP_SHIFT 2
#endif
__device__ __forceinline__ int crow(int r, int hi) { return (r & 3) + 8 * (r >> 2) + 4 * hi; }
__device__ __forceinline__ unsigned f2bf(float f) { unsigned u = __builtin_bit_cast(unsigned, f); return (u + 0x7fffu + ((u >> 16) & 1u)) >> 16; }
__device__ __forceinline__ s16x4 vtr(const ALAS unsigned char* p) { return __builtin_bit_cast(s16x4, __builtin_amdgcn_ds_read_tr16_b64_v4i16((ALAS v4i16_t*)p)); }
__device__ __forceinline__ float swapsum(float v) { auto rr = __builtin_amdgcn_permlane32_swap(__float_as_uint(v), __float_as_uint(v), false, false); return __uint_as_float(rr[0]) + __uint_as_float(rr[1]); }
__device__ __forceinline__ float swapmax(float v) { auto rr = __builtin_amdgcn_permlane32_swap(__float_as_uint(v), __float_as_uint(v), false, false); return fmaxf(__uint_as_float(rr[0]), __uint_as_float(rr[1])); }
__device__ __forceinline__ float max3f(float a, float b, float c) { float r; asm("v_max3_f32 %0, %1, %2, %3" : "=v"(r) : "v"(a), "v"(b), "v"(c)); return r; }
__device__ __forceinline__ float max2f(float a, float b) { float r; asm("v_max_f32_e32 %0, %1, %2" : "=v"(r) : "v"(a), "v"(b)); return r; }
#define ATT_GLDS(g, l) __builtin_amdgcn_global_load_lds((const unsigned*)(g), (ALAS unsigned*)(l), 16, 0, 0)
#define ATT_LWAIT() asm volatile("s_waitcnt lgkmcnt(0)" ::: "memory")

__device__ __forceinline__ void attn_unit(int b, int h, int qb, const bf16_t* Q, const bf16_t* K, const bf16_t* V, bf16_t* O, float* scr, ALAS unsigned char* shm, float lam, float outscale, const float* subg) {
    int tid_l = threadIdx.x; asm volatile("" : "+v"(tid_l));
    const int tid = tid_l, lane = tid & 63, r32 = lane & 31, hi = lane >> 5; const int wid = __builtin_amdgcn_readfirstlane(tid >> 6);
    const size_t rowbase = (size_t)b * SEQ; const int q0 = qb * 256;
    const int NT = 4 * qb + 4, cw = 4 * qb + (wid >> 1);
    const unsigned shm0 = (unsigned)(uintptr_t)shm;
    ALAS float* wsf = (ALAS float*)(shm + WSF_OFF) + wid * 64;
    float* myscr = scr + ((((rowbase + q0) >> 5) + wid) * 8 + h) * 4096;
    f32x16 o[4];
    for (int m = 0; m < 2; ++m) {
        const bf16_t* Qw = Q + (rowbase + q0 + wid * 32) * PITCH + h * 128 + m * 64;
        const bf16_t* ksrc = K + rowbase * PITCH + h * 128 + m * 64 + wid * 8;
        const bf16_t* vsrc = V + (rowbase + 16 * (wid & 3)) * PITCH + h * 128 + (wid >> 2) * 32;
        const unsigned koff = (unsigned)lane * (PITCH * 2), voff = (unsigned)(lane >> 2) * (PITCH * 2) + (unsigned)(lane & 3) * 16u;
        bf16x8 qr[4];
        unsigned qoff = (unsigned)r32 * (PITCH * 2) + (unsigned)hi * 16u; asm volatile("" : "+v"(qoff));
#pragma unroll
        for (int d0 = 0; d0 < 4; ++d0) qr[d0] = *(const bf16x8*)((const char*)Qw + (qoff + (unsigned)d0 * 32u));
        float mhat = 0.f, l = 0.f; f32x16 negm;
#pragma unroll
        for (int r = 0; r < 16; ++r) negm[r] = 0.f;
#pragma unroll
        for (int d0 = 0; d0 < 4; ++d0)
#pragma unroll
            for (int r = 0; r < 16; ++r) o[d0][r] = 0.f;
        bf16x8 pw[4];
#pragma unroll
        for (int ks = 0; ks < 4; ++ks) pw[ks] = (bf16x8){0, 0, 0, 0, 0, 0, 0, 0};
#define ATT_DMA(t, koffs, voffs) do { const size_t go_ = (size_t)(t) * 64 * PITCH; pg8::glds_s(ksrc + go_, koff, shm0 + (unsigned)(koffs) + (unsigned)wid * 1024u); \
            pg8::glds_s(vsrc + go_, voff, shm0 + (unsigned)(voffs) + (unsigned)wid * 1024u); pg8::glds_s(vsrc + go_ + 64, voff, shm0 + (unsigned)(voffs) + (unsigned)(wid + 8) * 1024u); } while (0)
#define ATT_QK(P0, P1, koffs) do { \
            const ALAS unsigned char* kb = shm + (koffs) + hi * 1024 + r32 * 16; \
            bf16x8 kf[8]; \
            _Pragma("unroll") for (int d0 = 0; d0 < 4; ++d0) { kf[2 * d0] = *(const ALAS bf16x8*)(kb + d0 * 2048); kf[2 * d0 + 1] = *(const ALAS bf16x8*)(kb + d0 * 2048 + 512); } \
            P0 = __builtin_amdgcn_mfma_f32_32x32x16_bf16(kf[0], qr[0], negm, 0, 0, 0); P1 = __builtin_amdgcn_mfma_f32_32x32x16_bf16(kf[1], qr[0], negm, 0, 0, 0); \
            _Pragma("unroll") for (int d0 = 1; d0 < 4; ++d0) { P0 = __builtin_amdgcn_mfma_f32_32x32x16_bf16(kf[2 * d0], qr[d0], P0, 0, 0, 0); P1 = __builtin_amdgcn_mfma_f32_32x32x16_bf16(kf[2 * d0 + 1], qr[d0], P1, 0, 0, 0); } \
        } while (0)
#define ATT_FIN(P0, P1) do { \
            float sacc = 0.f; \
            _Pragma("unroll") for (int r = 0; r < 16; ++r) { P1[r] = __builtin_amdgcn_exp2f(P1[r]); sacc += P0[r] + P1[r]; } \
            l += sacc; \
            _Pragma("unroll") for (int ks = 0; ks < 4; ++ks) { u32x4 w; \
                _Pragma("unroll") for (int i = 0; i < 4; ++i) { const int r = 8 * (ks & 1) + 2 * i; const float a = (ks < 2) ? P0[r] : P1[r], c = (ks < 2) ? P0[r + 1] : P1[r + 1]; w[i] = pg8::cvt_pk_bf16(a, c); } \
                pw[ks] = __builtin_bit_cast(bf16x8, w); } \
        } while (0)
#define ATT_PART(P0, P1, j_) do { \
            float rma = max3f(P0[0], P0[1], P1[0]), rmb = max3f(P0[2], P0[3], P1[1]); rma = max3f(rma, P1[2], P1[3]); \
            _Pragma("unroll") for (int r = 4; r < 16; r += 4) { rma = max3f(rma, P0[r], P0[r + 1]); rmb = max3f(rmb, P0[r + 2], P0[r + 3]); rma = max3f(rma, P1[r], P1[r + 1]); rmb = max3f(rmb, P1[r + 2], P1[r + 3]); } \
            float rm = swapmax(max2f(rma, rmb)); \
            const bool first_ = ((j_) == 0); \
            if (first_ || __any(rm > 8.0f)) { \
                const float dl = first_ ? rm : fmaxf(rm, 0.f), f = first_ ? 1.0f : __builtin_amdgcn_exp2f(-dl); mhat += dl; l *= f; \
                _Pragma("unroll") for (int r = 0; r < 16; ++r) { P0[r] -= dl; P1[r] -= dl; negm[r] = -mhat; } \
                ATT_LWAIT(); \
                if (hi == 0) wsf[r32] = f; \
                ATT_LWAIT(); \
                _Pragma("unroll") for (int r = 0; r < 16; ++r) { const float fr_ = wsf[crow(r, hi)]; \
                    _Pragma("unroll") for (int d0 = 0; d0 < 4; ++d0) o[d0][r] *= fr_; } \
                ATT_LWAIT(); \
            } \
            _Pragma("unroll") for (int r = 0; r < 16; ++r) P0[r] = __builtin_amdgcn_exp2f(P0[r]); \
        } while (0)
#define ATT_PV(voffs) do { \
            const ALAS unsigned char* vp = shm + (voffs) + ((lane >> 4) & 1) * 32 + (lane & 3) * 8 + (4 * hi + ((lane & 15) >> 2)) * 64; \
            _Pragma("unroll") for (int ks = 0; ks < 4; ++ks) \
                _Pragma("unroll") for (int d0 = 0; d0 < 4; ++d0) { \
                    const s16x4 lo = vtr(vp + d0 * 4096 + ks * 1024), hh = vtr(vp + d0 * 4096 + ks * 1024 + 512); \
                    const bf16x8 vf = (bf16x8){lo[0], lo[1], lo[2], lo[3], hh[0], hh[1], hh[2], hh[3]}; \
                    o[d0] = __builtin_amdgcn_mfma_f32_32x32x16_bf16(pw[ks], vf, o[d0], 0, 0, 0); } \
        } while (0)
#define ATT_STEP(PC0, PC1, PP0, PP1, j_) do { const int jj = (j_); \
            if (jj + 1 < NT) asm volatile("s_waitcnt vmcnt(3)" ::: "memory"); else if (jj + 1 == NT) asm volatile("s_waitcnt vmcnt(2)" ::: "memory"); else asm volatile("s_waitcnt vmcnt(0)" ::: "memory"); \
            __syncthreads(); \
            if (jj + 2 < NT) { const size_t go_ = (size_t)(jj + 2) * 64 * PITCH; pg8::glds_s(ksrc + go_, koff, shm0 + (unsigned)(s2 * KBYTES) + (unsigned)wid * 1024u); } \
            if (jj + 1 < NT) { const size_t go_ = (size_t)(jj + 1) * 64 * PITCH; const unsigned vd_ = shm0 + (unsigned)(VOFF0 + s1 * VBYTES); \
                pg8::glds_s(vsrc + go_, voff, vd_ + (unsigned)wid * 1024u); pg8::glds_s(vsrc + go_ + 64, voff, vd_ + (unsigned)(wid + 8) * 1024u); } \
            if (jj <= cw) ATT_QK(PC0, PC1, s0 * KBYTES); \
            if (jj >= 1 && jj - 1 <= cw) { ATT_FIN(PP0, PP1); ATT_PV(VOFF0 + s2 * VBYTES); } \
            if (jj <= cw) ATT_PART(PC0, PC1, jj); \
            { const int t_ = s0; s0 = s1; s1 = s2; s2 = t_; } \
        } while (0)
        {
            asm volatile("s_waitcnt vmcnt(0)" ::: "memory");
            pg8::glds_s(ksrc, koff, shm0 + (unsigned)wid * 1024u);
            pg8::glds_s(ksrc + (size_t)64 * PITCH, koff, shm0 + (unsigned)KBYTES + (unsigned)wid * 1024u);
            pg8::glds_s(vsrc, voff, shm0 + (unsigned)VOFF0 + (unsigned)wid * 1024u); pg8::glds_s(vsrc + 64, voff, shm0 + (unsigned)VOFF0 + (unsigned)(wid + 8) * 1024u);
        }
        int s0 = 0, s1 = 1, s2 = 2;
        f32x16 pA0, pA1, pB0, pB1;
#pragma unroll
        for (int r = 0; r < 16; ++r) { pA0[r] = 0.f; pA1[r] = 0.f; pB0[r] = 0.f; pB1[r] = 0.f; }
        for (int j = 0; j <= NT; j += 2) {
            ATT_STEP(pA0, pA1, pB0, pB1, j);
            if (j + 1 <= NT) ATT_STEP(pB0, pB1, pA0, pA1, j + 1);
        }
        __syncthreads();
#undef ATT_QK
#undef ATT_FIN
#undef ATT_PART
#undef ATT_PV
#undef ATT_STEP
#undef ATT_DMA
        const float lt = swapsum(l);
        ATT_LWAIT();
        if (hi == 0) wsf[32 + r32] = 1.0f / lt;
        ATT_LWAIT();
        float rli[16];
#pragma unroll
        for (int r = 0; r < 16; ++r) rli[r] = wsf[32 + crow(r, hi)];
        ATT_LWAIT();
        int lane2 = lane; asm volatile("" : "+v"(lane2));
        float* sp = (float*)((char*)myscr + (unsigned)lane2 * 16u);
        if (m == 0) {
#pragma unroll
            for (int d0 = 0; d0 < 4; ++d0) {
#pragma unroll
                for (int r4 = 0; r4 < 4; ++r4) { f32x4 v;
#pragma unroll
                    for (int i = 0; i < 4; ++i) v[i] = o[d0][4 * r4 + i] * rli[4 * r4 + i];
                    *(f32x4*)(sp + (d0 * 4 + r4) * 256) = v; }
                asm volatile("" ::: "memory"); }
        } else {
            float ss[16];
#pragma unroll
            for (int r = 0; r < 16; ++r) ss[r] = 0.f;
#pragma unroll
            for (int d0 = 0; d0 < 4; ++d0) {
#pragma unroll
                for (int r4 = 0; r4 < 4; ++r4) { const f32x4 v0 = *(const f32x4*)(sp + (d0 * 4 + r4) * 256);
#pragma unroll
                    for (int i = 0; i < 4; ++i) { const int r = 4 * r4 + i; const float v = v0[i] - lam * (o[d0][r] * rli[r]); o[d0][r] = v; ss[r] += v * v; } }
                asm volatile("" ::: "memory"); }
#pragma unroll
            for (int r = 0; r < 16; ++r) {
#pragma unroll
                for (int k = 1; k < 32; k <<= 1) ss[r] += __shfl_xor(ss[r], k);
                ss[r] = __builtin_amdgcn_rsqf(ss[r] * (1.0f / 128.0f) + 1e-5f) * outscale;
            }
            ALAS unsigned char* stw = shm + STG_OFF + wid * 8192;
            ALAS unsigned short* stg = (ALAS unsigned short*)stw + (4 * hi) * 128 + r32;
#pragma unroll
            for (int d0 = 0; d0 < 4; ++d0) { const float gg = subg[32 * d0 + (lane2 & 31)];
#pragma unroll
                for (int r = 0; r < 16; ++r) stg[((r & 3) + 8 * (r >> 2)) * 128 + 32 * d0] = (unsigned short)f2bf(o[d0][r] * ss[r] * gg); }
            ATT_LWAIT();
            bf16_t* Ow = (bf16_t*)((char*)(O + (rowbase + q0 + wid * 32) * PITCH + h * 128) + ((unsigned)(lane2 >> 4) * (PITCH * 2) + (unsigned)(lane2 & 15) * 16u));
#pragma unroll
            for (int i = 0; i < 8; ++i) { const u32x4 v = *(const ALAS u32x4*)(stw + i * 1024 + lane2 * 16); *(u32x4*)(Ow + (size_t)i * 4 * PITCH) = v; }
            ATT_LWAIT();
        }
    }
}
}

#ifndef PHMASK
#define PHMASK 0xFFFF
#endif
constexpr int NWAVES = 8;
constexpr int M = 32768, D = 1024, FF = 2816, SEQ = 8192;
constexpr float LN_EPS = 1e-5f;
constexpr float ALPHA = 1.4142135623730951f;
constexpr size_t MiB = 1u << 20;
constexpr size_t WS_BAR = 0;
constexpr size_t WS_ST = 1 * MiB;
constexpr size_t WS_TAB = 2 * MiB;
constexpr size_t WS_WQKV = 4 * MiB, WS_WO = 10 * MiB, WS_PW1 = 12 * MiB, WS_PW2 = 16 * MiB, WS_GU0 = 18 * MiB, WS_GU1 = 29 * MiB, WS_DN0 = 40 * MiB, WS_DN1 = 46 * MiB;
constexpr size_t WS_PAR = 52 * MiB;
constexpr int PO_LQ1 = 0, PO_LK1 = 64, PO_LQ2 = 128, PO_LK2 = 192, PO_SUBG = 256, PO_BPW1 = 384, PO_WDW = 2432, PO_BDW = 34176, PO_CLNG = 35200, PO_CLNB = 36224, PO_BPW2 = 37248, PO_LNG = 38272, PO_LNB = 42368, PO_END = 46464;
constexpr size_t WS_XN = 64 * MiB;
constexpr size_t WS_Q = 128 * MiB, WS_K = 192 * MiB, WS_V = 256 * MiB;
constexpr size_t WS_H = 128 * MiB;
constexpr size_t WS_G = 128 * MiB, WS_C = 192 * MiB;
constexpr size_t WS_Z = 320 * MiB;
constexpr size_t WS_END = 448 * MiB;
constexpr int LDS_BYTES = 147456;

#define LAS __attribute__((address_space(3)))
typedef unsigned short bf16;
typedef unsigned v4u __attribute__((ext_vector_type(4)));
typedef unsigned v2u __attribute__((ext_vector_type(2)));
typedef float f32x4 __attribute__((ext_vector_type(4)));
#define LDS_WAIT() asm volatile("s_waitcnt lgkmcnt(0)" ::: "memory")
__device__ __forceinline__ unsigned f2bf(float f) { unsigned u = __builtin_bit_cast(unsigned, f); return (u + 0x7fffu + ((u >> 16) & 1u)) >> 16; }
__device__ __forceinline__ unsigned pk2(float lo, float hi) { return f2bf(lo) | (f2bf(hi) << 16); }
__device__ __forceinline__ float wave_sum(float v) {
#pragma unroll
    for (int o = 1; o < 64; o <<= 1) v += __shfl_xor(v, o);
    return v;
}
__device__ __forceinline__ int map_row(int mode, int n) {
    if (mode == 1) {
        if (n >= 2048) return n;
        const int region = n >> 10, within = n & 1023, slice = within >> 6, d = within & 63;
        return 256 * (region * 4 + (slice >> 2)) + 128 * (d >> 5) + 32 * (slice & 3) + (d & 31);
    }
    if (mode == 2) { const int half = n >> 10, j = n & 1023; return 256 * (j >> 7) + 128 * half + (j & 127); }
    if (mode == 3) return 256 * (n >> 7) + (n & 127);
    if (mode == 4) return 256 * (n >> 7) + 128 + (n & 127);
    return n;
}
__device__ __forceinline__ void transpose_item(const float* W, int K, int N, bf16* WT, int mode, LAS float* scr, int item, int lane) {
    const int nblk = N / 32, kb = item / nblk, nb = item % nblk, k0 = 64 * kb, n0 = 32 * nb;
#pragma unroll 8
    for (int i = 0; i < 32; ++i) { const int kk = 2 * i + (lane >> 5); scr[kk * 33 + (lane & 31)] = W[(size_t)(k0 + kk) * N + n0 + (lane & 31)]; }
    LDS_WAIT(); asm volatile("" ::: "memory");
    const int c = lane & 7;
#pragma unroll
    for (int j = 0; j < 4; ++j) { const int n = (lane >> 3) + 8 * j; const LAS float* s = scr + (8 * c) * 33 + n;
        v4u o; o.x = pk2(s[0 * 33], s[1 * 33]); o.y = pk2(s[2 * 33], s[3 * 33]); o.z = pk2(s[4 * 33], s[5 * 33]); o.w = pk2(s[6 * 33], s[7 * 33]);
        *(v4u*)(WT + (size_t)map_row(mode, n0 + n) * K + k0 + 8 * c) = o; }
    LDS_WAIT(); asm volatile("" ::: "memory");
}

#define XB_TMO      128
#define XB_XCNT(j)  (256  + 64 * (j))
#define XB_XSUB(j)  (1280 + 64 * (j))
#define XB_XGEN(j)  (2304 + 64 * (j))
#define XB_TOP      3328
#define XB_TOPGEN   3392
#define XCD_BAR_WORDS 3456
#define XB_SPIN_CAP (1u << 18)

__device__ __forceinline__ unsigned xb_ld(unsigned* p)              { return __hip_atomic_load(p, __ATOMIC_RELAXED, __HIP_MEMORY_SCOPE_AGENT); }
__device__ __forceinline__ unsigned xb_add(unsigned* p, unsigned v) { return __hip_atomic_fetch_add(p, v, __ATOMIC_RELAXED, __HIP_MEMORY_SCOPE_AGENT); }
__device__ __forceinline__ unsigned xb_xcc_id() { return (unsigned)__builtin_amdgcn_s_getreg((3 << 11) | 20) & 0xFu; }
#define XB_SPIN(cond, bar) do { unsigned _sp = 0; while (cond) { __builtin_amdgcn_s_sleep(1); \
    if ((++_sp & 255u) == 0u) { if (xb_ld(&(bar)[XB_TMO])) break; if (_sp > XB_SPIN_CAP) { atomicAdd(&(bar)[XB_TMO], 1u); break; } } } } while (0)

struct XcdBarrier {
    unsigned* bar; unsigned x;
    volatile LAS unsigned* st;
};

__device__ __forceinline__ XcdBarrier xcd_barrier_post(unsigned* bar, volatile LAS unsigned* st) {
    XcdBarrier b; b.bar = bar; b.x = xb_xcc_id(); b.st = st;
    if (threadIdx.x == 0) (void)xb_add(&bar[XB_XCNT(b.x)], 1u);
    return b;
}
__device__ __forceinline__ void xcd_barrier_complete(unsigned* bar, unsigned x, unsigned& nloc, unsigned& nx) {
    const unsigned G = gridDim.x * gridDim.y * gridDim.z;
    unsigned sum, cnt, mine, sp = 0u;
    for (;;) {
        sum = 0u; cnt = 0u; mine = 0u;
#pragma unroll
        for (unsigned j = 0; j < 16; ++j) { const unsigned c = xb_ld(&bar[XB_XCNT(j)]); sum += c; cnt += (c > 0u) ? 1u : 0u; mine = (j == x) ? c : mine; }
        if (sum == G) break;
        __builtin_amdgcn_s_sleep(1);
        if ((++sp & 255u) == 0u) { if (xb_ld(&bar[XB_TMO])) break; if (sp > XB_SPIN_CAP) { atomicAdd(&bar[XB_TMO], 1u); break; } }
    }
    nloc = mine > 0u ? mine : 1u; nx = cnt > 0u ? cnt : 1u;
}

__device__ __forceinline__ void xcd_barrier(const XcdBarrier& b) {
    asm volatile("s_waitcnt vmcnt(0)" ::: "memory");
    __syncthreads();
    if (threadIdx.x == 0) {
        unsigned* bar = b.bar;
        __builtin_amdgcn_s_waitcnt(0);
        unsigned nloc = b.st[0], nx = b.st[1];
        if (nloc == 0u) { xcd_barrier_complete(bar, b.x, nloc, nx); b.st[0] = nloc; b.st[1] = nx; }
        const unsigned old = xb_add(&bar[XB_XSUB(b.x)], 1u);
        const unsigned gen = old / nloc;
        if (old + 1u == (gen + 1u) * nloc) {
            __builtin_amdgcn_fence(__ATOMIC_RELEASE, "agent");
            asm volatile("s_waitcnt vmcnt(0)" ::: "memory");
            const unsigned og = xb_add(&bar[XB_TOP], 1u);
            const unsigned tg = og / nx;
            if (og + 1u == (tg + 1u) * nx) xb_add(&bar[XB_TOPGEN], 1u);
            else XB_SPIN(xb_ld(&bar[XB_TOPGEN]) == tg, bar);
            __builtin_amdgcn_fence(__ATOMIC_ACQUIRE, "agent");
            xb_add(&bar[XB_XGEN(b.x)], 1u);
            asm volatile("s_waitcnt vmcnt(0)" ::: "memory");
        } else {
            XB_SPIN(xb_ld(&bar[XB_XGEN(b.x)]) == gen, bar);
            __builtin_amdgcn_fence(__ATOMIC_ACQUIRE, "agent");
            asm volatile("s_waitcnt vmcnt(0)" ::: "memory");
        }
    }
    __syncthreads();
}

struct Args { const float* in[21]; float* out; unsigned char* ws; };

__device__ __forceinline__ void ln_phase(const float* Z, bf16* XN, float* ST, const float* g, const float* b, float* OUT, int gw, int NGW, int lane) {
    asm volatile("" : "+v"(lane));
    f32x4 gv[4], bv[4];
#pragma unroll
    for (int j = 0; j < 4; ++j) { gv[j] = *((const f32x4*)g + lane + 64 * j); bv[j] = *((const f32x4*)b + lane + 64 * j); }
    for (int row = gw; row < M; row += NGW) {
        const f32x4* zr = (const f32x4*)(Z + (size_t)row * D) + lane;
        f32x4 v[4]; float s = 0.f;
#pragma unroll
        for (int j = 0; j < 4; ++j) { v[j] = zr[64 * j]; s += (v[j].x + v[j].y) + (v[j].z + v[j].w); }
        const float mean = wave_sum(s) * (1.f / D); float s2 = 0.f;
#pragma unroll
        for (int j = 0; j < 4; ++j) { v[j] = v[j] - mean; s2 += (v[j].x * v[j].x + v[j].y * v[j].y) + (v[j].z * v[j].z + v[j].w * v[j].w); }
        const float rstd = 1.f / sqrtf(wave_sum(s2) * (1.f / D) + LN_EPS);
        if (OUT) {
            f32x4* orow = (f32x4*)(OUT + (size_t)row * D) + lane;
#pragma unroll
            for (int j = 0; j < 4; ++j) orow[64 * j] = v[j] * rstd * gv[j] + bv[j];
        } else {
            if (lane == 0) { ST[2 * row] = mean; ST[2 * row + 1] = rstd; }
            v2u* o8 = (v2u*)(XN + (size_t)row * D) + lane;
#pragma unroll
            for (int j = 0; j < 4; ++j) { const f32x4 y = v[j] * rstd * gv[j] + bv[j]; v2u w; w.x = pk2(y.x, y.y); w.y = pk2(y.z, y.w); o8[64 * j] = w; }
        }
    }
}

__global__ void __launch_bounds__(NWAVES * 64, 2) fwd_kernel(Args args) {
    extern __shared__ __attribute__((aligned(16))) unsigned char lds[];
    cg::grid_group grid = cg::this_grid();
    LAS unsigned char* L = (LAS unsigned char*)lds;
    const int tid = threadIdx.x, lane = tid & 63, wave = __builtin_amdgcn_readfirstlane(tid >> 6);
    const int G = gridDim.x, bx = blockIdx.x;
    const int vcu = (G % 8 == 0) ? (bx % 8) * (G / 8) + bx / 8 : bx;
    const int gw = vcu * NWAVES + wave, NGW = G * NWAVES;
    unsigned char* ws = args.ws;
    const float* x = args.in[0];
    const float *w_qkv = args.in[1], *w_o = args.in[2], *w_pw1 = args.in[8], *w_pw2 = args.in[14], *w_gate = args.in[16], *w_up = args.in[17], *w_down = args.in[18];
    float* PARW = (float*)(ws + WS_PAR); const float* PAR = PARW;
    const float *lq1 = PAR + PO_LQ1, *lk1 = PAR + PO_LK1, *lq2 = PAR + PO_LQ2, *lk2 = PAR + PO_LK2, *subln_g = PAR + PO_SUBG, *b_pw1 = PAR + PO_BPW1, *w_dw = PAR + PO_WDW, *b_dw = PAR + PO_BDW;
    const float *cln_g = PAR + PO_CLNG, *cln_b = PAR + PO_CLNB, *b_pw2 = PAR + PO_BPW2, *ln_g = PAR + PO_LNG, *ln_b = PAR + PO_LNB;
    float* ST = (float*)(ws + WS_ST); float* TAB = (float*)(ws + WS_TAB);
    bf16 *Wqkv_t = (bf16*)(ws + WS_WQKV), *Wo_t = (bf16*)(ws + WS_WO), *Wpw1_t = (bf16*)(ws + WS_PW1), *Wpw2_t = (bf16*)(ws + WS_PW2);
    bf16 *Wgu0 = (bf16*)(ws + WS_GU0), *Wgu1 = (bf16*)(ws + WS_GU1), *Wdn0 = (bf16*)(ws + WS_DN0), *Wdn1 = (bf16*)(ws + WS_DN1);
    bf16 *XN = (bf16*)(ws + WS_XN), *QB = (bf16*)(ws + WS_Q), *KB = (bf16*)(ws + WS_K), *VB = (bf16*)(ws + WS_V), *HB = (bf16*)(ws + WS_H), *GB = (bf16*)(ws + WS_G), *CB = (bf16*)(ws + WS_C);
    float* Z = (float*)(ws + WS_Z);

    volatile LAS unsigned* xbst = (volatile LAS unsigned*)(L + LDS_BYTES - 64);
    if (tid < 2) xbst[tid] = 0u;
    if (bx == 0) for (int u = tid; u < XCD_BAR_WORDS; u += NWAVES * 64) __hip_atomic_store((unsigned*)(ws + WS_BAR) + u, 0u, __ATOMIC_RELAXED, __HIP_MEMORY_SCOPE_AGENT);
    __syncthreads();
    {
        LAS float* scr = (LAS float*)(L + wave * 16384);
        constexpr int I_QKV = 16 * 96, I_O = 16 * 32, I_PW1 = 16 * 64, I_PW2 = 16 * 32, I_GU = 16 * 88, I_DN = 44 * 32;
        constexpr int NITEMS = I_QKV + I_O + I_PW1 + I_PW2 + 4 * I_GU + 2 * I_DN;
        for (int it = gw; it < NITEMS; it += NGW) {
            int r = it;
            if (r < I_QKV) { transpose_item(w_qkv, D, 3 * D, Wqkv_t, 1, scr, r, lane); continue; } r -= I_QKV;
            if (r < I_O) { transpose_item(w_o, D, D, Wo_t, 0, scr, r, lane); continue; } r -= I_O;
            if (r < I_PW1) { transpose_item(w_pw1, D, 2 * D, Wpw1_t, 2, scr, r, lane); continue; } r -= I_PW1;
            if (r < I_PW2) { transpose_item(w_pw2, D, D, Wpw2_t, 0, scr, r, lane); continue; } r -= I_PW2;
            if (r < I_GU) { transpose_item(w_gate, D, FF, Wgu0, 3, scr, r, lane); continue; } r -= I_GU;
            if (r < I_GU) { transpose_item(w_up, D, FF, Wgu0, 4, scr, r, lane); continue; } r -= I_GU;
            if (r < I_GU) { transpose_item(w_gate + (size_t)D * FF, D, FF, Wgu1, 3, scr, r, lane); continue; } r -= I_GU;
            if (r < I_GU) { transpose_item(w_up + (size_t)D * FF, D, FF, Wgu1, 4, scr, r, lane); continue; } r -= I_GU;
            if (r < I_DN) { transpose_item(w_down, FF, D, Wdn0, 0, scr, r, lane); continue; } r -= I_DN;
            transpose_item(w_down + (size_t)FF * D, FF, D, Wdn1, 0, scr, r, lane);
        }
        for (int row = gw; row < M; row += NGW) {
            const f32x4* xr = (const f32x4*)(x + (size_t)row * D) + lane; v2u* o8 = (v2u*)(XN + (size_t)row * D) + lane;
#pragma unroll
            for (int j = 0; j < 4; ++j) { const f32x4 y = xr[64 * j]; v2u w; w.x = pk2(y.x, y.y); w.y = pk2(y.z, y.w); o8[64 * j] = w; }
        }
        for (int e = bx * (NWAVES * 64) + tid; e < PO_END; e += G * NWAVES * 64) {
            float v;
            if (e < PO_LK1) v = args.in[3][e - PO_LQ1]; else if (e < PO_LQ2) v = args.in[4][e - PO_LK1]; else if (e < PO_LK2) v = args.in[5][e - PO_LQ2]; else if (e < PO_SUBG) v = args.in[6][e - PO_LK2];
            else if (e < PO_BPW1) v = args.in[7][e - PO_SUBG]; else if (e < PO_WDW) v = args.in[9][e - PO_BPW1]; else if (e < PO_BDW) v = args.in[10][e - PO_WDW]; else if (e < PO_CLNG) v = args.in[11][e - PO_BDW];
            else if (e < PO_CLNB) v = args.in[12][e - PO_CLNG]; else if (e < PO_BPW2) v = args.in[13][e - PO_CLNB]; else if (e < PO_LNG) v = args.in[15][e - PO_BPW2]; else if (e < PO_LNB) v = args.in[19][e - PO_LNG];
            else v = args.in[20][e - PO_LNB];
            PARW[e] = v;
        }
        for (int e = bx * (NWAVES * 64) + tid; e < SEQ * 32; e += G * NWAVES * 64) {
            const int pos = e >> 5, i = e & 31, i8 = i & 7, i3 = i >> 3;
            double c = (i8 == 0) ? 1.0 : (i8 == 1) ? 0.7498942093324559 : (i8 == 2) ? 0.5623413251903491 : (i8 == 3) ? 0.4216965034285822 : (i8 == 4) ? 0.31622776601683794 : (i8 == 5) ? 0.23713737056616552 : (i8 == 6) ? 0.1778279410038923 : 0.1333521432163324;
            c *= (i3 == 0) ? 1.0 : (i3 == 1) ? 0.1 : (i3 == 2) ? 0.01 : 0.001;
            const double rev = (double)pos * c * 0.15915494309189535;
            const float fr = (float)(rev - __builtin_floor(rev));
            TAB[pos * 64 + i] = __builtin_amdgcn_cosf(fr); TAB[pos * 64 + 32 + i] = __builtin_amdgcn_sinf(fr);
        }
    }
    grid.sync();
    const XcdBarrier xbar = xcd_barrier_post((unsigned*)(ws + WS_BAR), xbst);

    if (PHMASK & (1 << 1)) {
        pg8::Gemm g{XN, Wqkv_t, M, 3 * D, D}; pg8::StaticOrder S; S.init(M, 3 * D, G, bx);
        pg8::EpiQKV E{QB, KB, VB, TAB, 0.125f * 1.4426950408889634f};
        pg8::gemm_phase<pg8::EpiQKV, pg8::StaticOrder, true, true>(L, g, S, E);
    }
    xcd_barrier(xbar);

    if (PHMASK & (1 << 2)) {
        const float d1 = wave_sum(lq1[lane] * lk1[lane]), d2 = wave_sum(lq2[lane] * lk2[lane]);
        const float lam = __expf(d1) - __expf(d2) + 0.2f;
        for (int idx = vcu; idx < 1024; idx += G) {
            const int v = idx & 255, i = idx >> 8, bh = v >> 3, s = v & 7;
            const int qb = (i == 0) ? 31 - s : (i == 1) ? 16 + s : (i == 2) ? 15 - s : s;
            att::attn_unit(bh >> 3, bh & 7, qb, QB, KB, VB, XN, Z, L, lam, 0.8f, subln_g);
        }
    }
    xcd_barrier(xbar);

    if (PHMASK & (1 << 3)) {
        pg8::Gemm g{XN, Wo_t, M, D, D}; pg8::StaticOrder S; S.init(M, D, G, bx);
        pg8::EpiResid<0> E{x, Z, nullptr, nullptr, nullptr, nullptr, ALPHA};
        pg8::gemm_phase<pg8::EpiResid<0>, pg8::StaticOrder, true, true>(L, g, S, E);
    }
    xcd_barrier(xbar);
    ln_phase(Z, XN, ST, ln_g, ln_b, nullptr, gw, NGW, lane);
    xcd_barrier(xbar);

    for (int layer = 0; layer < 2; ++layer) {
        if (layer == 1) {
            if (PHMASK & (1 << 8)) {
                pg8::Gemm g{XN, Wpw1_t, M, 2 * D, D}; pg8::StaticOrder S; S.init(M, 2 * D, G, bx);
                pg8::EpiGLU E{GB, b_pw1};
                pg8::gemm_phase<pg8::EpiGLU, pg8::StaticOrder, true, true>(L, g, S, E);
            }
            xcd_barrier(xbar);
            if (PHMASK & (1 << 9)) {
                int ctid = threadIdx.x; asm volatile("" : "+v"(ctid));
                const int clane = ctid & 63, cwave = __builtin_amdgcn_readfirstlane(ctid >> 6);
                LAS unsigned* tile = (LAS unsigned*)L;
                LAS float* red = (LAS float*)(L + 126976);
                LAS float* stat = red + 512;
                const unsigned L0 = (unsigned)(uintptr_t)L;
                for (int unit = vcu; unit < M / 32; unit += G) {
                    const int row0 = unit * 32, s0 = row0 & (SEQ - 1);
                    int c2 = ctid; asm volatile("" : "+v"(c2));
                    float w0[31], w1[31];
#pragma unroll
                    for (int t = 0; t < 31; ++t) { const float2 wv = *(const float2*)(w_dw + t * D + 2 * c2); w0[t] = wv.x; w1[t] = wv.y; }
                    const float bd0 = b_dw[2 * c2], bd1 = b_dw[2 * c2 + 1];
                    for (int p = cwave; p < 124; p += NWAVES) { const int rr = p >> 1;
                        if (s0 == 0 && rr < 30) *(LAS v4u*)(L + p * 1024 + clane * 16) = (v4u){0u, 0u, 0u, 0u};
                        else pg8::glds_s(GB + (size_t)(row0 - 30 + rr) * D + (p & 1) * 512, (unsigned)clane * 16u, L0 + (unsigned)p * 1024u); }
                    asm volatile("s_waitcnt vmcnt(0)" ::: "memory");
                    __syncthreads();
                    float y0[32], y1[32];
#pragma unroll
                    for (int r = 0; r < 32; ++r) { y0[r] = bd0; y1[r] = bd1; }
#pragma unroll
                    for (int k = 0; k < 62; ++k) { const unsigned xk = tile[k * 512 + c2]; const float a0 = __uint_as_float(xk << 16), a1 = __uint_as_float(xk & 0xffff0000u);
#pragma unroll
                        for (int r = 0; r < 32; ++r) { const int t = k - r; if (t >= 0 && t <= 30) { y0[r] += w0[t] * a0; y1[r] += w1[t] * a1; } } }
                    float vals[64];
#pragma unroll
                    for (int r = 0; r < 32; ++r) { vals[2 * r] = y0[r] + y1[r]; vals[2 * r + 1] = y0[r] * y0[r] + y1[r] * y1[r]; }
#define CONV_BFLY(MK) do { const bool up = (clane & (MK)) != 0; _Pragma("unroll") for (int k = 0; k < (MK); ++k) { const float a = vals[k], b = vals[k + (MK)]; const float snd = up ? a : b, kp = up ? b : a; vals[k] = kp + __shfl_xor(snd, (MK)); } } while (0)
                    CONV_BFLY(32); CONV_BFLY(16); CONV_BFLY(8); CONV_BFLY(4); CONV_BFLY(2); CONV_BFLY(1);
#undef CONV_BFLY
                    red[cwave * 64 + clane] = vals[0];
                    __syncthreads();
                    if (ctid < 32) { float sm = 0.f, q = 0.f;
#pragma unroll
                        for (int w = 0; w < 8; ++w) { sm += red[w * 64 + 2 * ctid]; q += red[w * 64 + 2 * ctid + 1]; }
                        const float mean = sm * (1.f / D), var = q * (1.f / D) - mean * mean;
                        stat[2 * ctid] = mean; stat[2 * ctid + 1] = 1.f / sqrtf(fmaxf(var, 0.f) + LN_EPS); }
                    __syncthreads();
                    int c3 = ctid; asm volatile("" : "+v"(c3));
                    const float g0 = cln_g[2 * c3], g1 = cln_g[2 * c3 + 1], bb0 = cln_b[2 * c3], bb1 = cln_b[2 * c3 + 1];
                    unsigned* op = (unsigned*)(CB + (size_t)row0 * D) + c3;
#pragma unroll
                    for (int r = 0; r < 32; ++r) {
                        const float mean = stat[2 * r], rstd = stat[2 * r + 1];
                        float n0 = (y0[r] - mean) * rstd * g0 + bb0, n1 = (y1[r] - mean) * rstd * g1 + bb1;
                        n0 = n0 * __builtin_amdgcn_rcpf(1.0f + __builtin_amdgcn_exp2f(n0 * -1.4426950408889634f));
                        n1 = n1 * __builtin_amdgcn_rcpf(1.0f + __builtin_amdgcn_exp2f(n1 * -1.4426950408889634f));
                        op[r * 512] = pk2(n0, n1);
                    }
                }
                __syncthreads();
            }
            xcd_barrier(xbar);
            if (PHMASK & (1 << 10)) {
                pg8::Gemm g{CB, Wpw2_t, M, D, D}; pg8::StaticOrder S; S.init(M, D, G, bx);
                pg8::EpiResid<1> E{Z, Z, ST, ln_g + 1 * D, ln_b + 1 * D, b_pw2, ALPHA};
                pg8::gemm_phase<pg8::EpiResid<1>, pg8::StaticOrder, true, true>(L, g, S, E);
            }
            xcd_barrier(xbar);
            ln_phase(Z, XN, ST, ln_g + 2 * D, ln_b + 2 * D, nullptr, gw, NGW, lane);
            xcd_barrier(xbar);
        }
        if (PHMASK & (1 << 5)) {
            pg8::Gemm g{XN, layer ? Wgu1 : Wgu0, M, 2 * FF, D}; pg8::StaticOrder S; S.init(M, 2 * FF, G, bx);
            pg8::EpiSwiGLU E{HB, FF};
            pg8::gemm_phase<pg8::EpiSwiGLU, pg8::StaticOrder, true, true>(L, g, S, E);
        }
        xcd_barrier(xbar);
        if (PHMASK & (1 << 6)) {
            pg8::Gemm g{HB, layer ? Wdn1 : Wdn0, M, D, FF}; pg8::StaticOrder S; S.init(M, D, G, bx);
            pg8::EpiResid<1> E{Z, Z, ST, ln_g + (2 * layer) * D, ln_b + (2 * layer) * D, nullptr, ALPHA};
            pg8::gemm_phase<pg8::EpiResid<1>, pg8::StaticOrder, true, true>(L, g, S, E);
        }
        xcd_barrier(xbar);
        if (layer == 0) { ln_phase(Z, XN, ST, ln_g + 1 * D, ln_b + 1 * D, nullptr, gw, NGW, lane); xcd_barrier(xbar); }
        else ln_phase(Z, nullptr, ST, ln_g + 3 * D, ln_b + 3 * D, args.out, gw, NGW, lane);
    }
}

extern "C" void kernel_launch(void* const* d_in, const int* in_sizes, int n_in, void* d_out, int out_size, void* d_ws, size_t ws_size, hipStream_t stream) {
    static int grid = 0;
    if (grid == 0) {
        if (n_in != 21 || out_size != M * D || ws_size < WS_END) { fprintf(stderr, "kernel_launch: unexpected shapes (n_in %d out %d ws %zu)\n", n_in, out_size, ws_size); grid = -1; return; }
        int dev = 0, cus = 0, per_cu = 0;
        hipGetDevice(&dev); hipDeviceGetAttribute(&cus, hipDeviceAttributeMultiprocessorCount, dev);
        if (hipFuncSetAttribute((const void*)fwd_kernel, hipFuncAttributeMaxDynamicSharedMemorySize, LDS_BYTES) != hipSuccess) { fprintf(stderr, "kernel_launch: hipFuncSetAttribute failed\n"); grid = -1; return; }
        hipOccupancyMaxActiveBlocksPerMultiprocessor(&per_cu, (const void*)fwd_kernel, NWAVES * 64, LDS_BYTES);
        (void)hipGetLastError();
        grid = cus * (per_cu > 0 ? 1 : 1);
        if (grid > 256) grid = 256;
        grid &= ~7;
        fprintf(stderr, "kernel_launch: cus %d per_cu %d grid %d\n", cus, per_cu, grid);
    }
    if (grid <= 0) return;
    Args a{};
    for (int i = 0; i < 21; ++i) a.in[i] = (const float*)d_in[i];
    a.out = (float*)d_out; a.ws = (unsigned char*)d_ws;
    void* kargs[] = {&a};
    hipError_t e = hipLaunchCooperativeKernel((const void*)fwd_kernel, dim3(grid), dim3(NWAVES * 64), kargs, LDS_BYTES, stream);
    if (e != hipSuccess) fprintf(stderr, "kernel_launch: cooperative launch failed: %s (grid %d)\n", hipGetErrorString(e), grid);
}
```

```cpp
#include <hip/hip_runtime.h>
#include <hip/hip_cooperative_groups.h>
#include <cstdio>
#include <cstdint>
namespace cg = cooperative_groups;
namespace pg8 {
#define PG8_LAS __attribute__((address_space(3)))
typedef unsigned short bf16_t;
typedef short bf16x8 __attribute__((ext_vector_type(8)));
typedef float f32x4 __attribute__((ext_vector_type(4)));
typedef unsigned u32x4 __attribute__((ext_vector_type(4)));
constexpr int BM = 256, BK = 64, HALF = 128, HTB = HALF * BK * 2  , STAGE_BYTES = 8 * HTB, NXCD = 8, WGM = 8;

__host__ __device__ __forceinline__ int lds_byte(int r, int c) { const int st = (r >> 4) * 2 + (c >> 5), rr = r & 15, cc = c & 31, ob = rr * 64 + cc * 2; return st * 1024 + (ob ^ (((ob >> 9) & 1) << 5)); }
__host__ __device__ __forceinline__ void stage_rc(int b, int& R, int& C) { const int st = b / 1024, sb = b % 1024, swz = sb ^ (((sb >> 9) & 1) << 5); R = (st >> 1) * 16 + swz / 64; C = (st & 1) * 32 + (swz % 64) / 2; }
__host__ __device__ __forceinline__ int perm32(int rho) { const int n = rho >> 4, i = rho & 15; return 8 * (i >> 2) + 4 * n + (i & 3); }

struct Unit { int pm, pn; };
struct Gemm { const bf16_t* A; const bf16_t* Bt; int M, N, K; };

struct StaticOrder {
    int nM, nN, nwg, G, c;
    __host__ __device__ void init(int M, int N, int G_, int c_) { nM = M / BM; nN = N / BM; nwg = nM * nN; G = G_; c = c_; }
    __host__ __device__ bool next(int i, Unit& u) const {
        const long L = (long)i * G + c; if (L >= nwg) return false;
        int wgid = (int)L; { const int q = nwg / NXCD, r = nwg % NXCD, xcd = wgid % NXCD, off = wgid / NXCD; wgid = (xcd < r ? xcd * (q + 1) : r * (q + 1) + (xcd - r) * q) + off; }
        const int nig = WGM * nN, gid = wgid / nig, fm = gid * WGM, gsz = (nM - fm) < WGM ? (nM - fm) : WGM;
        u.pm = fm + ((wgid % nig) % gsz); u.pn = (wgid % nig) / gsz; return true;
    }
    __device__ __forceinline__ void a_ready(const Unit&) const {}
    __device__ __forceinline__ void done(const Unit&) const {}
};

__device__ __forceinline__ unsigned cvt_pk_bf16(float lo, float hi) { unsigned r; asm volatile("v_cvt_pk_bf16_f32 %0, %1, %2" : "=v"(r) : "v"(lo), "v"(hi)); return r; }
__device__ __forceinline__ void glds_s(const void* sbase, unsigned voff, unsigned ldsdst) {
    unsigned keep;
    asm volatile("s_mov_b32 %0, m0\n\ts_mov_b32 m0, %3\n\ts_nop 0\n\tglobal_load_lds_dwordx4 %1, %2\n\ts_mov_b32 m0, %0" : "=&s"(keep) : "v"(voff), "s"(sbase), "s"(ldsdst) : "memory");
}
typedef float f32x2 __attribute__((ext_vector_type(2)));
__device__ __forceinline__ f32x2 gelu_pk(f32x2 v) {
    const f32x2 av = __builtin_elementwise_abs(v), d = av * 0.2316418882f + 1.0f;
    f32x2 t; t.x = __builtin_amdgcn_rcpf(d.x); t.y = __builtin_amdgcn_rcpf(d.y);
    f32x2 q = t * 0.5307027145f + (-0.7265760135f); q = q * t + 0.7107068705f; q = q * t + (-0.142248368f); q = q * t + 0.127414796f; q = q * t;
    const f32x2 s = (v * v) * (-0.72134752044f);
    f32x2 e; e.x = __builtin_amdgcn_exp2f(s.x); e.y = __builtin_amdgcn_exp2f(s.y);
    const f32x2 m = v * (q * e), r = v - m;
    f32x2 o; o.x = v.x < 0.f ? m.x : r.x; o.y = v.y < 0.f ? m.y : r.y; return o;
}

template <int ACT  > struct EpiBf16 {
    static constexpr bool PERM = true, AFTER_DRAIN = false; static_assert(ACT == 0 || ACT == 1, "EpiBf16: ACT is 0 (none) or 1 (gelu_pk)");
    bf16_t* O; int ldc; const float* bias; int split_cols; size_t split_stride; float scale0;
    __device__ __forceinline__ void operator()(const f32x4 (&acc)[2][2][4][2], const Unit& u, int wr, int wc, int fr_in, int fq_in) const {
        int fr = fr_in, fq = fq_in; asm volatile("" : "+v"(fr), "+v"(fq));
        const int row0 = u.pm * BM + wr * 64 + fr; int colt = u.pn * BM; bf16_t* base = O;
        float sc = 1.f; if (split_cols) { const int t = colt / split_cols; base += (size_t)t * split_stride; colt -= t * split_cols; if (t == 0) sc = scale0; }
        const int col0 = colt + wc * 32 + 8 * fq, bcol0 = u.pn * BM + wc * 32 + 8 * fq;
        f32x4 bv[2][2];
#pragma unroll
        for (int bj = 0; bj < 2; ++bj)
#pragma unroll
            for (int n = 0; n < 2; ++n) bv[bj][n] = bias ? *(const f32x4*)(bias + bcol0 + bj * HALF + 4 * n) : (f32x4){0.f, 0.f, 0.f, 0.f};
#pragma unroll
        for (int ai = 0; ai < 2; ++ai)
#pragma unroll
            for (int m = 0; m < 4; ++m) { bf16_t* rowp = base + (size_t)(row0 + ai * HALF + m * 16) * ldc + col0;
#pragma unroll
                for (int bj = 0; bj < 2; ++bj) { f32x4 v0 = acc[ai][bj][m][0] + bv[bj][0], v1 = acc[ai][bj][m][1] + bv[bj][1];
                    if (ACT == 1) { f32x2 a = gelu_pk((f32x2){v0[0], v0[1]}), b = gelu_pk((f32x2){v0[2], v0[3]}), c = gelu_pk((f32x2){v1[0], v1[1]}), d = gelu_pk((f32x2){v1[2], v1[3]});
                        v0 = (f32x4){a.x, a.y, b.x, b.y}; v1 = (f32x4){c.x, c.y, d.x, d.y}; }
                    v0 = v0 * sc; v1 = v1 * sc; u32x4 w; w.x = cvt_pk_bf16(v0[0], v0[1]); w.y = cvt_pk_bf16(v0[2], v0[3]); w.z = cvt_pk_bf16(v1[0], v1[1]); w.w = cvt_pk_bf16(v1[2], v1[3]);
                    *(u32x4*)(rowp + bj * HALF) = w; } }
    }
};
__device__ __forceinline__ u32x4 pack8(const f32x4 v0, const f32x4 v1) { u32x4 w; w.x = cvt_pk_bf16(v0[0], v0[1]); w.y = cvt_pk_bf16(v0[2], v0[3]); w.z = cvt_pk_bf16(v1[0], v1[1]); w.w = cvt_pk_bf16(v1[2], v1[3]); return w; }
__device__ __forceinline__ f32x4 sigm4(const f32x4 g) {
    f32x4 r;
#pragma unroll
    for (int i = 0; i < 4; ++i) r[i] = __builtin_amdgcn_rcpf(1.0f + __builtin_amdgcn_exp2f(g[i] * -1.4426950408889634f));
    return r;
}
struct EpiQKV {
    static constexpr bool PERM = true, AFTER_DRAIN = false;
    bf16_t* Q; bf16_t* Kb; bf16_t* V; const float* tab; float qscale;
    __device__ __forceinline__ void operator()(const f32x4 (&acc)[2][2][4][2], const Unit& u, int wr, int wc, int fr_in, int fq_in) const {
        int fr = fr_in, fq = fq_in; asm volatile("" : "+v"(fr), "+v"(fq));
        const int row0 = u.pm * BM + wr * 64 + fr;
        if (u.pn >= 8) {
            const int col0 = (u.pn - 8) * BM + wc * 32 + 8 * fq;
#pragma unroll
            for (int ai = 0; ai < 2; ++ai)
#pragma unroll
                for (int m = 0; m < 4; ++m) { bf16_t* rowp = V + (size_t)(row0 + ai * HALF + m * 16) * 1024 + col0;
#pragma unroll
                    for (int bj = 0; bj < 2; ++bj) *(u32x4*)(rowp + bj * HALF) = pack8(acc[ai][bj][m][0], acc[ai][bj][m][1]); }
        } else {
            bf16_t* dst = (u.pn >> 2) ? Kb : Q; const float sc = (u.pn >> 2) ? 1.0f : qscale;
            const int colbase = 64 * (4 * (u.pn & 3) + wc) + 8 * fq;
#pragma unroll
            for (int ai = 0; ai < 2; ++ai)
#pragma unroll
                for (int m = 0; m < 4; ++m) { const int row = row0 + ai * HALF + m * 16; const float* tp = tab + (size_t)(row & 8191) * 64 + 8 * fq;
                    const f32x4 c0 = *(const f32x4*)(tp), c1 = *(const f32x4*)(tp + 4), s0 = *(const f32x4*)(tp + 32), s1 = *(const f32x4*)(tp + 36);
                    const f32x4 x10 = acc[ai][0][m][0], x11 = acc[ai][0][m][1], x20 = acc[ai][1][m][0], x21 = acc[ai][1][m][1];
                    const f32x4 o10 = (x10 * c0 - x20 * s0) * sc, o11 = (x11 * c1 - x21 * s1) * sc, o20 = (x20 * c0 + x10 * s0) * sc, o21 = (x21 * c1 + x11 * s1) * sc;
                    bf16_t* rowp = dst + (size_t)row * 1024 + colbase;
                    *(u32x4*)(rowp) = pack8(o10, o11); *(u32x4*)(rowp + 32) = pack8(o20, o21); asm volatile("" ::: "memory"); }
        }
    }
};
struct EpiSwiGLU {
    static constexpr bool PERM = true, AFTER_DRAIN = false;
    bf16_t* H; int ldc;
    __device__ __forceinline__ void operator()(const f32x4 (&acc)[2][2][4][2], const Unit& u, int wr, int wc, int fr_in, int fq_in) const {
        int fr = fr_in, fq = fq_in; asm volatile("" : "+v"(fr), "+v"(fq));
        const int row0 = u.pm * BM + wr * 64 + fr, col0 = u.pn * HALF + wc * 32 + 8 * fq;
#pragma unroll
        for (int ai = 0; ai < 2; ++ai)
#pragma unroll
            for (int m = 0; m < 4; ++m) { bf16_t* rowp = H + (size_t)(row0 + ai * HALF + m * 16) * ldc + col0;
                const f32x4 g0 = acc[ai][0][m][0], g1 = acc[ai][0][m][1];
                const f32x4 h0 = g0 * sigm4(g0) * acc[ai][1][m][0], h1 = g1 * sigm4(g1) * acc[ai][1][m][1];
                *(u32x4*)(rowp) = pack8(h0, h1); __builtin_amdgcn_sched_barrier(0); }
    }
};
struct EpiGLU {
    static constexpr bool PERM = true, AFTER_DRAIN = false;
    bf16_t* G; const float* bias;
    __device__ __forceinline__ void operator()(const f32x4 (&acc)[2][2][4][2], const Unit& u, int wr, int wc, int fr_in, int fq_in) const {
        int fr = fr_in, fq = fq_in; asm volatile("" : "+v"(fr), "+v"(fq));
        const int row0 = u.pm * BM + wr * 64 + fr, col0 = u.pn * HALF + wc * 32 + 8 * fq;
#pragma unroll
        for (int ai = 0; ai < 2; ++ai)
#pragma unroll
            for (int m = 0; m < 4; ++m) { bf16_t* rowp = G + (size_t)(row0 + ai * HALF + m * 16) * 1024 + col0;
                const f32x4 ba0 = *(const f32x4*)(bias + col0), ba1 = *(const f32x4*)(bias + col0 + 4), bg0 = *(const f32x4*)(bias + 1024 + col0), bg1 = *(const f32x4*)(bias + 1024 + col0 + 4);
                const f32x4 h0 = (acc[ai][0][m][0] + ba0) * sigm4(acc[ai][1][m][0] + bg0), h1 = (acc[ai][0][m][1] + ba1) * sigm4(acc[ai][1][m][1] + bg1);
                *(u32x4*)(rowp) = pack8(h0, h1); asm volatile("" ::: "memory"); __builtin_amdgcn_sched_barrier(0); }
    }
};
template <int MODE> struct EpiResid {
    static constexpr bool PERM = false, AFTER_DRAIN = false;
    const float* xin; float* out; const float* st; const float* g; const float* b; const float* bias; float alpha;
    __device__ __forceinline__ void operator()(const f32x4 (&acc)[2][2][4][2], const Unit& u, int wr, int wc, int fr_in, int fq_in) const {
        int fr = fr_in, fq = fq_in; asm volatile("" : "+v"(fr), "+v"(fq));
        const int col0 = u.pn * BM + wc * 32 + 4 * fq;
#pragma unroll
        for (int bj = 0; bj < 2; ++bj)
#pragma unroll
            for (int n = 0; n < 2; ++n) { const int c = col0 + bj * HALF + n * 16;
                const f32x4 cv = bias ? *(const f32x4*)(bias + c) : (f32x4){0.f, 0.f, 0.f, 0.f};
                f32x4 gv = cv, bv = cv; if (MODE == 1) { gv = *(const f32x4*)(g + c); bv = *(const f32x4*)(b + c); }
#pragma unroll
                for (int ai = 0; ai < 2; ++ai)
#pragma unroll
                    for (int m = 0; m < 4; ++m) { const int row = u.pm * BM + ai * HALF + wr * 64 + m * 16 + fr; const size_t off = (size_t)row * 1024 + c;
                        f32x4 xv = *(const f32x4*)(xin + off);
                        if (MODE == 1) { const float mean = st[2 * row], rstd = st[2 * row + 1]; xv = (xv - mean) * rstd * gv + bv; }
                        *(f32x4*)(out + off) = xv * alpha + acc[ai][bj][m][n] + cv;
                        if (m & 1) asm volatile("" ::: "memory"); }
            }
    }
};

template <class Epi, class Sched, bool ALIGN_EPI = false, bool SP2 = false>
__device__ __forceinline__ void gemm_phase(PG8_LAS unsigned char* lds, const Gemm g, const Sched& S, const Epi& E) {
    int tid_l = threadIdx.x; asm volatile("" : "+v"(tid_l));
    const int tid = tid_l, wid = __builtin_amdgcn_readfirstlane(tid >> 6), lane = tid & 63, wr = wid >> 2, wc = wid & 3, fr = lane & 15, fq = lane >> 4;
    const int K = g.K, nt = K / BK;
    unsigned voffA[2], voffB[2];
#pragma unroll
    for (int i = 0; i < 2; ++i) { int R, C; stage_rc(tid * 16 + i * 8192, R, C); const int Rb = Epi::PERM ? ((R & ~31) + perm32(R & 31)) : R;
        voffA[i] = (unsigned)(R * K + C) * 2u; voffB[i] = (unsigned)(Rb * K + C) * 2u; }
    const size_t kstep = (size_t)(BK * 2);
    const size_t hstep = (size_t)HALF * K * 2;
    const size_t tstep = 2 * hstep;
    const unsigned ldsbase_ = (unsigned)(uintptr_t)lds;
    const unsigned ldsw = (unsigned)wid * 1024u;
    const int aoff = lds_byte(wr * 64 + fr, fq * 8), boff = lds_byte(wc * 32 + fr, fq * 8);
#define PG8_SA(b, h) (((b) * 2 + (h)) * HTB)
#define PG8_SB(b, h) ((4 + (b) * 2 + (h)) * HTB)
#define PG8_STAGE(bufoff, gbase, voff) do { _Pragma("unroll") for (int _i = 0; _i < 2; ++_i) \
        glds_s((const void*)(gbase), (voff)[_i], ldsbase_ + (unsigned)(bufoff) + ldsw + (unsigned)_i * 8192u); } while (0)
#define PG8_LDA(dst, b, h) do { _Pragma("unroll") for (int m = 0; m < 4; ++m) _Pragma("unroll") for (int k = 0; k < 2; ++k) dst[m][k] = *(const PG8_LAS bf16x8*)(lds + PG8_SA(b, h) + aoff + m * 2048 + k * 1024); } while (0)
#define PG8_LDB(dst, b, h) do { _Pragma("unroll") for (int n = 0; n < 2; ++n) _Pragma("unroll") for (int k = 0; k < 2; ++k) dst[n][k] = *(const PG8_LAS bf16x8*)(lds + PG8_SB(b, h) + boff + n * 2048 + k * 1024); } while (0)
#define PG8_MMA(ai, bj, At, Bt) do { __builtin_amdgcn_s_setprio(1); _Pragma("unroll") for (int m = 0; m < 4; ++m) _Pragma("unroll") for (int n = 0; n < 2; ++n) _Pragma("unroll") for (int k = 0; k < 2; ++k) \
        acc[ai][bj][m][n] = __builtin_amdgcn_mfma_f32_16x16x32_bf16(Bt[n][k], At[m][k], acc[ai][bj][m][n], 0, 0, 0); __builtin_amdgcn_s_setprio(0); } while (0)
#define PG8_WAIT_V(n) asm volatile("s_waitcnt vmcnt(" #n ")" ::: "memory")
#define PG8_WAIT_L(n) asm volatile("s_waitcnt lgkmcnt(" #n ")" ::: "memory")
#define PG8_BAR __builtin_amdgcn_s_barrier()
#define PG8_SCHED __builtin_amdgcn_sched_barrier(0)
    Unit cur, nxt; int ui = 0;
    if (!S.next(0, cur)) return;
    f32x4 acc[2][2][4][2];
#pragma unroll
    for (int a = 0; a < 2; ++a)
#pragma unroll
        for (int b = 0; b < 2; ++b)
#pragma unroll
            for (int m = 0; m < 4; ++m)
#pragma unroll
                for (int n = 0; n < 2; ++n) acc[a][b][m][n] = (f32x4){0.f, 0.f, 0.f, 0.f};
    bf16x8 At[4][2], B0[2][2], B1[2][2];
    const char* cA = (const char*)g.A + (size_t)cur.pm * tstep; const char* cB = (const char*)g.Bt + (size_t)cur.pn * tstep;
    S.a_ready(cur);
    if constexpr (SP2) {
        PG8_STAGE(PG8_SB(0, 0), cB, voffB); PG8_SCHED; PG8_STAGE(PG8_SB(0, 1), cB + hstep, voffB); PG8_SCHED; PG8_STAGE(PG8_SA(0, 0), cA, voffA); PG8_SCHED; PG8_STAGE(PG8_SA(0, 1), cA + hstep, voffA); PG8_SCHED;
        if (wr == 1) PG8_BAR;
        PG8_WAIT_V(2); PG8_BAR; PG8_SCHED;
        PG8_STAGE(PG8_SB(1, 0), cB + kstep, voffB); PG8_SCHED; PG8_STAGE(PG8_SA(1, 0), cA + kstep, voffA); PG8_SCHED; PG8_STAGE(PG8_SB(1, 1), cB + hstep + kstep, voffB); PG8_SCHED;
        PG8_WAIT_V(6); PG8_BAR; PG8_SCHED;
    } else {
        PG8_STAGE(PG8_SB(0, 0), cB, voffB); PG8_STAGE(PG8_SA(0, 0), cA, voffA); PG8_STAGE(PG8_SB(0, 1), cB + hstep, voffB); PG8_STAGE(PG8_SA(0, 1), cA + hstep, voffA);
        if (wr == 1) PG8_BAR;
        PG8_WAIT_V(4); PG8_BAR;
        PG8_STAGE(PG8_SB(1, 0), cB + kstep, voffB); PG8_STAGE(PG8_SA(1, 0), cA + kstep, voffA); PG8_STAGE(PG8_SB(1, 1), cB + hstep + kstep, voffB);
        PG8_WAIT_V(6); PG8_BAR;
    }
    for (;;) {
        const bool has_next = S.next(ui + 1, nxt);
        const char* nA = has_next ? (const char*)g.A + (size_t)nxt.pm * tstep : cA; const char* nB = has_next ? (const char*)g.Bt + (size_t)nxt.pn * tstep : cB;
        for (int t = 0; t < nt; t += 2) {
            const bool last = (t == nt - 2);
            const char* a1 = cA + (size_t)(t + 1) * kstep;
            const char* a2 = last ? nA : cA + (size_t)(t + 2) * kstep; const char* b2 = last ? nB : cB + (size_t)(t + 2) * kstep;
            const char* a3 = a2 + kstep; const char* b3 = b2 + kstep;
            if (last && has_next) S.a_ready(nxt);
            if constexpr (SP2) {
            PG8_LDB(B0, 0, 0); PG8_LDB(B1, 0, 1); PG8_SCHED; PG8_LDA(At, 0, 0); PG8_STAGE(PG8_SA(1, 1), a1 + hstep, voffA);
            PG8_WAIT_V(8); PG8_WAIT_L(0); PG8_BAR; PG8_MMA(0, 0, At, B0); PG8_MMA(0, 1, At, B1); PG8_BAR; PG8_SCHED;
            PG8_LDA(At, 0, 1); PG8_STAGE(PG8_SB(0, 0), b2, voffB); PG8_STAGE(PG8_SB(0, 1), b2 + hstep, voffB); PG8_STAGE(PG8_SA(0, 0), a2, voffA);
            PG8_WAIT_V(8); PG8_WAIT_L(0); PG8_BAR; PG8_MMA(1, 0, At, B0); PG8_MMA(1, 1, At, B1); PG8_BAR; PG8_SCHED;
            PG8_LDB(B0, 1, 0); PG8_LDB(B1, 1, 1); PG8_SCHED; PG8_LDA(At, 1, 0); PG8_STAGE(PG8_SA(0, 1), a2 + hstep, voffA);
            PG8_WAIT_V(8); PG8_WAIT_L(0); PG8_BAR; PG8_MMA(0, 0, At, B0); PG8_MMA(0, 1, At, B1); PG8_BAR; PG8_SCHED;
            PG8_LDA(At, 1, 1); PG8_STAGE(PG8_SB(1, 0), b3, voffB); PG8_STAGE(PG8_SB(1, 1), b3 + hstep, voffB); PG8_STAGE(PG8_SA(1, 0), a3, voffA);
            PG8_WAIT_V(8); PG8_WAIT_L(0); PG8_BAR; PG8_MMA(1, 0, At, B0); PG8_MMA(1, 1, At, B1); PG8_BAR; PG8_SCHED;
            } else {
            PG8_LDB(B0, 0, 0); PG8_SCHED; PG8_LDA(At, 0, 0); PG8_STAGE(PG8_SA(1, 1), a1 + hstep, voffA);
            PG8_WAIT_L(8); PG8_BAR; PG8_WAIT_L(0); PG8_MMA(0, 0, At, B0); PG8_BAR; PG8_SCHED;
            PG8_LDB(B1, 0, 1); PG8_STAGE(PG8_SB(0, 0), b2, voffB);
            PG8_BAR; PG8_WAIT_L(0); PG8_MMA(0, 1, At, B1); PG8_BAR;
            PG8_LDA(At, 0, 1); PG8_STAGE(PG8_SA(0, 0), a2, voffA);
            PG8_BAR; PG8_WAIT_L(0); PG8_MMA(1, 0, At, B0); PG8_BAR; PG8_SCHED;
            PG8_STAGE(PG8_SB(0, 1), b2 + hstep, voffB);
            PG8_WAIT_V(6); PG8_BAR; PG8_MMA(1, 1, At, B1); PG8_BAR;
            PG8_LDB(B0, 1, 0); PG8_SCHED; PG8_LDA(At, 1, 0); PG8_STAGE(PG8_SA(0, 1), a2 + hstep, voffA);
            PG8_WAIT_L(8); PG8_BAR; PG8_WAIT_L(0); PG8_MMA(0, 0, At, B0); PG8_BAR; PG8_SCHED;
            PG8_LDB(B1, 1, 1); PG8_STAGE(PG8_SB(1, 0), b3, voffB);
            PG8_BAR; PG8_WAIT_L(0); PG8_MMA(0, 1, At, B1); PG8_BAR;
            PG8_LDA(At, 1, 1); PG8_STAGE(PG8_SA(1, 0), a3, voffA);
            PG8_BAR; PG8_WAIT_L(0); PG8_MMA(1, 0, At, B0); PG8_BAR; PG8_SCHED;
            PG8_STAGE(PG8_SB(1, 1), b3 + hstep, voffB);
            PG8_WAIT_V(6); PG8_BAR; PG8_MMA(1, 1, At, B1); PG8_BAR;
            }
        }
        if constexpr (ALIGN_EPI) { if (wr == 0) PG8_BAR; }
        if constexpr (!Epi::AFTER_DRAIN) { E(acc, cur, wr, wc, fr, fq); S.done(cur); }
        if (!has_next) break;
#pragma unroll
        for (int a = 0; a < 2; ++a)
#pragma unroll
            for (int b = 0; b < 2; ++b)
#pragma unroll
                for (int m = 0; m < 4; ++m)
#pragma unroll
                    for (int n = 0; n < 2; ++n) acc[a][b][m][n] = (f32x4){0.f, 0.f, 0.f, 0.f};
        cur = nxt; cA = nA; cB = nB; ++ui;
        if constexpr (ALIGN_EPI) { if (wr == 1) PG8_BAR; }
    }
    PG8_WAIT_V(0);
    if constexpr (!ALIGN_EPI) { if (wr == 0) PG8_BAR; }
    PG8_BAR;
    if constexpr (Epi::AFTER_DRAIN) { E.fused(acc, cur, wr, wc, fr, fq, lds, wid, lane); S.done(cur); }
#undef PG8_SA
#undef PG8_SB
#undef PG8_STAGE
#undef PG8_LDA
#undef PG8_LDB
#undef PG8_MMA
#undef PG8_WAIT_V
#undef PG8_WAIT_L
#undef PG8_BAR
#undef PG8_SCHED
}
}

namespace att {
#define ALAS __attribute__((address_space(3)))
typedef unsigned short bf16_t;
typedef short bf16x8 __attribute__((ext_vector_type(8)));
typedef short s16x4 __attribute__((ext_vector_type(4)));
typedef short v4i16_t __attribute__((ext_vector_type(4)));
typedef float f32x16 __attribute__((ext_vector_type(16)));
typedef float f32x4 __attribute__((ext_vector_type(4)));
typedef unsigned u32x4 __attribute__((ext_vector_type(4)));
constexpr int SEQ = 8192, PITCH = 1024;
constexpr int KBYTES = 8192, VBYTES = 16384, VOFF0 = 3 * KBYTES, WSF_OFF = VOFF0 + 3 * VBYTES, STG_OFF = WSF_OFF + 8 * 64 * 4, LDS_BYTES = STG_OFF + 8 * 8192;
#ifndef ATT_GRP_SHIFT
#define ATT_GRP_SHIFT 2
#endif
__device__ __forceinline__ int crow(int r, int hi) { return (r & 3) + 8 * (r >> 2) + 4 * hi; }
__device__ __forceinline__ unsigned f2bf(float f) { unsigned u = __builtin_bit_cast(unsigned, f); return (u + 0x7fffu + ((u >> 16) & 1u)) >> 16; }
__device__ __forceinline__ s16x4 vtr(const ALAS unsigned char* p) { return __builtin_bit_cast(s16x4, __builtin_amdgcn_ds_read_tr16_b64_v4i16((ALAS v4i16_t*)p)); }
__device__ __forceinline__ float swapsum(float v) { auto rr = __builtin_amdgcn_permlane32_swap(__float_as_uint(v), __float_as_uint(v), false, false); return __uint_as_float(rr[0]) + __uint_as_float(rr[1]); }
__device__ __forceinline__ float swapmax(float v) { auto rr = __builtin_amdgcn_permlane32_swap(__float_as_uint(v), __float_as_uint(v), false, false); return fmaxf(__uint_as_float(rr[0]), __uint_as_float(rr[1])); }
__device__ __forceinline__ float max3f(float a, float b, float c) { float r; asm("v_max3_f32 %0, %1, %2, %3" : "=v"(r) : "v"(a), "v"(b), "v"(c)); return r; }
__device__ __forceinline__ float max2f(float a, float b) { float r; asm("v_max_f32_e32 %0, %1, %2" : "=v"(r) : "v"(a), "v"(b)); return r; }
#define ATT_GLDS(g, l) __builtin_amdgcn_global_load_lds((const unsigned*)(g), (ALAS unsigned*)(l), 16, 0, 0)
#define ATT_LWAIT() asm volatile("s_waitcnt lgkmcnt(0)" ::: "memory")

__device__ __forceinline__ void attn_unit(int b, int h, int qb, const bf16_t* Q, const bf16_t* K, const bf16_t* V, bf16_t* O, float* scr, ALAS unsigned char* shm, float lam, float outscale, const float* subg) {
    int tid_l = threadIdx.x; asm volatile("" : "+v"(tid_l));
    const int tid = tid_l, lane = tid & 63, r32 = lane & 31, hi = lane >> 5; const int wid = __builtin_amdgcn_readfirstlane(tid >> 6);
    const size_t rowbase = (size_t)b * SEQ; const int q0 = qb * 256;
    const int NT = 4 * qb + 4, cw = 4 * qb + (wid >> 1);
    const unsigned shm0 = (unsigned)(uintptr_t)shm;
    ALAS float* wsf = (ALAS float*)(shm + WSF_OFF) + wid * 64;
    float* myscr = scr + ((((rowbase + q0) >> 5) + wid) * 8 + h) * 4096;
    f32x16 o[4];
    for (int m = 0; m < 2; ++m) {
        const bf16_t* Qw = Q + (rowbase + q0 + wid * 32) * PITCH + h * 128 + m * 64;
        const bf16_t* ksrc = K + rowbase * PITCH + h * 128 + m * 64 + wid * 8;
        const bf16_t* vsrc = V + (rowbase + 16 * (wid & 3)) * PITCH + h * 128 + (wid >> 2) * 32;
        const unsigned koff = (unsigned)lane * (PITCH * 2), voff = (unsigned)(lane >> 2) * (PITCH * 2) + (unsigned)(lane & 3) * 16u;
        bf16x8 qr[4];
        unsigned qoff = (unsigned)r32 * (PITCH * 2) + (unsigned)hi * 16u; asm volatile("" : "+v"(qoff));
#pragma unroll
        for (int d0 = 0; d0 < 4; ++d0) qr[d0] = *(const bf16x8*)((const char*)Qw + (qoff + (unsigned)d0 * 32u));
        float mhat = 0.f, l = 0.f; f32x16 negm;
#pragma unroll
        for (int r = 0; r < 16; ++r) negm[r] = 0.f;
#pragma unroll
        for (int d0 = 0; d0 < 4; ++d0)
#pragma unroll
            for (int r = 0; r < 16; ++r) o[d0][r] = 0.f;
        bf16x8 pw[4];
#pragma unroll
        for (int ks = 0; ks < 4; ++ks) pw[ks] = (bf16x8){0, 0, 0, 0, 0, 0, 0, 0};
#define ATT_DMA(t, koffs, voffs) do { const size_t go_ = (size_t)(t) * 64 * PITCH; pg8::glds_s(ksrc + go_, koff, shm0 + (unsigned)(koffs) + (unsigned)wid * 1024u); \
            pg8::glds_s(vsrc + go_, voff, shm0 + (unsigned)(voffs) + (unsigned)wid * 1024u); pg8::glds_s(vsrc + go_ + 64, voff, shm0 + (unsigned)(voffs) + (unsigned)(wid + 8) * 1024u); } while (0)
#define ATT_QK(P0, P1, koffs) do { \
            const ALAS unsigned char* kb = shm + (koffs) + hi * 1024 + r32 * 16; \
            bf16x8 kf[8]; \
            _Pragma("unroll") for (int d0 = 0; d0 < 4; ++d0) { kf[2 * d0] = *(const ALAS bf16x8*)(kb + d0 * 2048); kf[2 * d0 + 1] = *(const ALAS bf16x8*)(kb + d0 * 2048 + 512); } \
            P0 = __builtin_amdgcn_mfma_f32_32x32x16_bf16(kf[0], qr[0], negm, 0, 0, 0); P1 = __builtin_amdgcn_mfma_f32_32x32x16_bf16(kf[1], qr[0], negm, 0, 0, 0); \
            _Pragma("unroll") for (int d0 = 1; d0 < 4; ++d0) { P0 = __builtin_amdgcn_mfma_f32_32x32x16_bf16(kf[2 * d0], qr[d0], P0, 0, 0, 0); P1 = __builtin_amdgcn_mfma_f32_32x32x16_bf16(kf[2 * d0 + 1], qr[d0], P1, 0, 0, 0); } \
        } while (0)
#define ATT_FIN(P0, P1) do { \
            float sacc = 0.f; \
            _Pragma("unroll") for (int r = 0; r < 16; ++r) { P1[r] = __builtin_amdgcn_exp2f(P1[r]); sacc += P0[r] + P1[r]; } \
            l += sacc; \
            _Pragma("unroll") for (int ks = 0; ks < 4; ++ks) { u32x4 w; \
                _Pragma("unroll") for (int i = 0; i < 4; ++i) { const int r = 8 * (ks & 1) + 2 * i; const float a = (ks < 2) ? P0[r] : P1[r], c = (ks < 2) ? P0[r + 1] : P1[r + 1]; w[i] = pg8::cvt_pk_bf16(a, c); } \
                pw[ks] = __builtin_bit_cast(bf16x8, w); } \
        } while (0)
#define ATT_PART(P0, P1, j_) do { \
            float rma = max3f(P0[0], P0[1], P1[0]), rmb = max3f(P0[2], P0[3], P1[1]); rma = max3f(rma, P1[2], P1[3]); \
            _Pragma("unroll") for (int r = 4; r < 16; r += 4) { rma = max3f(rma, P0[r], P0[r + 1]); rmb = max3f(rmb, P0[r + 2], P0[r + 3]); rma = max3f(rma, P1[r], P1[r + 1]); rmb = max3f(rmb, P1[r + 2], P1[r + 3]); } \
            float rm = swapmax(max2f(rma, rmb)); \
            const bool first_ = ((j_) == 0); \
            if (first_ || __any(rm > 8.0f)) { \
                const float dl = first_ ? rm : fmaxf(rm, 0.f), f = first_ ? 1.0f : __builtin_amdgcn_exp2f(-dl); mhat += dl; l *= f; \
                _Pragma("unroll") for (int r = 0; r < 16; ++r) { P0[r] -= dl; P1[r] -= dl; negm[r] = -mhat; } \
                ATT_LWAIT(); \
                if (hi == 0) wsf[r32] = f; \
                ATT_LWAIT(); \
                _Pragma("unroll") for (int r = 0; r < 16; ++r) { const float fr_ = wsf[crow(r, hi)]; \
                    _Pragma("unroll") for (int d0 = 0; d0 < 4; ++d0) o[d0][r] *= fr_; } \
                ATT_LWAIT(); \
            } \
            _Pragma("unroll") for (int r = 0; r < 16; ++r) P0[r] = __builtin_amdgcn_exp2f(P0[r]); \
        } while (0)
#define ATT_PV(voffs) do { \
            const ALAS unsigned char* vp = shm + (voffs) + ((lane >> 4) & 1) * 32 + (lane & 3) * 8 + (4 * hi + ((lane & 15) >> 2)) * 64; \
            _Pragma("unroll") for (int ks = 0; ks < 4; ++ks) \
                _Pragma("unroll") for (int d0 = 0; d0 < 4; ++d0) { \
                    const s16x4 lo = vtr(vp + d0 * 4096 + ks * 1024), hh = vtr(vp + d0 * 4096 + ks * 1024 + 512); \
                    const bf16x8 vf = (bf16x8){lo[0], lo[1], lo[2], lo[3], hh[0], hh[1], hh[2], hh[3]}; \
                    o[d0] = __builtin_amdgcn_mfma_f32_32x32x16_bf16(pw[ks], vf, o[d0], 0, 0, 0); } \
        } while (0)
#define ATT_STEP(PC0, PC1, PP0, PP1, j_) do { const int jj = (j_); \
            if (jj + 1 < NT) asm volatile("s_waitcnt vmcnt(3)" ::: "memory"); else if (jj + 1 == NT) asm volatile("s_waitcnt vmcnt(2)" ::: "memory"); else asm volatile("s_waitcnt vmcnt(0)" ::: "memory"); \
            __syncthreads(); \
            if (jj + 2 < NT) { const size_t go_ = (size_t)(jj + 2) * 64 * PITCH; pg8::glds_s(ksrc + go_, koff, shm0 + (unsigned)(s2 * KBYTES) + (unsigned)wid * 1024u); } \
            if (jj + 1 < NT) { const size_t go_ = (size_t)(jj + 1) * 64 * PITCH; const unsigned vd_ = shm0 + (unsigned)(VOFF0 + s1 * VBYTES); \
                pg8::glds_s(vsrc + go_, voff, vd_ + (unsigned)wid * 1024u); pg8::glds_s(vsrc + go_ + 64, voff, vd_ + (unsigned)(wid + 8) * 1024u); } \
            if (jj <= cw) ATT_QK(PC0, PC1, s0 * KBYTES); \
            if (jj >= 1 && jj - 1 <= cw) { ATT_FIN(PP0, PP1); ATT_PV(VOFF0 + s2 * VBYTES); } \
            if (jj <= cw) ATT_PART(PC0, PC1, jj); \
            { const int t_ = s0; s0 = s1; s1 = s2; s2 = t_; } \
        } while (0)
        {
            asm volatile("s_waitcnt vmcnt(0)" ::: "memory");
            pg8::glds_s(ksrc, koff, shm0 + (unsigned)wid * 1024u);
            pg8::glds_s(ksrc + (size_t)64 * PITCH, koff, shm0 + (unsigned)KBYTES + (unsigned)wid * 1024u);
            pg8::glds_s(vsrc, voff, shm0 + (unsigned)VOFF0 + (unsigned)wid * 1024u); pg8::glds_s(vsrc + 64, voff, shm0 + (unsigned)VOFF0 + (unsigned)(wid + 8) * 1024u);
        }
        int s0 = 0, s1 = 1, s2 = 2;
        f32x16 pA0, pA1, pB0, pB1;
#pragma unroll
        for (int r = 0; r < 16; ++r) { pA0[r] = 0.f; pA1[r] = 0.f; pB0[r] = 0.f; pB1[r] = 0.f; }
        for (int j = 0; j <= NT; j += 2) {
            ATT_STEP(pA0, pA1, pB0, pB1, j);
            if (j + 1 <= NT) ATT_STEP(pB0, pB1, pA0, pA1, j + 1);
        }
        __syncthreads();
#undef ATT_QK
#undef ATT_FIN
#undef ATT_PART
#undef ATT_PV
#undef ATT_STEP
#undef ATT_DMA
        const float lt = swapsum(l);
        ATT_LWAIT();
        if (hi == 0) wsf[32 + r32] = 1.0f / lt;
        ATT_LWAIT();
        float rli[16];
#pragma unroll
        for (int r = 0; r < 16; ++r) rli[r] = wsf[32 + crow(r, hi)];
        ATT_LWAIT();
        int lane2 = lane; asm volatile("" : "+v"(lane2));
        float* sp = (float*)((char*)myscr + (unsigned)lane2 * 16u);
        if (m == 0) {
#pragma unroll
            for (int d0 = 0; d0 < 4; ++d0) {
#pragma unroll
                for (int r4 = 0; r4 < 4; ++r4) { f32x4 v;
#pragma unroll
                    for (int i = 0; i < 4; ++i) v[i] = o[d0][4 * r4 + i] * rli[4 * r4 + i];
                    *(f32x4*)(sp + (d0 * 4 + r4) * 256) = v; }
                asm volatile("" ::: "memory"); }
        } else {
            float ss[16];
#pragma unroll
            for (int r = 0; r < 16; ++r) ss[r] = 0.f;
#pragma unroll
            for (int d0 = 0; d0 < 4; ++d0) {
#pragma unroll
                for (int r4 = 0; r4 < 4; ++r4) { const f32x4 v0 = *(const f32x4*)(sp + (d0 * 4 + r4) * 256);
#pragma unroll
                    for (int i = 0; i < 4; ++i) { const int r = 4 * r4 + i; const float v = v0[i] - lam * (o[d0][r] * rli[r]); o[d0][r] = v; ss[r] += v * v; } }
                asm volatile("" ::: "memory"); }
#pragma unroll
            for (int r = 0; r < 16; ++r) {
#pragma unroll
                for (int k = 1; k < 32; k <<= 1) ss[r] += __shfl_xor(ss[r], k);
                ss[r] = __builtin_amdgcn_rsqf(ss[r] * (1.0f / 128.0f) + 1e-5f) * outscale;
            }
            ALAS unsigned char* stw = shm + STG_OFF + wid * 8192;
            ALAS unsigned short* stg = (ALAS unsigned short*)stw + (4 * hi) * 128 + r32;
#pragma unroll
            for (int d0 = 0; d0 < 4; ++d0) { const float gg = subg[32 * d0 + (lane2 & 31)];
#pragma unroll
                for (int r = 0; r < 16; ++r) stg[((r & 3) + 8 * (r >> 2)) * 128 + 32 * d0] = (unsigned short)f2bf(o[d0][r] * ss[r] * gg); }
            ATT_LWAIT();
            bf16_t* Ow = (bf16_t*)((char*)(O + (rowbase + q0 + wid * 32) * PITCH + h * 128) + ((unsigned)(lane2 >> 4) * (PITCH * 2) + (unsigned)(lane2 & 15) * 16u));
#pragma unroll
            for (int i = 0; i < 8; ++i) { const u32x4 v = *(const ALAS u32x4*)(stw + i * 1024 + lane2 * 16); *(u32x4*)(Ow + (size_t)i * 4 * PITCH) = v; }
            ATT_LWAIT();
        }
    }
}
}

#ifndef PHMASK
#define PHMASK 0xFFFF
#endif
constexpr int NWAVES = 8;
constexpr int M = 32768, D = 1024, FF = 2816, SEQ = 8192;
constexpr float LN_EPS = 1e-5f;
constexpr float ALPHA = 1.4142135623730951f;
constexpr size_t MiB = 1u << 20;
constexpr size_t WS_BAR = 0;
constexpr size_t WS_ST = 1 * MiB;
constexpr size_t WS_TAB = 2 * MiB;
constexpr size_t WS_WQKV = 4 * MiB, WS_WO = 10 * MiB, WS_PW1 = 12 * MiB, WS_PW2 = 16 * MiB, WS_GU0 = 18 * MiB, WS_GU1 = 29 * MiB, WS_DN0 = 40 * MiB, WS_DN1 = 46 * MiB;
constexpr size_t WS_PAR = 52 * MiB;
constexpr int PO_LQ1 = 0, PO_LK1 = 64, PO_LQ2 = 128, PO_LK2 = 192, PO_SUBG = 256, PO_BPW1 = 384, PO_WDW = 2432, PO_BDW = 34176, PO_CLNG = 35200, PO_CLNB = 36224, PO_BPW2 = 37248, PO_LNG = 38272, PO_LNB = 42368, PO_END = 46464;
constexpr size_t WS_XN = 64 * MiB;
constexpr size_t WS_Q = 128 * MiB, WS_K = 192 * MiB, WS_V = 256 * MiB;
constexpr size_t WS_H = 128 * MiB;
constexpr size_t WS_G = 128 * MiB, WS_C = 192 * MiB;
constexpr size_t WS_Z = 320 * MiB;
constexpr size_t WS_END = 448 * MiB;
constexpr int LDS_BYTES = 147456;

#define LAS __attribute__((address_space(3)))
typedef unsigned short bf16;
typedef unsigned v4u __attribute__((ext_vector_type(4)));
typedef unsigned v2u __attribute__((ext_vector_type(2)));
typedef float f32x4 __attribute__((ext_vector_type(4)));
#define LDS_WAIT() asm volatile("s_waitcnt lgkmcnt(0)" ::: "memory")
__device__ __forceinline__ unsigned f2bf(float f) { unsigned u = __builtin_bit_cast(unsigned, f); return (u + 0x7fffu + ((u >> 16) & 1u)) >> 16; }
__device__ __forceinline__ unsigned pk2(float lo, float hi) { return f2bf(lo) | (f2bf(hi) << 16); }
__device__ __forceinline__ float wave_sum(float v) {
#pragma unroll
    for (int o = 1; o < 64; o <<= 1) v += __shfl_xor(v, o);
    return v;
}
__device__ __forceinline__ int map_row(int mode, int n) {
    if (mode == 1) {
        if (n >= 2048) return n;
        const int region = n >> 10, within = n & 1023, slice = within >> 6, d = within & 63;
        return 256 * (region * 4 + (slice >> 2)) + 128 * (d >> 5) + 32 * (slice & 3) + (d & 31);
    }
    if (mode == 2) { const int half = n >> 10, j = n & 1023; return 256 * (j >> 7) + 128 * half + (j & 127); }
    if (mode == 3) return 256 * (n >> 7) + (n & 127);
    if (mode == 4) return 256 * (n >> 7) + 128 + (n & 127);
    return n;
}
__device__ __forceinline__ void transpose_item(const float* W, int K, int N, bf16* WT, int mode, LAS float* scr, int item, int lane) {
    const int nblk = N / 64, kb = item / nblk, nb = item % nblk, k0 = 64 * kb, n0 = 64 * nb;
    const float* src = W + (size_t)(k0 + (lane >> 4)) * N + n0 + 4 * (lane & 15);
    f32x4 v[16];
#pragma unroll
    for (int i = 0; i < 16; ++i) v[i] = *(const f32x4*)(src + (size_t)(4 * i) * N);
    LAS float* sw = scr + (lane >> 4) * 65 + 4 * (lane & 15);
#pragma unroll
    for (int i = 0; i < 16; ++i) { sw[(4 * i) * 65 + 0] = v[i].x; sw[(4 * i) * 65 + 1] = v[i].y; sw[(4 * i) * 65 + 2] = v[i].z; sw[(4 * i) * 65 + 3] = v[i].w; }
    LDS_WAIT(); asm volatile("" ::: "memory");
    const int c = lane & 7;
#pragma unroll
    for (int j = 0; j < 8; ++j) { const int n = (lane >> 3) + 8 * j; const LAS float* s = scr + (8 * c) * 65 + n;
        v4u o; o.x = pk2(s[0 * 65], s[1 * 65]); o.y = pk2(s[2 * 65], s[3 * 65]); o.z = pk2(s[4 * 65], s[5 * 65]); o.w = pk2(s[6 * 65], s[7 * 65]);
        *(v4u*)(WT + (size_t)map_row(mode, n0 + n) * K + k0 + 8 * c) = o; }
    LDS_WAIT(); asm volatile("" ::: "memory");
}

#define XB_TMO      128
#define XB_XCNT(j)  (256  + 64 * (j))
#define XB_XSUB(j)  (1280 + 64 * (j))
#define XB_XGEN(j)  (2304 + 64 * (j))
#define XB_TOP      3328
#define XB_TOPGEN   3392
#define XCD_BAR_WORDS 3456
#define XB_SPIN_CAP (1u << 18)

__device__ __forceinline__ unsigned xb_ld(unsigned* p)              { return __hip_atomic_load(p, __ATOMIC_RELAXED, __HIP_MEMORY_SCOPE_AGENT); }
__device__ __forceinline__ unsigned xb_add(unsigned* p, unsigned v) { return __hip_atomic_fetch_add(p, v, __ATOMIC_RELAXED, __HIP_MEMORY_SCOPE_AGENT); }
__device__ __forceinline__ unsigned xb_xcc_id() { return (unsigned)__builtin_amdgcn_s_getreg((3 << 11) | 20) & 0xFu; }
#define XB_SPIN(cond, bar) do { unsigned _sp = 0; while (cond) { __builtin_amdgcn_s_sleep(1); \
    if ((++_sp & 255u) == 0u) { if (xb_ld(&(bar)[XB_TMO])) break; if (_sp > XB_SPIN_CAP) { atomicAdd(&(bar)[XB_TMO], 1u); break; } } } } while (0)

struct XcdBarrier {
    unsigned* bar; unsigned x;
    volatile LAS unsigned* st;
};

__device__ __forceinline__ XcdBarrier xcd_barrier_post(unsigned* bar, volatile LAS unsigned* st) {
    XcdBarrier b; b.bar = bar; b.x = xb_xcc_id(); b.st = st;
    if (threadIdx.x == 0) (void)xb_add(&bar[XB_XCNT(b.x)], 1u);
    return b;
}
__device__ __forceinline__ void xcd_barrier_complete(unsigned* bar, unsigned x, unsigned& nloc, unsigned& nx) {
    const unsigned G = gridDim.x * gridDim.y * gridDim.z;
    unsigned sum, cnt, mine, sp = 0u;
    for (;;) {
        sum = 0u; cnt = 0u; mine = 0u;
#pragma unroll
        for (unsigned j = 0; j < 16; ++j) { const unsigned c = xb_ld(&bar[XB_XCNT(j)]); sum += c; cnt += (c > 0u) ? 1u : 0u; mine = (j == x) ? c : mine; }
        if (sum == G) break;
        __builtin_amdgcn_s_sleep(1);
        if ((++sp & 255u) == 0u) { if (xb_ld(&bar[XB_TMO])) break; if (sp > XB_SPIN_CAP) { atomicAdd(&bar[XB_TMO], 1u); break; } }
    }
    nloc = mine > 0u ? mine : 1u; nx = cnt > 0u ? cnt : 1u;
}

__device__ __forceinline__ void xcd_barrier(const XcdBarrier& b) {
    asm volatile("s_waitcnt vmcnt(0)" ::: "memory");
    __syncthreads();
    if (threadIdx.x == 0) {
        unsigned* bar = b.bar;
        __builtin_amdgcn_s_waitcnt(0);
        unsigned nloc = b.st[0], nx = b.st[1];
        if (nloc == 0u) { xcd_barrier_complete(bar, b.x, nloc, nx); b.st[0] = nloc; b.st[1] = nx; }
        const unsigned old = xb_add(&bar[XB_XSUB(b.x)], 1u);
        const unsigned gen = old / nloc;
        if (old + 1u == (gen + 1u) * nloc) {
            __builtin_amdgcn_fence(__ATOMIC_RELEASE, "agent");
            asm volatile("s_waitcnt vmcnt(0)" ::: "memory");
            const unsigned og = xb_add(&bar[XB_TOP], 1u);
            const unsigned tg = og / nx;
            if (og + 1u == (tg + 1u) * nx) xb_add(&bar[XB_TOPGEN], 1u);
            else XB_SPIN(xb_ld(&bar[XB_TOPGEN]) == tg, bar);
            __builtin_amdgcn_fence(__ATOMIC_ACQUIRE, "agent");
            xb_add(&bar[XB_XGEN(b.x)], 1u);
            asm volatile("s_waitcnt vmcnt(0)" ::: "memory");
        } else {
            XB_SPIN(xb_ld(&bar[XB_XGEN(b.x)]) == gen, bar);
            __builtin_amdgcn_fence(__ATOMIC_ACQUIRE, "agent");
            asm volatile("s_waitcnt vmcnt(0)" ::: "memory");
        }
    }
    __syncthreads();
}

struct Args { const float* in[21]; float* out; unsigned char* ws; };

__device__ __forceinline__ void ln_phase(const float* Z, bf16* XN, float* ST, const float* g, const float* b, float* OUT, int gw, int NGW, int lane) {
    asm volatile("" : "+v"(lane));
    f32x4 gv[4], bv[4];
#pragma unroll
    for (int j = 0; j < 4; ++j) { gv[j] = *((const f32x4*)g + lane + 64 * j); bv[j] = *((const f32x4*)b + lane + 64 * j); }
    for (int row = gw; row < M; row += NGW) {
        const f32x4* zr = (const f32x4*)(Z + (size_t)row * D) + lane;
        f32x4 v[4]; float s = 0.f;
#pragma unroll
        for (int j = 0; j < 4; ++j) { v[j] = zr[64 * j]; s += (v[j].x + v[j].y) + (v[j].z + v[j].w); }
        const float mean = wave_sum(s) * (1.f / D); float s2 = 0.f;
#pragma unroll
        for (int j = 0; j < 4; ++j) { v[j] = v[j] - mean; s2 += (v[j].x * v[j].x + v[j].y * v[j].y) + (v[j].z * v[j].z + v[j].w * v[j].w); }
        const float rstd = 1.f / sqrtf(wave_sum(s2) * (1.f / D) + LN_EPS);
        if (OUT) {
            f32x4* orow = (f32x4*)(OUT + (size_t)row * D) + lane;
#pragma unroll
            for (int j = 0; j < 4; ++j) orow[64 * j] = v[j] * rstd * gv[j] + bv[j];
        } else {
            if (lane == 0) { ST[2 * row] = mean; ST[2 * row + 1] = rstd; }
            v2u* o8 = (v2u*)(XN + (size_t)row * D) + lane;
#pragma unroll
            for (int j = 0; j < 4; ++j) { const f32x4 y = v[j] * rstd * gv[j] + bv[j]; v2u w; w.x = pk2(y.x, y.y); w.y = pk2(y.z, y.w); o8[64 * j] = w; }
        }
    }
}

__global__ void __launch_bounds__(NWAVES * 64, 2) fwd_kernel(Args args) {
    extern __shared__ __attribute__((aligned(16))) unsigned char lds[];
    cg::grid_group grid = cg::this_grid();
    LAS unsigned char* L = (LAS unsigned char*)lds;
    const int tid = threadIdx.x, lane = tid & 63, wave = __builtin_amdgcn_readfirstlane(tid >> 6);
    const int G = gridDim.x, bx = blockIdx.x;
    const int vcu = (G % 8 == 0) ? (bx % 8) * (G / 8) + bx / 8 : bx;
    const int gw = vcu * NWAVES + wave, NGW = G * NWAVES;
    unsigned char* ws = args.ws;
    const float* x = args.in[0];
    const float *w_qkv = args.in[1], *w_o = args.in[2], *w_pw1 = args.in[8], *w_pw2 = args.in[14], *w_gate = args.in[16], *w_up = args.in[17], *w_down = args.in[18];
    float* PARW = (float*)(ws + WS_PAR); const float* PAR = PARW;
    const float *lq1 = PAR + PO_LQ1, *lk1 = PAR + PO_LK1, *lq2 = PAR + PO_LQ2, *lk2 = PAR + PO_LK2, *subln_g = PAR + PO_SUBG, *b_pw1 = PAR + PO_BPW1, *w_dw = PAR + PO_WDW, *b_dw = PAR + PO_BDW;
    const float *cln_g = PAR + PO_CLNG, *cln_b = PAR + PO_CLNB, *b_pw2 = PAR + PO_BPW2, *ln_g = PAR + PO_LNG, *ln_b = PAR + PO_LNB;
    float* ST = (float*)(ws + WS_ST); float* TAB = (float*)(ws + WS_TAB);
    bf16 *Wqkv_t = (bf16*)(ws + WS_WQKV), *Wo_t = (bf16*)(ws + WS_WO), *Wpw1_t = (bf16*)(ws + WS_PW1), *Wpw2_t = (bf16*)(ws + WS_PW2);
    bf16 *Wgu0 = (bf16*)(ws + WS_GU0), *Wgu1 = (bf16*)(ws + WS_GU1), *Wdn0 = (bf16*)(ws + WS_DN0), *Wdn1 = (bf16*)(ws + WS_DN1);
    bf16 *XN = (bf16*)(ws + WS_XN), *QB = (bf16*)(ws + WS_Q), *KB = (bf16*)(ws + WS_K), *VB = (bf16*)(ws + WS_V), *HB = (bf16*)(ws + WS_H), *GB = (bf16*)(ws + WS_G), *CB = (bf16*)(ws + WS_C);
    float* Z = (float*)(ws + WS_Z);

    volatile LAS unsigned* xbst = (volatile LAS unsigned*)(L + LDS_BYTES - 64);
    if (tid < 2) xbst[tid] = 0u;
    if (bx == 0) for (int u = tid; u < XCD_BAR_WORDS; u += NWAVES * 64) __hip_atomic_store((unsigned*)(ws + WS_BAR) + u, 0u, __ATOMIC_RELAXED, __HIP_MEMORY_SCOPE_AGENT);
    __syncthreads();
    {
        LAS float* scr = (LAS float*)(L + wave * 16640);
        constexpr int I_QKV = 16 * 48, I_O = 16 * 16, I_PW1 = 16 * 32, I_PW2 = 16 * 16, I_GU = 16 * 44, I_DN = 44 * 16;
        constexpr int NITEMS = I_QKV + I_O + I_PW1 + I_PW2 + 4 * I_GU + 2 * I_DN;
        for (int it = gw; it < NITEMS; it += NGW) {
            int r = it;
            if (r < I_QKV) { transpose_item(w_qkv, D, 3 * D, Wqkv_t, 1, scr, r, lane); continue; } r -= I_QKV;
            if (r < I_O) { transpose_item(w_o, D, D, Wo_t, 0, scr, r, lane); continue; } r -= I_O;
            if (r < I_PW1) { transpose_item(w_pw1, D, 2 * D, Wpw1_t, 2, scr, r, lane); continue; } r -= I_PW1;
            if (r < I_PW2) { transpose_item(w_pw2, D, D, Wpw2_t, 0, scr, r, lane); continue; } r -= I_PW2;
            if (r < I_GU) { transpose_item(w_gate, D, FF, Wgu0, 3, scr, r, lane); continue; } r -= I_GU;
            if (r < I_GU) { transpose_item(w_up, D, FF, Wgu0, 4, scr, r, lane); continue; } r -= I_GU;
            if (r < I_GU) { transpose_item(w_gate + (size_t)D * FF, D, FF, Wgu1, 3, scr, r, lane); continue; } r -= I_GU;
            if (r < I_GU) { transpose_item(w_up + (size_t)D * FF, D, FF, Wgu1, 4, scr, r, lane); continue; } r -= I_GU;
            if (r < I_DN) { transpose_item(w_down, FF, D, Wdn0, 0, scr, r, lane); continue; } r -= I_DN;
            transpose_item(w_down + (size_t)FF * D, FF, D, Wdn1, 0, scr, r, lane);
        }
        for (int row = gw; row < M; row += 4 * NGW) {
            f32x4 y[4][4];
#pragma unroll
            for (int q = 0; q < 4; ++q) { const f32x4* xr = (const f32x4*)(x + (size_t)(row + q * NGW) * D) + 2 * lane;
                y[q][0] = xr[0]; y[q][1] = xr[1]; y[q][2] = xr[128]; y[q][3] = xr[129]; }
#pragma unroll
            for (int q = 0; q < 4; ++q) { v4u* o16 = (v4u*)(XN + (size_t)(row + q * NGW) * D) + lane;
                v4u w0, w1; w0.x = pk2(y[q][0].x, y[q][0].y); w0.y = pk2(y[q][0].z, y[q][0].w); w0.z = pk2(y[q][1].x, y[q][1].y); w0.w = pk2(y[q][1].z, y[q][1].w);
                w1.x = pk2(y[q][2].x, y[q][2].y); w1.y = pk2(y[q][2].z, y[q][2].w); w1.z = pk2(y[q][3].x, y[q][3].y); w1.w = pk2(y[q][3].z, y[q][3].w);
                o16[0] = w0; o16[64] = w1; }
        }
        for (int e = bx * (NWAVES * 64) + tid; e < PO_END; e += G * NWAVES * 64) {
            float v;
            if (e < PO_LK1) v = args.in[3][e - PO_LQ1]; else if (e < PO_LQ2) v = args.in[4][e - PO_LK1]; else if (e < PO_LK2) v = args.in[5][e - PO_LQ2]; else if (e < PO_SUBG) v = args.in[6][e - PO_LK2];
            else if (e < PO_BPW1) v = args.in[7][e - PO_SUBG]; else if (e < PO_WDW) v = args.in[9][e - PO_BPW1]; else if (e < PO_BDW) v = args.in[10][e - PO_WDW]; else if (e < PO_CLNG) v = args.in[11][e - PO_BDW];
            else if (e < PO_CLNB) v = args.in[12][e - PO_CLNG]; else if (e < PO_BPW2) v = args.in[13][e - PO_CLNB]; else if (e < PO_LNG) v = args.in[15][e - PO_BPW2]; else if (e < PO_LNB) v = args.in[19][e - PO_LNG];
            else v = args.in[20][e - PO_LNB];
            PARW[e] = v;
        }
        for (int e = bx * (NWAVES * 64) + tid; e < SEQ * 32; e += G * NWAVES * 64) {
            const int pos = e >> 5, i = e & 31, i8 = i & 7, i3 = i >> 3;
            double c = (i8 == 0) ? 1.0 : (i8 == 1) ? 0.7498942093324559 : (i8 == 2) ? 0.5623413251903491 : (i8 == 3) ? 0.4216965034285822 : (i8 == 4) ? 0.31622776601683794 : (i8 == 5) ? 0.23713737056616552 : (i8 == 6) ? 0.1778279410038923 : 0.1333521432163324;
            c *= (i3 == 0) ? 1.0 : (i3 == 1) ? 0.1 : (i3 == 2) ? 0.01 : 0.001;
            const double rev = (double)pos * c * 0.15915494309189535;
            const float fr = (float)(rev - __builtin_floor(rev));
            TAB[pos * 64 + i] = __builtin_amdgcn_cosf(fr); TAB[pos * 64 + 32 + i] = __builtin_amdgcn_sinf(fr);
        }
    }
    grid.sync();
    const XcdBarrier xbar = xcd_barrier_post((unsigned*)(ws + WS_BAR), xbst);

    if (PHMASK & (1 << 1)) {
        pg8::Gemm g{XN, Wqkv_t, M, 3 * D, D}; pg8::StaticOrder S; S.init(M, 3 * D, G, bx);
        pg8::EpiQKV E{QB, KB, VB, TAB, 0.125f * 1.4426950408889634f};
        pg8::gemm_phase<pg8::EpiQKV, pg8::StaticOrder, true, true>(L, g, S, E);
    }
    xcd_barrier(xbar);

    if (PHMASK & (1 << 2)) {
        const float d1 = wave_sum(lq1[lane] * lk1[lane]), d2 = wave_sum(lq2[lane] * lk2[lane]);
        const float lam = __expf(d1) - __expf(d2) + 0.2f;
        for (int idx = vcu; idx < 1024; idx += G) {
            const int v = idx & 255, i = idx >> 8, bh = v >> 3, s = v & 7;
            const int qb = (i == 0) ? 31 - s : (i == 1) ? 16 + s : (i == 2) ? 15 - s : s;
            att::attn_unit(bh >> 3, bh & 7, qb, QB, KB, VB, XN, Z, L, lam, 0.8f, subln_g);
        }
    }
    xcd_barrier(xbar);

    if (PHMASK & (1 << 3)) {
        pg8::Gemm g{XN, Wo_t, M, D, D}; pg8::StaticOrder S; S.init(M, D, G, bx);
        pg8::EpiResid<0> E{x, Z, nullptr, nullptr, nullptr, nullptr, ALPHA};
        pg8::gemm_phase<pg8::EpiResid<0>, pg8::StaticOrder, true, true>(L, g, S, E);
    }
    xcd_barrier(xbar);
    ln_phase(Z, XN, ST, ln_g, ln_b, nullptr, gw, NGW, lane);
    xcd_barrier(xbar);

    for (int layer = 0; layer < 2; ++layer) {
        if (layer == 1) {
            if (PHMASK & (1 << 8)) {
                pg8::Gemm g{XN, Wpw1_t, M, 2 * D, D}; pg8::StaticOrder S; S.init(M, 2 * D, G, bx);
                pg8::EpiGLU E{GB, b_pw1};
                pg8::gemm_phase<pg8::EpiGLU, pg8::StaticOrder, true, true>(L, g, S, E);
            }
            xcd_barrier(xbar);
            if (PHMASK & (1 << 9)) {
                int ctid = threadIdx.x; asm volatile("" : "+v"(ctid));
                const int clane = ctid & 63, cwave = __builtin_amdgcn_readfirstlane(ctid >> 6);
                LAS unsigned* tile = (LAS unsigned*)L;
                LAS float* red = (LAS float*)(L + 126976);
                LAS float* stat = red + 512;
                const unsigned L0 = (unsigned)(uintptr_t)L;
                for (int unit = vcu; unit < M / 32; unit += G) {
                    const int row0 = unit * 32, s0 = row0 & (SEQ - 1);
                    int c2 = ctid; asm volatile("" : "+v"(c2));
                    float w0[31], w1[31];
#pragma unroll
                    for (int t = 0; t < 31; ++t) { const float2 wv = *(const float2*)(w_dw + t * D + 2 * c2); w0[t] = wv.x; w1[t] = wv.y; }
                    const float bd0 = b_dw[2 * c2], bd1 = b_dw[2 * c2 + 1];
                    for (int p = cwave; p < 124; p += NWAVES) { const int rr = p >> 1;
                        if (s0 == 0 && rr < 30) *(LAS v4u*)(L + p * 1024 + clane * 16) = (v4u){0u, 0u, 0u, 0u};
                        else pg8::glds_s(GB + (size_t)(row0 - 30 + rr) * D + (p & 1) * 512, (unsigned)clane * 16u, L0 + (unsigned)p * 1024u); }
                    asm volatile("s_waitcnt vmcnt(0)" ::: "memory");
                    __syncthreads();
                    float y0[32], y1[32];
#pragma unroll
                    for (int r = 0; r < 32; ++r) { y0[r] = bd0; y1[r] = bd1; }
#pragma unroll
                    for (int k = 0; k < 62; ++k) { const unsigned xk = tile[k * 512 + c2]; const float a0 = __uint_as_float(xk << 16), a1 = __uint_as_float(xk & 0xffff0000u);
#pragma unroll
                        for (int r = 0; r < 32; ++r) { const int t = k - r; if (t >= 0 && t <= 30) { y0[r] += w0[t] * a0; y1[r] += w1[t] * a1; } } }
                    float vals[64];
#pragma unroll
                    for (int r = 0; r < 32; ++r) { vals[2 * r] = y0[r] + y1[r]; vals[2 * r + 1] = y0[r] * y0[r] + y1[r] * y1[r]; }
#define CONV_BFLY(MK) do { const bool up = (clane & (MK)) != 0; _Pragma("unroll") for (int k = 0; k < (MK); ++k) { const float a = vals[k], b = vals[k + (MK)]; const float snd = up ? a : b, kp = up ? b : a; vals[k] = kp + __shfl_xor(snd, (MK)); } } while (0)
                    CONV_BFLY(32); CONV_BFLY(16); CONV_BFLY(8); CONV_BFLY(4); CONV_BFLY(2); CONV_BFLY(1);
#undef CONV_BFLY
                    red[cwave * 64 + clane] = vals[0];
                    __syncthreads();
                    if (ctid < 32) { float sm = 0.f, q = 0.f;
#pragma unroll
                        for (int w = 0; w < 8; ++w) { sm += red[w * 64 + 2 * ctid]; q += red[w * 64 + 2 * ctid + 1]; }
                        const float mean = sm * (1.f / D), var = q * (1.f / D) - mean * mean;
                        stat[2 * ctid] = mean; stat[2 * ctid + 1] = 1.f / sqrtf(fmaxf(var, 0.f) + LN_EPS); }
                    __syncthreads();
                    int c3 = ctid; asm volatile("" : "+v"(c3));
                    const float g0 = cln_g[2 * c3], g1 = cln_g[2 * c3 + 1], bb0 = cln_b[2 * c3], bb1 = cln_b[2 * c3 + 1];
                    unsigned* op = (unsigned*)(CB + (size_t)row0 * D) + c3;
#pragma unroll
                    for (int r = 0; r < 32; ++r) {
                        const float mean = stat[2 * r], rstd = stat[2 * r + 1];
                        float n0 = (y0[r] - mean) * rstd * g0 + bb0, n1 = (y1[r] - mean) * rstd * g1 + bb1;
                        n0 = n0 * __builtin_amdgcn_rcpf(1.0f + __builtin_amdgcn_exp2f(n0 * -1.4426950408889634f));
                        n1 = n1 * __builtin_amdgcn_rcpf(1.0f + __builtin_amdgcn_exp2f(n1 * -1.4426950408889634f));
                        op[r * 512] = pk2(n0, n1);
                    }
                }
                __syncthreads();
            }
            xcd_barrier(xbar);
            if (PHMASK & (1 << 10)) {
                pg8::Gemm g{CB, Wpw2_t, M, D, D}; pg8::StaticOrder S; S.init(M, D, G, bx);
                pg8::EpiResid<1> E{Z, Z, ST, ln_g + 1 * D, ln_b + 1 * D, b_pw2, ALPHA};
                pg8::gemm_phase<pg8::EpiResid<1>, pg8::StaticOrder, true, true>(L, g, S, E);
            }
            xcd_barrier(xbar);
            ln_phase(Z, XN, ST, ln_g + 2 * D, ln_b + 2 * D, nullptr, gw, NGW, lane);
            xcd_barrier(xbar);
        }
        if (PHMASK & (1 << 5)) {
            pg8::Gemm g{XN, layer ? Wgu1 : Wgu0, M, 2 * FF, D}; pg8::StaticOrder S; S.init(M, 2 * FF, G, bx);
            pg8::EpiSwiGLU E{HB, FF};
            pg8::gemm_phase<pg8::EpiSwiGLU, pg8::StaticOrder, true, true>(L, g, S, E);
        }
        xcd_barrier(xbar);
        if (PHMASK & (1 << 6)) {
            pg8::Gemm g{HB, layer ? Wdn1 : Wdn0, M, D, FF}; pg8::StaticOrder S; S.init(M, D, G, bx);
            pg8::EpiResid<1> E{Z, Z, ST, ln_g + (2 * layer) * D, ln_b + (2 * layer) * D, nullptr, ALPHA};
            pg8::gemm_phase<pg8::EpiResid<1>, pg8::StaticOrder, true, true>(L, g, S, E);
        }
        xcd_barrier(xbar);
        if (layer == 0) { ln_phase(Z, XN, ST, ln_g + 1 * D, ln_b + 1 * D, nullptr, gw, NGW, lane); xcd_barrier(xbar); }
        else ln_phase(Z, nullptr, ST, ln_g + 3 * D, ln_b + 3 * D, args.out, gw, NGW, lane);
    }
}

extern "C" void kernel_launch(void* const* d_in, const int* in_sizes, int n_in, void* d_out, int out_size, void* d_ws, size_t ws_size, hipStream_t stream) {
    static int grid = 0;
    if (grid == 0) {
        if (n_in != 21 || out_size != M * D || ws_size < WS_END) { fprintf(stderr, "kernel_launch: unexpected shapes (n_in %d out %d ws %zu)\n", n_in, out_size, ws_size); grid = -1; return; }
        int dev = 0, cus = 0, per_cu = 0;
        hipGetDevice(&dev); hipDeviceGetAttribute(&cus, hipDeviceAttributeMultiprocessorCount, dev);
        if (hipFuncSetAttribute((const void*)fwd_kernel, hipFuncAttributeMaxDynamicSharedMemorySize, LDS_BYTES) != hipSuccess) { fprintf(stderr, "kernel_launch: hipFuncSetAttribute failed\n"); grid = -1; return; }
        hipOccupancyMaxActiveBlocksPerMultiprocessor(&per_cu, (const void*)fwd_kernel, NWAVES * 64, LDS_BYTES);
        (void)hipGetLastError();
        grid = cus * (per_cu > 0 ? 1 : 1);
        if (grid > 256) grid = 256;
        grid &= ~7;
        fprintf(stderr, "kernel_launch: cus %d per_cu %d grid %d\n", cus, per_cu, grid);
    }
    if (grid <= 0) return;
    Args a{};
    for (int i = 0; i < 21; ++i) a.in[i] = (const float*)d_in[i];
    a.out = (float*)d_out; a.ws = (unsigned char*)d_ws;
    void* kargs[] = {&a};
    hipError_t e = hipLaunchCooperativeKernel((const void*)fwd_kernel, dim3(grid), dim3(NWAVES * 64), kargs, LDS_BYTES, stream);
    if (e != hipSuccess) fprintf(stderr, "kernel_launch: cooperative launch failed: %s (grid %d)\n", hipGetErrorString(e), grid);
}
```

```cpp
#include <hip/hip_runtime.h>
#include <hip/hip_cooperative_groups.h>
#include <cstdio>
#include <cstdint>
namespace cg = cooperative_groups;
namespace pg8 {
#define PG8_LAS __attribute__((address_space(3)))
typedef unsigned short bf16_t;
typedef short bf16x8 __attribute__((ext_vector_type(8)));
typedef float f32x4 __attribute__((ext_vector_type(4)));
typedef unsigned u32x4 __attribute__((ext_vector_type(4)));
constexpr int BM = 256, BK = 64, HALF = 128, HTB = HALF * BK * 2  , STAGE_BYTES = 8 * HTB, NXCD = 8, WGM = 8;

__host__ __device__ __forceinline__ int lds_byte(int r, int c) { const int st = (r >> 4) * 2 + (c >> 5), rr = r & 15, cc = c & 31, ob = rr * 64 + cc * 2; return st * 1024 + (ob ^ (((ob >> 9) & 1) << 5)); }
__host__ __device__ __forceinline__ void stage_rc(int b, int& R, int& C) { const int st = b / 1024, sb = b % 1024, swz = sb ^ (((sb >> 9) & 1) << 5); R = (st >> 1) * 16 + swz / 64; C = (st & 1) * 32 + (swz % 64) / 2; }
__host__ __device__ __forceinline__ int perm32(int rho) { const int n = rho >> 4, i = rho & 15; return 8 * (i >> 2) + 4 * n + (i & 3); }

struct Unit { int pm, pn; };
struct Gemm { const bf16_t* A; const bf16_t* Bt; int M, N, K; };

struct StaticOrder {
    int nM, nN, nwg, G, c;
    __host__ __device__ void init(int M, int N, int G_, int c_) { nM = M / BM; nN = N / BM; nwg = nM * nN; G = G_; c = c_; }
    __host__ __device__ bool next(int i, Unit& u) const {
        const long L = (long)i * G + c; if (L >= nwg) return false;
        int wgid = (int)L; { const int q = nwg / NXCD, r = nwg % NXCD, xcd = wgid % NXCD, off = wgid / NXCD; wgid = (xcd < r ? xcd * (q + 1) : r * (q + 1) + (xcd - r) * q) + off; }
        const int nig = WGM * nN, gid = wgid / nig, fm = gid * WGM, gsz = (nM - fm) < WGM ? (nM - fm) : WGM;
        u.pm = fm + ((wgid % nig) % gsz); u.pn = (wgid % nig) / gsz; return true;
    }
    __device__ __forceinline__ void a_ready(const Unit&) const {}
    __device__ __forceinline__ void done(const Unit&) const {}
};

__device__ __forceinline__ unsigned cvt_pk_bf16(float lo, float hi) { unsigned r; asm volatile("v_cvt_pk_bf16_f32 %0, %1, %2" : "=v"(r) : "v"(lo), "v"(hi)); return r; }
__device__ __forceinline__ void glds_s(const void* sbase, unsigned voff, unsigned ldsdst) {
    unsigned keep;
    asm volatile("s_mov_b32 %0, m0\n\ts_mov_b32 m0, %3\n\ts_nop 0\n\tglobal_load_lds_dwordx4 %1, %2\n\ts_mov_b32 m0, %0" : "=&s"(keep) : "v"(voff), "s"(sbase), "s"(ldsdst) : "memory");
}
typedef float f32x2 __attribute__((ext_vector_type(2)));
__device__ __forceinline__ f32x2 gelu_pk(f32x2 v) {
    const f32x2 av = __builtin_elementwise_abs(v), d = av * 0.2316418882f + 1.0f;
    f32x2 t; t.x = __builtin_amdgcn_rcpf(d.x); t.y = __builtin_amdgcn_rcpf(d.y);
    f32x2 q = t * 0.5307027145f + (-0.7265760135f); q = q * t + 0.7107068705f; q = q * t + (-0.142248368f); q = q * t + 0.127414796f; q = q * t;
    const f32x2 s = (v * v) * (-0.72134752044f);
    f32x2 e; e.x = __builtin_amdgcn_exp2f(s.x); e.y = __builtin_amdgcn_exp2f(s.y);
    const f32x2 m = v * (q * e), r = v - m;
    f32x2 o; o.x = v.x < 0.f ? m.x : r.x; o.y = v.y < 0.f ? m.y : r.y; return o;
}

template <int ACT  > struct EpiBf16 {
    static constexpr bool PERM = true, AFTER_DRAIN = false; static_assert(ACT == 0 || ACT == 1, "EpiBf16: ACT is 0 (none) or 1 (gelu_pk)");
    bf16_t* O; int ldc; const float* bias; int split_cols; size_t split_stride; float scale0;
    __device__ __forceinline__ void operator()(const f32x4 (&acc)[2][2][4][2], const Unit& u, int wr, int wc, int fr_in, int fq_in) const {
        int fr = fr_in, fq = fq_in; asm volatile("" : "+v"(fr), "+v"(fq));
        const int row0 = u.pm * BM + wr * 64 + fr; int colt = u.pn * BM; bf16_t* base = O;
        float sc = 1.f; if (split_cols) { const int t = colt / split_cols; base += (size_t)t * split_stride; colt -= t * split_cols; if (t == 0) sc = scale0; }
        const int col0 = colt + wc * 32 + 8 * fq, bcol0 = u.pn * BM + wc * 32 + 8 * fq;
        f32x4 bv[2][2];
#pragma unroll
        for (int bj = 0; bj < 2; ++bj)
#pragma unroll
            for (int n = 0; n < 2; ++n) bv[bj][n] = bias ? *(const f32x4*)(bias + bcol0 + bj * HALF + 4 * n) : (f32x4){0.f, 0.f, 0.f, 0.f};
#pragma unroll
        for (int ai = 0; ai < 2; ++ai)
#pragma unroll
            for (int m = 0; m < 4; ++m) { bf16_t* rowp = base + (size_t)(row0 + ai * HALF + m * 16) * ldc + col0;
#pragma unroll
                for (int bj = 0; bj < 2; ++bj) { f32x4 v0 = acc[ai][bj][m][0] + bv[bj][0], v1 = acc[ai][bj][m][1] + bv[bj][1];
                    if (ACT == 1) { f32x2 a = gelu_pk((f32x2){v0[0], v0[1]}), b = gelu_pk((f32x2){v0[2], v0[3]}), c = gelu_pk((f32x2){v1[0], v1[1]}), d = gelu_pk((f32x2){v1[2], v1[3]});
                        v0 = (f32x4){a.x, a.y, b.x, b.y}; v1 = (f32x4){c.x, c.y, d.x, d.y}; }
                    v0 = v0 * sc; v1 = v1 * sc; u32x4 w; w.x = cvt_pk_bf16(v0[0], v0[1]); w.y = cvt_pk_bf16(v0[2], v0[3]); w.z = cvt_pk_bf16(v1[0], v1[1]); w.w = cvt_pk_bf16(v1[2], v1[3]);
                    *(u32x4*)(rowp + bj * HALF) = w; } }
    }
};
__device__ __forceinline__ u32x4 pack8(const f32x4 v0, const f32x4 v1) { u32x4 w; w.x = cvt_pk_bf16(v0[0], v0[1]); w.y = cvt_pk_bf16(v0[2], v0[3]); w.z = cvt_pk_bf16(v1[0], v1[1]); w.w = cvt_pk_bf16(v1[2], v1[3]); return w; }
__device__ __forceinline__ f32x4 sigm4(const f32x4 g) {
    f32x4 r;
#pragma unroll
    for (int i = 0; i < 4; ++i) r[i] = __builtin_amdgcn_rcpf(1.0f + __builtin_amdgcn_exp2f(g[i] * -1.4426950408889634f));
    return r;
}
struct EpiQKV {
    static constexpr bool PERM = true, AFTER_DRAIN = false;
    bf16_t* Q; bf16_t* Kb; bf16_t* V; const float* tab; float qscale;
    __device__ __forceinline__ void operator()(const f32x4 (&acc)[2][2][4][2], const Unit& u, int wr, int wc, int fr_in, int fq_in) const {
        int fr = fr_in, fq = fq_in; asm volatile("" : "+v"(fr), "+v"(fq));
        const int row0 = u.pm * BM + wr * 64 + fr;
        if (u.pn >= 8) {
            const int col0 = (u.pn - 8) * BM + wc * 32 + 8 * fq;
#pragma unroll
            for (int ai = 0; ai < 2; ++ai)
#pragma unroll
                for (int m = 0; m < 4; ++m) { bf16_t* rowp = V + (size_t)(row0 + ai * HALF + m * 16) * 1024 + col0;
#pragma unroll
                    for (int bj = 0; bj < 2; ++bj) *(u32x4*)(rowp + bj * HALF) = pack8(acc[ai][bj][m][0], acc[ai][bj][m][1]); }
        } else {
            bf16_t* dst = (u.pn >> 2) ? Kb : Q; const float sc = (u.pn >> 2) ? 1.0f : qscale;
            const int colbase = 64 * (4 * (u.pn & 3) + wc) + 8 * fq;
#pragma unroll
            for (int ai = 0; ai < 2; ++ai)
#pragma unroll
                for (int m = 0; m < 4; ++m) { const int row = row0 + ai * HALF + m * 16; const float* tp = tab + (size_t)(row & 8191) * 64 + 8 * fq;
                    const f32x4 c0 = *(const f32x4*)(tp), c1 = *(const f32x4*)(tp + 4), s0 = *(const f32x4*)(tp + 32), s1 = *(const f32x4*)(tp + 36);
                    const f32x4 x10 = acc[ai][0][m][0], x11 = acc[ai][0][m][1], x20 = acc[ai][1][m][0], x21 = acc[ai][1][m][1];
                    const f32x4 o10 = (x10 * c0 - x20 * s0) * sc, o11 = (x11 * c1 - x21 * s1) * sc, o20 = (x20 * c0 + x10 * s0) * sc, o21 = (x21 * c1 + x11 * s1) * sc;
                    bf16_t* rowp = dst + (size_t)row * 1024 + colbase;
                    *(u32x4*)(rowp) = pack8(o10, o11); *(u32x4*)(rowp + 32) = pack8(o20, o21); asm volatile("" ::: "memory"); }
        }
    }
};
struct EpiSwiGLU {
    static constexpr bool PERM = true, AFTER_DRAIN = false;
    bf16_t* H; int ldc;
    __device__ __forceinline__ void operator()(const f32x4 (&acc)[2][2][4][2], const Unit& u, int wr, int wc, int fr_in, int fq_in) const {
        int fr = fr_in, fq = fq_in; asm volatile("" : "+v"(fr), "+v"(fq));
        const int row0 = u.pm * BM + wr * 64 + fr, col0 = u.pn * HALF + wc * 32 + 8 * fq;
#pragma unroll
        for (int ai = 0; ai < 2; ++ai)
#pragma unroll
            for (int m = 0; m < 4; ++m) { bf16_t* rowp = H + (size_t)(row0 + ai * HALF + m * 16) * ldc + col0;
                const f32x4 g0 = acc[ai][0][m][0], g1 = acc[ai][0][m][1];
                const f32x4 h0 = g0 * sigm4(g0) * acc[ai][1][m][0], h1 = g1 * sigm4(g1) * acc[ai][1][m][1];
                *(u32x4*)(rowp) = pack8(h0, h1); __builtin_amdgcn_sched_barrier(0); }
    }
};
struct EpiGLU {
    static constexpr bool PERM = true, AFTER_DRAIN = false;
    bf16_t* G; const float* bias;
    __device__ __forceinline__ void operator()(const f32x4 (&acc)[2][2][4][2], const Unit& u, int wr, int wc, int fr_in, int fq_in) const {
        int fr = fr_in, fq = fq_in; asm volatile("" : "+v"(fr), "+v"(fq));
        const int row0 = u.pm * BM + wr * 64 + fr, col0 = u.pn * HALF + wc * 32 + 8 * fq;
#pragma unroll
        for (int ai = 0; ai < 2; ++ai)
#pragma unroll
            for (int m = 0; m < 4; ++m) { bf16_t* rowp = G + (size_t)(row0 + ai * HALF + m * 16) * 1024 + col0;
                const f32x4 ba0 = *(const f32x4*)(bias + col0), ba1 = *(const f32x4*)(bias + col0 + 4), bg0 = *(const f32x4*)(bias + 1024 + col0), bg1 = *(const f32x4*)(bias + 1024 + col0 + 4);
                const f32x4 h0 = (acc[ai][0][m][0] + ba0) * sigm4(acc[ai][1][m][0] + bg0), h1 = (acc[ai][0][m][1] + ba1) * sigm4(acc[ai][1][m][1] + bg1);
                *(u32x4*)(rowp) = pack8(h0, h1); asm volatile("" ::: "memory"); __builtin_amdgcn_sched_barrier(0); }
    }
};
template <int MODE> struct EpiResid {
    static constexpr bool PERM = false, AFTER_DRAIN = false;
    const float* xin; float* out; const float* st; const float* g; const float* b; const float* bias; float alpha;
    __device__ __forceinline__ void operator()(const f32x4 (&acc)[2][2][4][2], const Unit& u, int wr, int wc, int fr_in, int fq_in) const {
        int fr = fr_in, fq = fq_in; asm volatile("" : "+v"(fr), "+v"(fq));
        const int col0 = u.pn * BM + wc * 32 + 4 * fq;
#pragma unroll
        for (int bj = 0; bj < 2; ++bj)
#pragma unroll
            for (int n = 0; n < 2; ++n) { const int c = col0 + bj * HALF + n * 16;
                const f32x4 cv = bias ? *(const f32x4*)(bias + c) : (f32x4){0.f, 0.f, 0.f, 0.f};
                f32x4 gv = cv, bv = cv; if (MODE == 1) { gv = *(const f32x4*)(g + c); bv = *(const f32x4*)(b + c); }
#pragma unroll
                for (int ai = 0; ai < 2; ++ai)
#pragma unroll
                    for (int m = 0; m < 4; ++m) { const int row = u.pm * BM + ai * HALF + wr * 64 + m * 16 + fr; const size_t off = (size_t)row * 1024 + c;
                        f32x4 xv = *(const f32x4*)(xin + off);
                        if (MODE == 1) { const float mean = st[2 * row], rstd = st[2 * row + 1]; xv = (xv - mean) * rstd * gv + bv; }
                        *(f32x4*)(out + off) = xv * alpha + acc[ai][bj][m][n] + cv;
                        if (m & 1) asm volatile("" ::: "memory"); }
            }
    }
};

template <class Epi, class Sched, bool ALIGN_EPI = false, bool SP2 = false>
__device__ __forceinline__ void gemm_phase(PG8_LAS unsigned char* lds, const Gemm g, const Sched& S, const Epi& E) {
    int tid_l = threadIdx.x; asm volatile("" : "+v"(tid_l));
    const int tid = tid_l, wid = __builtin_amdgcn_readfirstlane(tid >> 6), lane = tid & 63, wr = wid >> 2, wc = wid & 3, fr = lane & 15, fq = lane >> 4;
    const int K = g.K, nt = K / BK;
    unsigned voffA[2], voffB[2];
#pragma unroll
    for (int i = 0; i < 2; ++i) { int R, C; stage_rc(tid * 16 + i * 8192, R, C); const int Rb = Epi::PERM ? ((R & ~31) + perm32(R & 31)) : R;
        voffA[i] = (unsigned)(R * K + C) * 2u; voffB[i] = (unsigned)(Rb * K + C) * 2u; }
    const size_t kstep = (size_t)(BK * 2);
    const size_t hstep = (size_t)HALF * K * 2;
    const size_t tstep = 2 * hstep;
    const unsigned ldsbase_ = (unsigned)(uintptr_t)lds;
    const unsigned ldsw = (unsigned)wid * 1024u;
    const int aoff = lds_byte(wr * 64 + fr, fq * 8), boff = lds_byte(wc * 32 + fr, fq * 8);
#define PG8_SA(b, h) (((b) * 2 + (h)) * HTB)
#define PG8_SB(b, h) ((4 + (b) * 2 + (h)) * HTB)
#define PG8_STAGE(bufoff, gbase, voff) do { _Pragma("unroll") for (int _i = 0; _i < 2; ++_i) \
        glds_s((const void*)(gbase), (voff)[_i], ldsbase_ + (unsigned)(bufoff) + ldsw + (unsigned)_i * 8192u); } while (0)
#define PG8_LDA(dst, b, h) do { _Pragma("unroll") for (int m = 0; m < 4; ++m) _Pragma("unroll") for (int k = 0; k < 2; ++k) dst[m][k] = *(const PG8_LAS bf16x8*)(lds + PG8_SA(b, h) + aoff + m * 2048 + k * 1024); } while (0)
#define PG8_LDB(dst, b, h) do { _Pragma("unroll") for (int n = 0; n < 2; ++n) _Pragma("unroll") for (int k = 0; k < 2; ++k) dst[n][k] = *(const PG8_LAS bf16x8*)(lds + PG8_SB(b, h) + boff + n * 2048 + k * 1024); } while (0)
#define PG8_MMA(ai, bj, At, Bt) do { __builtin_amdgcn_s_setprio(1); _Pragma("unroll") for (int m = 0; m < 4; ++m) _Pragma("unroll") for (int n = 0; n < 2; ++n) _Pragma("unroll") for (int k = 0; k < 2; ++k) \
        acc[ai][bj][m][n] = __builtin_amdgcn_mfma_f32_16x16x32_bf16(Bt[n][k], At[m][k], acc[ai][bj][m][n], 0, 0, 0); __builtin_amdgcn_s_setprio(0); } while (0)
#define PG8_WAIT_V(n) asm volatile("s_waitcnt vmcnt(" #n ")" ::: "memory")
#define PG8_WAIT_L(n) asm volatile("s_waitcnt lgkmcnt(" #n ")" ::: "memory")
#define PG8_BAR __builtin_amdgcn_s_barrier()
#define PG8_SCHED __builtin_amdgcn_sched_barrier(0)
    Unit cur, nxt; int ui = 0;
    if (!S.next(0, cur)) return;
    f32x4 acc[2][2][4][2];
#pragma unroll
    for (int a = 0; a < 2; ++a)
#pragma unroll
        for (int b = 0; b < 2; ++b)
#pragma unroll
            for (int m = 0; m < 4; ++m)
#pragma unroll
                for (int n = 0; n < 2; ++n) acc[a][b][m][n] = (f32x4){0.f, 0.f, 0.f, 0.f};
    bf16x8 At[4][2], B0[2][2], B1[2][2];
    const char* cA = (const char*)g.A + (size_t)cur.pm * tstep; const char* cB = (const char*)g.Bt + (size_t)cur.pn * tstep;
    S.a_ready(cur);
    if constexpr (SP2) {
        PG8_STAGE(PG8_SB(0, 0), cB, voffB); PG8_SCHED; PG8_STAGE(PG8_SB(0, 1), cB + hstep, voffB); PG8_SCHED; PG8_STAGE(PG8_SA(0, 0), cA, voffA); PG8_SCHED; PG8_STAGE(PG8_SA(0, 1), cA + hstep, voffA); PG8_SCHED;
        if (wr == 1) PG8_BAR;
        PG8_WAIT_V(2); PG8_BAR; PG8_SCHED;
        PG8_STAGE(PG8_SB(1, 0), cB + kstep, voffB); PG8_SCHED; PG8_STAGE(PG8_SA(1, 0), cA + kstep, voffA); PG8_SCHED; PG8_STAGE(PG8_SB(1, 1), cB + hstep + kstep, voffB); PG8_SCHED;
        PG8_WAIT_V(6); PG8_BAR; PG8_SCHED;
    } else {
        PG8_STAGE(PG8_SB(0, 0), cB, voffB); PG8_STAGE(PG8_SA(0, 0), cA, voffA); PG8_STAGE(PG8_SB(0, 1), cB + hstep, voffB); PG8_STAGE(PG8_SA(0, 1), cA + hstep, voffA);
        if (wr == 1) PG8_BAR;
        PG8_WAIT_V(4); PG8_BAR;
        PG8_STAGE(PG8_SB(1, 0), cB + kstep, voffB); PG8_STAGE(PG8_SA(1, 0), cA + kstep, voffA); PG8_STAGE(PG8_SB(1, 1), cB + hstep + kstep, voffB);
        PG8_WAIT_V(6); PG8_BAR;
    }
    for (;;) {
        const bool has_next = S.next(ui + 1, nxt);
        const char* nA = has_next ? (const char*)g.A + (size_t)nxt.pm * tstep : cA; const char* nB = has_next ? (const char*)g.Bt + (size_t)nxt.pn * tstep : cB;
        for (int t = 0; t < nt; t += 2) {
            const bool last = (t == nt - 2);
            const char* a1 = cA + (size_t)(t + 1) * kstep;
            const char* a2 = last ? nA : cA + (size_t)(t + 2) * kstep; const char* b2 = last ? nB : cB + (size_t)(t + 2) * kstep;
            const char* a3 = a2 + kstep; const char* b3 = b2 + kstep;
            if (last && has_next) S.a_ready(nxt);
            if constexpr (SP2) {
            PG8_LDB(B0, 0, 0); PG8_LDB(B1, 0, 1); PG8_SCHED; PG8_LDA(At, 0, 0); PG8_STAGE(PG8_SA(1, 1), a1 + hstep, voffA);
            PG8_WAIT_V(8); PG8_WAIT_L(0); PG8_BAR; PG8_MMA(0, 0, At, B0); PG8_MMA(0, 1, At, B1); PG8_BAR; PG8_SCHED;
            PG8_LDA(At, 0, 1); PG8_STAGE(PG8_SB(0, 0), b2, voffB); PG8_STAGE(PG8_SB(0, 1), b2 + hstep, voffB); PG8_STAGE(PG8_SA(0, 0), a2, voffA);
            PG8_WAIT_V(8); PG8_WAIT_L(0); PG8_BAR; PG8_MMA(1, 0, At, B0); PG8_MMA(1, 1, At, B1); PG8_BAR; PG8_SCHED;
            PG8_LDB(B0, 1, 0); PG8_LDB(B1, 1, 1); PG8_SCHED; PG8_LDA(At, 1, 0); PG8_STAGE(PG8_SA(0, 1), a2 + hstep, voffA);
            PG8_WAIT_V(8); PG8_WAIT_L(0); PG8_BAR; PG8_MMA(0, 0, At, B0); PG8_MMA(0, 1, At, B1); PG8_BAR; PG8_SCHED;
            PG8_LDA(At, 1, 1); PG8_STAGE(PG8_SB(1, 0), b3, voffB); PG8_STAGE(PG8_SB(1, 1), b3 + hstep, voffB); PG8_STAGE(PG8_SA(1, 0), a3, voffA);
            PG8_WAIT_V(8); PG8_WAIT_L(0); PG8_BAR; PG8_MMA(1, 0, At, B0); PG8_MMA(1, 1, At, B1); PG8_BAR; PG8_SCHED;
            } else {
            PG8_LDB(B0, 0, 0); PG8_SCHED; PG8_LDA(At, 0, 0); PG8_STAGE(PG8_SA(1, 1), a1 + hstep, voffA);
            PG8_WAIT_L(8); PG8_BAR; PG8_WAIT_L(0); PG8_MMA(0, 0, At, B0); PG8_BAR; PG8_SCHED;
            PG8_LDB(B1, 0, 1); PG8_STAGE(PG8_SB(0, 0), b2, voffB);
            PG8_BAR; PG8_WAIT_L(0); PG8_MMA(0, 1, At, B1); PG8_BAR;
            PG8_LDA(At, 0, 1); PG8_STAGE(PG8_SA(0, 0), a2, voffA);
            PG8_BAR; PG8_WAIT_L(0); PG8_MMA(1, 0, At, B0); PG8_BAR; PG8_SCHED;
            PG8_STAGE(PG8_SB(0, 1), b2 + hstep, voffB);
            PG8_WAIT_V(6); PG8_BAR; PG8_MMA(1, 1, At, B1); PG8_BAR;
            PG8_LDB(B0, 1, 0); PG8_SCHED; PG8_LDA(At, 1, 0); PG8_STAGE(PG8_SA(0, 1), a2 + hstep, voffA);
            PG8_WAIT_L(8); PG8_BAR; PG8_WAIT_L(0); PG8_MMA(0, 0, At, B0); PG8_BAR; PG8_SCHED;
            PG8_LDB(B1, 1, 1); PG8_STAGE(PG8_SB(1, 0), b3, voffB);
            PG8_BAR; PG8_WAIT_L(0); PG8_MMA(0, 1, At, B1); PG8_BAR;
            PG8_LDA(At, 1, 1); PG8_STAGE(PG8_SA(1, 0), a3, voffA);
            PG8_BAR; PG8_WAIT_L(0); PG8_MMA(1, 0, At, B0); PG8_BAR; PG8_SCHED;
            PG8_STAGE(PG8_SB(1, 1), b3 + hstep, voffB);
            PG8_WAIT_V(6); PG8_BAR; PG8_MMA(1, 1, At, B1); PG8_BAR;
            }
        }
        if constexpr (ALIGN_EPI) { if (wr == 0) PG8_BAR; }
        if constexpr (!Epi::AFTER_DRAIN) { E(acc, cur, wr, wc, fr, fq); S.done(cur); }
        if (!has_next) break;
#pragma unroll
        for (int a = 0; a < 2; ++a)
#pragma unroll
            for (int b = 0; b < 2; ++b)
#pragma unroll
                for (int m = 0; m < 4; ++m)
#pragma unroll
                    for (int n = 0; n < 2; ++n) acc[a][b][m][n] = (f32x4){0.f, 0.f, 0.f, 0.f};
        cur = nxt; cA = nA; cB = nB; ++ui;
        if constexpr (ALIGN_EPI) { if (wr == 1) PG8_BAR; }
    }
    PG8_WAIT_V(0);
    if constexpr (!ALIGN_EPI) { if (wr == 0) PG8_BAR; }
    PG8_BAR;
    if constexpr (Epi::AFTER_DRAIN) { E.fused(acc, cur, wr, wc, fr, fq, lds, wid, lane); S.done(cur); }
#undef PG8_SA
#undef PG8_SB
#undef PG8_STAGE
#undef PG8_LDA
#undef PG8_LDB
#undef PG8_MMA
#undef PG8_WAIT_V
#undef PG8_WAIT_L
#undef PG8_BAR
#undef PG8_SCHED
}
}

namespace att {
#define ALAS __attribute__((address_space(3)))
typedef unsigned short bf16_t;
typedef short bf16x8 __attribute__((ext_vector_type(8)));
typedef short s16x4 __attribute__((ext_vector_type(4)));
typedef short v4i16_t __attribute__((ext_vector_type(4)));
typedef float f32x16 __attribute__((ext_vector_type(16)));
typedef float f32x4 __attribute__((ext_vector_type(4)));
typedef unsigned u32x4 __attribute__((ext_vector_type(4)));
constexpr int SEQ = 8192, PITCH = 1024;
constexpr int KBYTES = 8192, VBYTES = 16384, VOFF0 = 3 * KBYTES, WSF_OFF = VOFF0 + 3 * VBYTES, STG_OFF = WSF_OFF + 8 * 64 * 4, LDS_BYTES = STG_OFF + 8 * 8192;
#ifndef ATT_GRP_SHIFT
#define ATT_GRP_SHIFT 2
#endif
__device__ __forceinline__ int crow(int r, int hi) { return (r & 3) + 8 * (r >> 2) + 4 * hi; }
__device__ __forceinline__ unsigned f2bf(float f) { unsigned u = __builtin_bit_cast(unsigned, f); return (u + 0x7fffu + ((u >> 16) & 1u)) >> 16; }
__device__ __forceinline__ s16x4 vtr(const ALAS unsigned char* p) { return __builtin_bit_cast(s16x4, __builtin_amdgcn_ds_read_tr16_b64_v4i16((ALAS v4i16_t*)p)); }
__device__ __forceinline__ float swapsum(float v) { auto rr = __builtin_amdgcn_permlane32_swap(__float_as_uint(v), __float_as_uint(v), false, false); return __uint_as_float(rr[0]) + __uint_as_float(rr[1]); }
__device__ __forceinline__ float swapmax(float v) { auto rr = __builtin_amdgcn_permlane32_swap(__float_as_uint(v), __float_as_uint(v), false, false); return fmaxf(__uint_as_float(rr[0]), __uint_as_float(rr[1])); }
__device__ __forceinline__ float max3f(float a, float b, float c) { float r; asm("v_max3_f32 %0, %1, %2, %3" : "=v"(r) : "v"(a), "v"(b), "v"(c)); return r; }
__device__ __forceinline__ float max2f(float a, float b) { float r; asm("v_max_f32_e32 %0, %1, %2" : "=v"(r) : "v"(a), "v"(b)); return r; }
#define ATT_GLDS(g, l) __builtin_amdgcn_global_load_lds((const unsigned*)(g), (ALAS unsigned*)(l), 16, 0, 0)
#define ATT_LWAIT() asm volatile("s_waitcnt lgkmcnt(0)" ::: "memory")

__device__ __forceinline__ void attn_unit(int b, int h, int qb, const bf16_t* Q, const bf16_t* K, const bf16_t* V, bf16_t* O, float* scr, ALAS unsigned char* shm, float lam, float outscale, const float* subg) {
    int tid_l = threadIdx.x; asm volatile("" : "+v"(tid_l));
    const int tid = tid_l, lane = tid & 63, r32 = lane & 31, hi = lane >> 5; const int wid = __builtin_amdgcn_readfirstlane(tid >> 6);
    const size_t rowbase = (size_t)b * SEQ; const int q0 = qb * 256;
    const int NT = 4 * qb + 4, cw = 4 * qb + (wid >> 1);
    const unsigned shm0 = (unsigned)(uintptr_t)shm;
    ALAS float* wsf = (ALAS float*)(shm + WSF_OFF) + wid * 64;
    float* myscr = scr + ((((rowbase + q0) >> 5) + wid) * 8 + h) * 4096;
    f32x16 o[4];
    for (int m = 0; m < 2; ++m) {
        const bf16_t* Qw = Q + (rowbase + q0 + wid * 32) * PITCH + h * 128 + m * 64;
        const bf16_t* ksrc = K + rowbase * PITCH + h * 128 + m * 64 + wid * 8;
        const bf16_t* vsrc = V + (rowbase + 16 * (wid & 3)) * PITCH + h * 128 + (wid >> 2) * 32;
        const unsigned koff = (unsigned)lane * (PITCH * 2), voff = (unsigned)(lane >> 2) * (PITCH * 2) + (unsigned)(lane & 3) * 16u;
        bf16x8 qr[4];
        unsigned qoff = (unsigned)r32 * (PITCH * 2) + (unsigned)hi * 16u; asm volatile("" : "+v"(qoff));
#pragma unroll
        for (int d0 = 0; d0 < 4; ++d0) qr[d0] = *(const bf16x8*)((const char*)Qw + (qoff + (unsigned)d0 * 32u));
        float mhat = 0.f, l = 0.f; f32x16 negm;
#pragma unroll
        for (int r = 0; r < 16; ++r) negm[r] = 0.f;
#pragma unroll
        for (int d0 = 0; d0 < 4; ++d0)
#pragma unroll
            for (int r = 0; r < 16; ++r) o[d0][r] = 0.f;
        bf16x8 pw[4];
#pragma unroll
        for (int ks = 0; ks < 4; ++ks) pw[ks] = (bf16x8){0, 0, 0, 0, 0, 0, 0, 0};
#define ATT_DMA(t, koffs, voffs) do { const size_t go_ = (size_t)(t) * 64 * PITCH; pg8::glds_s(ksrc + go_, koff, shm0 + (unsigned)(koffs) + (unsigned)wid * 1024u); \
            pg8::glds_s(vsrc + go_, voff, shm0 + (unsigned)(voffs) + (unsigned)wid * 1024u); pg8::glds_s(vsrc + go_ + 64, voff, shm0 + (unsigned)(voffs) + (unsigned)(wid + 8) * 1024u); } while (0)
#define ATT_QK(P0, P1, koffs) do { \
            const ALAS unsigned char* kb = shm + (koffs) + hi * 1024 + r32 * 16; \
            bf16x8 kf[8]; \
            _Pragma("unroll") for (int d0 = 0; d0 < 4; ++d0) { kf[2 * d0] = *(const ALAS bf16x8*)(kb + d0 * 2048); kf[2 * d0 + 1] = *(const ALAS bf16x8*)(kb + d0 * 2048 + 512); } \
            P0 = __builtin_amdgcn_mfma_f32_32x32x16_bf16(kf[0], qr[0], negm, 0, 0, 0); P1 = __builtin_amdgcn_mfma_f32_32x32x16_bf16(kf[1], qr[0], negm, 0, 0, 0); \
            _Pragma("unroll") for (int d0 = 1; d0 < 4; ++d0) { P0 = __builtin_amdgcn_mfma_f32_32x32x16_bf16(kf[2 * d0], qr[d0], P0, 0, 0, 0); P1 = __builtin_amdgcn_mfma_f32_32x32x16_bf16(kf[2 * d0 + 1], qr[d0], P1, 0, 0, 0); } \
        } while (0)
#define ATT_FIN(P0, P1) do { \
            float sacc = 0.f; \
            _Pragma("unroll") for (int r = 0; r < 16; ++r) { P1[r] = __builtin_amdgcn_exp2f(P1[r]); sacc += P0[r] + P1[r]; } \
            l += sacc; \
            _Pragma("unroll") for (int ks = 0; ks < 4; ++ks) { u32x4 w; \
                _Pragma("unroll") for (int i = 0; i < 4; ++i) { const int r = 8 * (ks & 1) + 2 * i; const float a = (ks < 2) ? P0[r] : P1[r], c = (ks < 2) ? P0[r + 1] : P1[r + 1]; w[i] = pg8::cvt_pk_bf16(a, c); } \
                pw[ks] = __builtin_bit_cast(bf16x8, w); } \
        } while (0)
#define ATT_PART(P0, P1, j_) do { \
            float rma = max3f(P0[0], P0[1], P1[0]), rmb = max3f(P0[2], P0[3], P1[1]); rma = max3f(rma, P1[2], P1[3]); \
            _Pragma("unroll") for (int r = 4; r < 16; r += 4) { rma = max3f(rma, P0[r], P0[r + 1]); rmb = max3f(rmb, P0[r + 2], P0[r + 3]); rma = max3f(rma, P1[r], P1[r + 1]); rmb = max3f(rmb, P1[r + 2], P1[r + 3]); } \
            float rm = swapmax(max2f(rma, rmb)); \
            const bool first_ = ((j_) == 0); \
            if (first_ || __any(rm > 8.0f)) { \
                const float dl = first_ ? rm : fmaxf(rm, 0.f), f = first_ ? 1.0f : __builtin_amdgcn_exp2f(-dl); mhat += dl; l *= f; \
                _Pragma("unroll") for (int r = 0; r < 16; ++r) { P0[r] -= dl; P1[r] -= dl; negm[r] = -mhat; } \
                ATT_LWAIT(); \
                if (hi == 0) wsf[r32] = f; \
                ATT_LWAIT(); \
                _Pragma("unroll") for (int r = 0; r < 16; ++r) { const float fr_ = wsf[crow(r, hi)]; \
                    _Pragma("unroll") for (int d0 = 0; d0 < 4; ++d0) o[d0][r] *= fr_; } \
                ATT_LWAIT(); \
            } \
            _Pragma("unroll") for (int r = 0; r < 16; ++r) P0[r] = __builtin_amdgcn_exp2f(P0[r]); \
        } while (0)
#define ATT_PV(voffs) do { \
            const ALAS unsigned char* vp = shm + (voffs) + ((lane >> 4) & 1) * 32 + (lane & 3) * 8 + (4 * hi + ((lane & 15) >> 2)) * 64; \
            _Pragma("unroll") for (int ks = 0; ks < 4; ++ks) \
                _Pragma("unroll") for (int d0 = 0; d0 < 4; ++d0) { \
                    const s16x4 lo = vtr(vp + d0 * 4096 + ks * 1024), hh = vtr(vp + d0 * 4096 + ks * 1024 + 512); \
                    const bf16x8 vf = (bf16x8){lo[0], lo[1], lo[2], lo[3], hh[0], hh[1], hh[2], hh[3]}; \
                    o[d0] = __builtin_amdgcn_mfma_f32_32x32x16_bf16(pw[ks], vf, o[d0], 0, 0, 0); } \
        } while (0)
#define ATT_STEP(PC0, PC1, PP0, PP1, j_) do { const int jj = (j_); \
            if (jj + 1 < NT) asm volatile("s_waitcnt vmcnt(3)" ::: "memory"); else if (jj + 1 == NT) asm volatile("s_waitcnt vmcnt(2)" ::: "memory"); else asm volatile("s_waitcnt vmcnt(0)" ::: "memory"); \
            __syncthreads(); \
            if (jj + 2 < NT) { const size_t go_ = (size_t)(jj + 2) * 64 * PITCH; pg8::glds_s(ksrc + go_, koff, shm0 + (unsigned)(s2 * KBYTES) + (unsigned)wid * 1024u); } \
            if (jj + 1 < NT) { const size_t go_ = (size_t)(jj + 1) * 64 * PITCH; const unsigned vd_ = shm0 + (unsigned)(VOFF0 + s1 * VBYTES); \
                pg8::glds_s(vsrc + go_, voff, vd_ + (unsigned)wid * 1024u); pg8::glds_s(vsrc + go_ + 64, voff, vd_ + (unsigned)(wid + 8) * 1024u); } \
            if (jj <= cw) ATT_QK(PC0, PC1, s0 * KBYTES); \
            if (jj >= 1 && jj - 1 <= cw) { ATT_FIN(PP0, PP1); ATT_PV(VOFF0 + s2 * VBYTES); } \
            if (jj <= cw) ATT_PART(PC0, PC1, jj); \
            { const int t_ = s0; s0 = s1; s1 = s2; s2 = t_; } \
        } while (0)
        {
            asm volatile("s_waitcnt vmcnt(0)" ::: "memory");
            pg8::glds_s(ksrc, koff, shm0 + (unsigned)wid * 1024u);
            pg8::glds_s(ksrc + (size_t)64 * PITCH, koff, shm0 + (unsigned)KBYTES + (unsigned)wid * 1024u);
            pg8::glds_s(vsrc, voff, shm0 + (unsigned)VOFF0 + (unsigned)wid * 1024u); pg8::glds_s(vsrc + 64, voff, shm0 + (unsigned)VOFF0 + (unsigned)(wid + 8) * 1024u);
        }
        int s0 = 0, s1 = 1, s2 = 2;
        f32x16 pA0, pA1, pB0, pB1;
#pragma unroll
        for (int r = 0; r < 16; ++r) { pA0[r] = 0.f; pA1[r] = 0.f; pB0[r] = 0.f; pB1[r] = 0.f; }
        for (int j = 0; j <= NT; j += 2) {
            ATT_STEP(pA0, pA1, pB0, pB1, j);
            if (j + 1 <= NT) ATT_STEP(pB0, pB1, pA0, pA1, j + 1);
        }
        __syncthreads();
#undef ATT_QK
#undef ATT_FIN
#undef ATT_PART
#undef ATT_PV
#undef ATT_STEP
#undef ATT_DMA
        const float lt = swapsum(l);
        ATT_LWAIT();
        if (hi == 0) wsf[32 + r32] = 1.0f / lt;
        ATT_LWAIT();
        float rli[16];
#pragma unroll
        for (int r = 0; r < 16; ++r) rli[r] = wsf[32 + crow(r, hi)];
        ATT_LWAIT();
        int lane2 = lane; asm volatile("" : "+v"(lane2));
        float* sp = (float*)((char*)myscr + (unsigned)lane2 * 16u);
        if (m == 0) {
#pragma unroll
            for (int d0 = 0; d0 < 4; ++d0) {
#pragma unroll
                for (int r4 = 0; r4 < 4; ++r4) { f32x4 v;
#pragma unroll
                    for (int i = 0; i < 4; ++i) v[i] = o[d0][4 * r4 + i] * rli[4 * r4 + i];
                    *(f32x4*)(sp + (d0 * 4 + r4) * 256) = v; }
                asm volatile("" ::: "memory"); }
        } else {
            float ss[16];
#pragma unroll
            for (int r = 0; r < 16; ++r) ss[r] = 0.f;
#pragma unroll
            for (int d0 = 0; d0 < 4; ++d0) {
#pragma unroll
                for (int r4 = 0; r4 < 4; ++r4) { const f32x4 v0 = *(const f32x4*)(sp + (d0 * 4 + r4) * 256);
#pragma unroll
                    for (int i = 0; i < 4; ++i) { const int r = 4 * r4 + i; const float v = v0[i] - lam * (o[d0][r] * rli[r]); o[d0][r] = v; ss[r] += v * v; } }
                asm volatile("" ::: "memory"); }
#pragma unroll
            for (int r = 0; r < 16; ++r) {
#pragma unroll
                for (int k = 1; k < 32; k <<= 1) ss[r] += __shfl_xor(ss[r], k);
                ss[r] = __builtin_amdgcn_rsqf(ss[r] * (1.0f / 128.0f) + 1e-5f) * outscale;
            }
            ALAS unsigned char* stw = shm + STG_OFF + wid * 8192;
            ALAS unsigned short* stg = (ALAS unsigned short*)stw + (4 * hi) * 128 + r32;
#pragma unroll
            for (int d0 = 0; d0 < 4; ++d0) { const float gg = subg[32 * d0 + (lane2 & 31)];
#pragma unroll
                for (int r = 0; r < 16; ++r) stg[((r & 3) + 8 * (r >> 2)) * 128 + 32 * d0] = (unsigned short)f2bf(o[d0][r] * ss[r] * gg); }
            ATT_LWAIT();
            bf16_t* Ow = (bf16_t*)((char*)(O + (rowbase + q0 + wid * 32) * PITCH + h * 128) + ((unsigned)(lane2 >> 4) * (PITCH * 2) + (unsigned)(lane2 & 15) * 16u));
#pragma unroll
            for (int i = 0; i < 8; ++i) { const u32x4 v = *(const ALAS u32x4*)(stw + i * 1024 + lane2 * 16); *(u32x4*)(Ow + (size_t)i * 4 * PITCH) = v; }
            ATT_LWAIT();
        }
    }
}
}

#ifndef PHMASK
#define PHMASK 0xFFFF
#endif
constexpr int NWAVES = 8;
constexpr int M = 32768, D = 1024, FF = 2816, SEQ = 8192;
constexpr float LN_EPS = 1e-5f;
constexpr float ALPHA = 1.4142135623730951f;
constexpr size_t MiB = 1u << 20;
constexpr size_t WS_BAR = 0;
constexpr size_t WS_ST = 1 * MiB;
constexpr size_t WS_TAB = 2 * MiB;
constexpr size_t WS_WQKV = 4 * MiB, WS_WO = 10 * MiB, WS_PW1 = 12 * MiB, WS_PW2 = 16 * MiB, WS_GU0 = 18 * MiB, WS_GU1 = 29 * MiB, WS_DN0 = 40 * MiB, WS_DN1 = 46 * MiB;
constexpr size_t WS_PAR = 52 * MiB;
constexpr int PO_LQ1 = 0, PO_LK1 = 64, PO_LQ2 = 128, PO_LK2 = 192, PO_SUBG = 256, PO_BPW1 = 384, PO_WDW = 2432, PO_BDW = 34176, PO_CLNG = 35200, PO_CLNB = 36224, PO_BPW2 = 37248, PO_LNG = 38272, PO_LNB = 42368, PO_END = 46464;
constexpr size_t WS_XN = 64 * MiB;
constexpr size_t WS_Q = 128 * MiB, WS_K = 192 * MiB, WS_V = 256 * MiB;
constexpr size_t WS_H = 128 * MiB;
constexpr size_t WS_G = 128 * MiB, WS_C = 192 * MiB;
constexpr size_t WS_Z = 320 * MiB;
constexpr size_t WS_END = 448 * MiB;
constexpr int LDS_BYTES = 147456;

#define LAS __attribute__((address_space(3)))
typedef unsigned short bf16;
typedef unsigned v4u __attribute__((ext_vector_type(4)));
typedef unsigned v2u __attribute__((ext_vector_type(2)));
typedef float f32x4 __attribute__((ext_vector_type(4)));
#define LDS_WAIT() asm volatile("s_waitcnt lgkmcnt(0)" ::: "memory")
__device__ __forceinline__ unsigned f2bf(float f) { unsigned u = __builtin_bit_cast(unsigned, f); return (u + 0x7fffu + ((u >> 16) & 1u)) >> 16; }
__device__ __forceinline__ unsigned pk2(float lo, float hi) { return f2bf(lo) | (f2bf(hi) << 16); }
__device__ __forceinline__ float wave_sum(float v) {
#pragma unroll
    for (int o = 1; o < 64; o <<= 1) v += __shfl_xor(v, o);
    return v;
}
__device__ __forceinline__ int map_row(int mode, int n) {
    if (mode == 1) {
        if (n >= 2048) return n;
        const int region = n >> 10, within = n & 1023, slice = within >> 6, d = within & 63;
        return 256 * (region * 4 + (slice >> 2)) + 128 * (d >> 5) + 32 * (slice & 3) + (d & 31);
    }
    if (mode == 2) { const int half = n >> 10, j = n & 1023; return 256 * (j >> 7) + 128 * half + (j & 127); }
    if (mode == 3) return 256 * (n >> 7) + (n & 127);
    if (mode == 4) return 256 * (n >> 7) + 128 + (n & 127);
    return n;
}
__device__ __forceinline__ void transpose_item(const float* W, int K, int N, bf16* WT, int mode, LAS float* scr, int item, int lane) {
    const int nblk = N / 64, kb = item / nblk, nb = item % nblk, k0 = 64 * kb, n0 = 64 * nb;
    const float* src = W + (size_t)(k0 + (lane >> 4)) * N + n0 + 4 * (lane & 15);
    f32x4 v[16];
#pragma unroll
    for (int i = 0; i < 16; ++i) v[i] = *(const f32x4*)(src + (size_t)(4 * i) * N);
    LAS float* sw = scr + (lane >> 4) * 65 + 4 * (lane & 15);
#pragma unroll
    for (int i = 0; i < 16; ++i) { sw[(4 * i) * 65 + 0] = v[i].x; sw[(4 * i) * 65 + 1] = v[i].y; sw[(4 * i) * 65 + 2] = v[i].z; sw[(4 * i) * 65 + 3] = v[i].w; }
    LDS_WAIT(); asm volatile("" ::: "memory");
    const int c = lane & 7;
#pragma unroll
    for (int j = 0; j < 8; ++j) { const int n = (lane >> 3) + 8 * j; const LAS float* s = scr + (8 * c) * 65 + n;
        v4u o; o.x = pk2(s[0 * 65], s[1 * 65]); o.y = pk2(s[2 * 65], s[3 * 65]); o.z = pk2(s[4 * 65], s[5 * 65]); o.w = pk2(s[6 * 65], s[7 * 65]);
        *(v4u*)(WT + (size_t)map_row(mode, n0 + n) * K + k0 + 8 * c) = o; }
    LDS_WAIT(); asm volatile("" ::: "memory");
}

#define XB_TMO      128
#define XB_XCNT(j)  (256  + 64 * (j))
#define XB_XSUB(j)  (1280 + 64 * (j))
#define XB_XGEN(j)  (2304 + 64 * (j))
#define XB_TOP      3328
#define XB_TOPGEN   3392
#define XCD_BAR_WORDS 3456
#define XB_SPIN_CAP (1u << 18)

__device__ __forceinline__ unsigned xb_ld(unsigned* p)              { return __hip_atomic_load(p, __ATOMIC_RELAXED, __HIP_MEMORY_SCOPE_AGENT); }
__device__ __forceinline__ unsigned xb_add(unsigned* p, unsigned v) { return __hip_atomic_fetch_add(p, v, __ATOMIC_RELAXED, __HIP_MEMORY_SCOPE_AGENT); }
__device__ __forceinline__ unsigned xb_xcc_id() { return (unsigned)__builtin_amdgcn_s_getreg((3 << 11) | 20) & 0xFu; }
#define XB_SPIN(cond, bar) do { unsigned _sp = 0; while (cond) { __builtin_amdgcn_s_sleep(1); \
    if ((++_sp & 255u) == 0u) { if (xb_ld(&(bar)[XB_TMO])) break; if (_sp > XB_SPIN_CAP) { atomicAdd(&(bar)[XB_TMO], 1u); break; } } } } while (0)

struct XcdBarrier {
    unsigned* bar; unsigned x;
    volatile LAS unsigned* st;
};

__device__ __forceinline__ XcdBarrier xcd_barrier_post(unsigned* bar, volatile LAS unsigned* st) {
    XcdBarrier b; b.bar = bar; b.x = xb_xcc_id(); b.st = st;
    if (threadIdx.x == 0) (void)xb_add(&bar[XB_XCNT(b.x)], 1u);
    return b;
}
__device__ __forceinline__ void xcd_barrier_complete(unsigned* bar, unsigned x, unsigned& nloc, unsigned& nx) {
    const unsigned G = gridDim.x * gridDim.y * gridDim.z;
    unsigned sum, cnt, mine, sp = 0u;
    for (;;) {
        sum = 0u; cnt = 0u; mine = 0u;
#pragma unroll
        for (unsigned j = 0; j < 16; ++j) { const unsigned c = xb_ld(&bar[XB_XCNT(j)]); sum += c; cnt += (c > 0u) ? 1u : 0u; mine = (j == x) ? c : mine; }
        if (sum == G) break;
        __builtin_amdgcn_s_sleep(1);
        if ((++sp & 255u) == 0u) { if (xb_ld(&bar[XB_TMO])) break; if (sp > XB_SPIN_CAP) { atomicAdd(&bar[XB_TMO], 1u); break; } }
    }
    nloc = mine > 0u ? mine : 1u; nx = cnt > 0u ? cnt : 1u;
}

__device__ __forceinline__ void xcd_barrier(const XcdBarrier& b) {
    asm volatile("s_waitcnt vmcnt(0)" ::: "memory");
    __syncthreads();
    if (threadIdx.x == 0) {
        unsigned* bar = b.bar;
        __builtin_amdgcn_s_waitcnt(0);
        unsigned nloc = b.st[0], nx = b.st[1];
        if (nloc == 0u) { xcd_barrier_complete(bar, b.x, nloc, nx); b.st[0] = nloc; b.st[1] = nx; }
        const unsigned old = xb_add(&bar[XB_XSUB(b.x)], 1u);
        const unsigned gen = old / nloc;
        if (old + 1u == (gen + 1u) * nloc) {
            __builtin_amdgcn_fence(__ATOMIC_RELEASE, "agent");
            asm volatile("s_waitcnt vmcnt(0)" ::: "memory");
            const unsigned og = xb_add(&bar[XB_TOP], 1u);
            const unsigned tg = og / nx;
            if (og + 1u == (tg + 1u) * nx) xb_add(&bar[XB_TOPGEN], 1u);
            else XB_SPIN(xb_ld(&bar[XB_TOPGEN]) == tg, bar);
            __builtin_amdgcn_fence(__ATOMIC_ACQUIRE, "agent");
            xb_add(&bar[XB_XGEN(b.x)], 1u);
            asm volatile("s_waitcnt vmcnt(0)" ::: "memory");
        } else {
            XB_SPIN(xb_ld(&bar[XB_XGEN(b.x)]) == gen, bar);
            __builtin_amdgcn_fence(__ATOMIC_ACQUIRE, "agent");
            asm volatile("s_waitcnt vmcnt(0)" ::: "memory");
        }
    }
    __syncthreads();
}

struct Args { const float* in[21]; float* out; unsigned char* ws; };

__device__ __forceinline__ void ln_phase(const float* Z, bf16* XN, float* ST, const float* g, const float* b, float* OUT, int gw, int NGW, int lane) {
    asm volatile("" : "+v"(lane));
    f32x4 gv[4], bv[4];
#pragma unroll
    for (int j = 0; j < 4; ++j) { gv[j] = *((const f32x4*)g + lane + 64 * j); bv[j] = *((const f32x4*)b + lane + 64 * j); }
    for (int row0 = gw; row0 < M; row0 += 2 * NGW) {
        f32x4 v[2][4]; float mean[2], rstd[2];
#pragma unroll
        for (int q = 0; q < 2; ++q) { const f32x4* zr = (const f32x4*)(Z + (size_t)(row0 + q * NGW) * D) + lane;
#pragma unroll
            for (int j = 0; j < 4; ++j) v[q][j] = zr[64 * j]; }
#pragma unroll
        for (int q = 0; q < 2; ++q) { float s = 0.f;
#pragma unroll
            for (int j = 0; j < 4; ++j) s += (v[q][j].x + v[q][j].y) + (v[q][j].z + v[q][j].w);
            mean[q] = wave_sum(s) * (1.f / D); float s2 = 0.f;
#pragma unroll
            for (int j = 0; j < 4; ++j) { v[q][j] = v[q][j] - mean[q]; s2 += (v[q][j].x * v[q][j].x + v[q][j].y * v[q][j].y) + (v[q][j].z * v[q][j].z + v[q][j].w * v[q][j].w); }
            rstd[q] = 1.f / sqrtf(wave_sum(s2) * (1.f / D) + LN_EPS); }
#pragma unroll
        for (int q = 0; q < 2; ++q) { const int row = row0 + q * NGW;
            if (OUT) {
                f32x4* orow = (f32x4*)(OUT + (size_t)row * D) + lane;
#pragma unroll
                for (int j = 0; j < 4; ++j) orow[64 * j] = v[q][j] * rstd[q] * gv[j] + bv[j];
            } else {
                if (lane == 0) { ST[2 * row] = mean[q]; ST[2 * row + 1] = rstd[q]; }
                v2u* o8 = (v2u*)(XN + (size_t)row * D) + lane;
#pragma unroll
                for (int j = 0; j < 4; ++j) { const f32x4 y = v[q][j] * rstd[q] * gv[j] + bv[j]; v2u w; w.x = pk2(y.x, y.y); w.y = pk2(y.z, y.w); o8[64 * j] = w; }
            } }
    }
}

__global__ void __launch_bounds__(NWAVES * 64, 2) fwd_kernel(Args args) {
    extern __shared__ __attribute__((aligned(16))) unsigned char lds[];
    cg::grid_group grid = cg::this_grid();
    LAS unsigned char* L = (LAS unsigned char*)lds;
    const int tid = threadIdx.x, lane = tid & 63, wave = __builtin_amdgcn_readfirstlane(tid >> 6);
    const int G = gridDim.x, bx = blockIdx.x;
    const int vcu = (G % 8 == 0) ? (bx % 8) * (G / 8) + bx / 8 : bx;
    const int gw = vcu * NWAVES + wave, NGW = G * NWAVES;
    unsigned char* ws = args.ws;
    const float* x = args.in[0];
    const float *w_qkv = args.in[1], *w_o = args.in[2], *w_pw1 = args.in[8], *w_pw2 = args.in[14], *w_gate = args.in[16], *w_up = args.in[17], *w_down = args.in[18];
    float* PARW = (float*)(ws + WS_PAR); const float* PAR = PARW;
    const float *lq1 = PAR + PO_LQ1, *lk1 = PAR + PO_LK1, *lq2 = PAR + PO_LQ2, *lk2 = PAR + PO_LK2, *subln_g = PAR + PO_SUBG, *b_pw1 = PAR + PO_BPW1, *w_dw = PAR + PO_WDW, *b_dw = PAR + PO_BDW;
    const float *cln_g = PAR + PO_CLNG, *cln_b = PAR + PO_CLNB, *b_pw2 = PAR + PO_BPW2, *ln_g = PAR + PO_LNG, *ln_b = PAR + PO_LNB;
    float* ST = (float*)(ws + WS_ST); float* TAB = (float*)(ws + WS_TAB);
    bf16 *Wqkv_t = (bf16*)(ws + WS_WQKV), *Wo_t = (bf16*)(ws + WS_WO), *Wpw1_t = (bf16*)(ws + WS_PW1), *Wpw2_t = (bf16*)(ws + WS_PW2);
    bf16 *Wgu0 = (bf16*)(ws + WS_GU0), *Wgu1 = (bf16*)(ws + WS_GU1), *Wdn0 = (bf16*)(ws + WS_DN0), *Wdn1 = (bf16*)(ws + WS_DN1);
    bf16 *XN = (bf16*)(ws + WS_XN), *QB = (bf16*)(ws + WS_Q), *KB = (bf16*)(ws + WS_K), *VB = (bf16*)(ws + WS_V), *HB = (bf16*)(ws + WS_H), *GB = (bf16*)(ws + WS_G), *CB = (bf16*)(ws + WS_C);
    float* Z = (float*)(ws + WS_Z);

    volatile LAS unsigned* xbst = (volatile LAS unsigned*)(L + LDS_BYTES - 64);
    if (tid < 2) xbst[tid] = 0u;
    if (bx == 0) for (int u = tid; u < XCD_BAR_WORDS; u += NWAVES * 64) __hip_atomic_store((unsigned*)(ws + WS_BAR) + u, 0u, __ATOMIC_RELAXED, __HIP_MEMORY_SCOPE_AGENT);
    __syncthreads();
    {
        LAS float* scr = (LAS float*)(L + wave * 16640);
        constexpr int I_QKV = 16 * 48, I_O = 16 * 16, I_PW1 = 16 * 32, I_PW2 = 16 * 16, I_GU = 16 * 44, I_DN = 44 * 16;
        constexpr int NITEMS = I_QKV + I_O + I_PW1 + I_PW2 + 4 * I_GU + 2 * I_DN;
        for (int it = gw; it < NITEMS; it += NGW) {
            int r = it;
            if (r < I_QKV) { transpose_item(w_qkv, D, 3 * D, Wqkv_t, 1, scr, r, lane); continue; } r -= I_QKV;
            if (r < I_O) { transpose_item(w_o, D, D, Wo_t, 0, scr, r, lane); continue; } r -= I_O;
            if (r < I_PW1) { transpose_item(w_pw1, D, 2 * D, Wpw1_t, 2, scr, r, lane); continue; } r -= I_PW1;
            if (r < I_PW2) { transpose_item(w_pw2, D, D, Wpw2_t, 0, scr, r, lane); continue; } r -= I_PW2;
            if (r < I_GU) { transpose_item(w_gate, D, FF, Wgu0, 3, scr, r, lane); continue; } r -= I_GU;
            if (r < I_GU) { transpose_item(w_up, D, FF, Wgu0, 4, scr, r, lane); continue; } r -= I_GU;
            if (r < I_GU) { transpose_item(w_gate + (size_t)D * FF, D, FF, Wgu1, 3, scr, r, lane); continue; } r -= I_GU;
            if (r < I_GU) { transpose_item(w_up + (size_t)D * FF, D, FF, Wgu1, 4, scr, r, lane); continue; } r -= I_GU;
            if (r < I_DN) { transpose_item(w_down, FF, D, Wdn0, 0, scr, r, lane); continue; } r -= I_DN;
            transpose_item(w_down + (size_t)FF * D, FF, D, Wdn1, 0, scr, r, lane);
        }
        for (int row = gw; row < M; row += 4 * NGW) {
            f32x4 y[4][4];
#pragma unroll
            for (int q = 0; q < 4; ++q) { const f32x4* xr = (const f32x4*)(x + (size_t)(row + q * NGW) * D) + 2 * lane;
                y[q][0] = xr[0]; y[q][1] = xr[1]; y[q][2] = xr[128]; y[q][3] = xr[129]; }
#pragma unroll
            for (int q = 0; q < 4; ++q) { v4u* o16 = (v4u*)(XN + (size_t)(row + q * NGW) * D) + lane;
                v4u w0, w1; w0.x = pk2(y[q][0].x, y[q][0].y); w0.y = pk2(y[q][0].z, y[q][0].w); w0.z = pk2(y[q][1].x, y[q][1].y); w0.w = pk2(y[q][1].z, y[q][1].w);
                w1.x = pk2(y[q][2].x, y[q][2].y); w1.y = pk2(y[q][2].z, y[q][2].w); w1.z = pk2(y[q][3].x, y[q][3].y); w1.w = pk2(y[q][3].z, y[q][3].w);
                o16[0] = w0; o16[64] = w1; }
        }
        for (int e = bx * (NWAVES * 64) + tid; e < PO_END; e += G * NWAVES * 64) {
            float v;
            if (e < PO_LK1) v = args.in[3][e - PO_LQ1]; else if (e < PO_LQ2) v = args.in[4][e - PO_LK1]; else if (e < PO_LK2) v = args.in[5][e - PO_LQ2]; else if (e < PO_SUBG) v = args.in[6][e - PO_LK2];
            else if (e < PO_BPW1) v = args.in[7][e - PO_SUBG]; else if (e < PO_WDW) v = args.in[9][e - PO_BPW1]; else if (e < PO_BDW) v = args.in[10][e - PO_WDW]; else if (e < PO_CLNG) v = args.in[11][e - PO_BDW];
            else if (e < PO_CLNB) v = args.in[12][e - PO_CLNG]; else if (e < PO_BPW2) v = args.in[13][e - PO_CLNB]; else if (e < PO_LNG) v = args.in[15][e - PO_BPW2]; else if (e < PO_LNB) v = args.in[19][e - PO_LNG];
            else v = args.in[20][e - PO_LNB];
            PARW[e] = v;
        }
        for (int e = bx * (NWAVES * 64) + tid; e < SEQ * 32; e += G * NWAVES * 64) {
            const int pos = e >> 5, i = e & 31, i8 = i & 7, i3 = i >> 3;
            double c = (i8 == 0) ? 1.0 : (i8 == 1) ? 0.7498942093324559 : (i8 == 2) ? 0.5623413251903491 : (i8 == 3) ? 0.4216965034285822 : (i8 == 4) ? 0.31622776601683794 : (i8 == 5) ? 0.23713737056616552 : (i8 == 6) ? 0.1778279410038923 : 0.1333521432163324;
            c *= (i3 == 0) ? 1.0 : (i3 == 1) ? 0.1 : (i3 == 2) ? 0.01 : 0.001;
            const double rev = (double)pos * c * 0.15915494309189535;
            const float fr = (float)(rev - __builtin_floor(rev));
            TAB[pos * 64 + i] = __builtin_amdgcn_cosf(fr); TAB[pos * 64 + 32 + i] = __builtin_amdgcn_sinf(fr);
        }
    }
    grid.sync();
    const XcdBarrier xbar = xcd_barrier_post((unsigned*)(ws + WS_BAR), xbst);

    if (PHMASK & (1 << 1)) {
        pg8::Gemm g{XN, Wqkv_t, M, 3 * D, D}; pg8::StaticOrder S; S.init(M, 3 * D, G, bx);
        pg8::EpiQKV E{QB, KB, VB, TAB, 0.125f * 1.4426950408889634f};
        pg8::gemm_phase<pg8::EpiQKV, pg8::StaticOrder, true, true>(L, g, S, E);
    }
    xcd_barrier(xbar);

    if (PHMASK & (1 << 2)) {
        const float d1 = wave_sum(lq1[lane] * lk1[lane]), d2 = wave_sum(lq2[lane] * lk2[lane]);
        const float lam = __expf(d1) - __expf(d2) + 0.2f;
        for (int idx = vcu; idx < 1024; idx += G) {
            const int v = idx & 255, i = idx >> 8, bh = v >> 3, s = v & 7;
            const int qb = (i == 0) ? 31 - s : (i == 1) ? 16 + s : (i == 2) ? 15 - s : s;
            att::attn_unit(bh >> 3, bh & 7, qb, QB, KB, VB, XN, Z, L, lam, 0.8f, subln_g);
        }
    }
    xcd_barrier(xbar);

    if (PHMASK & (1 << 3)) {
        pg8::Gemm g{XN, Wo_t, M, D, D}; pg8::StaticOrder S; S.init(M, D, G, bx);
        pg8::EpiResid<0> E{x, Z, nullptr, nullptr, nullptr, nullptr, ALPHA};
        pg8::gemm_phase<pg8::EpiResid<0>, pg8::StaticOrder, true, true>(L, g, S, E);
    }
    xcd_barrier(xbar);
    ln_phase(Z, XN, ST, ln_g, ln_b, nullptr, gw, NGW, lane);
    xcd_barrier(xbar);

    for (int layer = 0; layer < 2; ++layer) {
        if (layer == 1) {
            if (PHMASK & (1 << 8)) {
                pg8::Gemm g{XN, Wpw1_t, M, 2 * D, D}; pg8::StaticOrder S; S.init(M, 2 * D, G, bx);
                pg8::EpiGLU E{GB, b_pw1};
                pg8::gemm_phase<pg8::EpiGLU, pg8::StaticOrder, true, true>(L, g, S, E);
            }
            xcd_barrier(xbar);
            if (PHMASK & (1 << 9)) {
                int ctid = threadIdx.x; asm volatile("" : "+v"(ctid));
                const int clane = ctid & 63, cwave = __builtin_amdgcn_readfirstlane(ctid >> 6);
                LAS unsigned* tile = (LAS unsigned*)L;
                LAS float* red = (LAS float*)(L + 126976);
                LAS float* stat = red + 512;
                const unsigned L0 = (unsigned)(uintptr_t)L;
                for (int unit = vcu; unit < M / 32; unit += G) {
                    const int row0 = unit * 32, s0 = row0 & (SEQ - 1);
                    int c2 = ctid; asm volatile("" : "+v"(c2));
                    float w0[31], w1[31];
#pragma unroll
                    for (int t = 0; t < 31; ++t) { const float2 wv = *(const float2*)(w_dw + t * D + 2 * c2); w0[t] = wv.x; w1[t] = wv.y; }
                    const float bd0 = b_dw[2 * c2], bd1 = b_dw[2 * c2 + 1];
                    for (int p = cwave; p < 124; p += NWAVES) { const int rr = p >> 1;
                        if (s0 == 0 && rr < 30) *(LAS v4u*)(L + p * 1024 + clane * 16) = (v4u){0u, 0u, 0u, 0u};
                        else pg8::glds_s(GB + (size_t)(row0 - 30 + rr) * D + (p & 1) * 512, (unsigned)clane * 16u, L0 + (unsigned)p * 1024u); }
                    asm volatile("s_waitcnt vmcnt(0)" ::: "memory");
                    __syncthreads();
                    float y0[32], y1[32];
#pragma unroll
                    for (int r = 0; r < 32; ++r) { y0[r] = bd0; y1[r] = bd1; }
#pragma unroll
                    for (int k = 0; k < 62; ++k) { const unsigned xk = tile[k * 512 + c2]; const float a0 = __uint_as_float(xk << 16), a1 = __uint_as_float(xk & 0xffff0000u);
#pragma unroll
                        for (int r = 0; r < 32; ++r) { const int t = k - r; if (t >= 0 && t <= 30) { y0[r] += w0[t] * a0; y1[r] += w1[t] * a1; } } }
                    float vals[64];
#pragma unroll
                    for (int r = 0; r < 32; ++r) { vals[2 * r] = y0[r] + y1[r]; vals[2 * r + 1] = y0[r] * y0[r] + y1[r] * y1[r]; }
#define CONV_BFLY(MK) do { const bool up = (clane & (MK)) != 0; _Pragma("unroll") for (int k = 0; k < (MK); ++k) { const float a = vals[k], b = vals[k + (MK)]; const float snd = up ? a : b, kp = up ? b : a; vals[k] = kp + __shfl_xor(snd, (MK)); } } while (0)
                    CONV_BFLY(32); CONV_BFLY(16); CONV_BFLY(8); CONV_BFLY(4); CONV_BFLY(2); CONV_BFLY(1);
#undef CONV_BFLY
                    red[cwave * 64 + clane] = vals[0];
                    __syncthreads();
                    if (ctid < 32) { float sm = 0.f, q = 0.f;
#pragma unroll
                        for (int w = 0; w < 8; ++w) { sm += red[w * 64 + 2 * ctid]; q += red[w * 64 + 2 * ctid + 1]; }
                        const float mean = sm * (1.f / D), var = q * (1.f / D) - mean * mean;
                        stat[2 * ctid] = mean; stat[2 * ctid + 1] = 1.f / sqrtf(fmaxf(var, 0.f) + LN_EPS); }
                    __syncthreads();
                    int c3 = ctid; asm volatile("" : "+v"(c3));
                    const float g0 = cln_g[2 * c3], g1 = cln_g[2 * c3 + 1], bb0 = cln_b[2 * c3], bb1 = cln_b[2 * c3 + 1];
                    unsigned* op = (unsigned*)(CB + (size_t)row0 * D) + c3;
#pragma unroll
                    for (int r = 0; r < 32; ++r) {
                        const float mean = stat[2 * r], rstd = stat[2 * r + 1];
                        float n0 = (y0[r] - mean) * rstd * g0 + bb0, n1 = (y1[r] - mean) * rstd * g1 + bb1;
                        n0 = n0 * __builtin_amdgcn_rcpf(1.0f + __builtin_amdgcn_exp2f(n0 * -1.4426950408889634f));
                        n1 = n1 * __builtin_amdgcn_rcpf(1.0f + __builtin_amdgcn_exp2f(n1 * -1.4426950408889634f));
                        op[r * 512] = pk2(n0, n1);
                    }
                }
                __syncthreads();
            }
            xcd_barrier(xbar);
            if (PHMASK & (1 << 10)) {
                pg8::Gemm g{CB, Wpw2_t, M, D, D}; pg8::StaticOrder S; S.init(M, D, G, bx);
                pg8::EpiResid<1> E{Z, Z, ST, ln_g + 1 * D, ln_b + 1 * D, b_pw2, ALPHA};
                pg8::gemm_phase<pg8::EpiResid<1>, pg8::StaticOrder, true, true>(L, g, S, E);
            }
            xcd_barrier(xbar);
            ln_phase(Z, XN, ST, ln_g + 2 * D, ln_b + 2 * D, nullptr, gw, NGW, lane);
            xcd_barrier(xbar);
        }
        if (PHMASK & (1 << 5)) {
            pg8::Gemm g{XN, layer ? Wgu1 : Wgu0, M, 2 * FF, D}; pg8::StaticOrder S; S.init(M, 2 * FF, G, bx);
            pg8::EpiSwiGLU E{HB, FF};
            pg8::gemm_phase<pg8::EpiSwiGLU, pg8::StaticOrder, true, true>(L, g, S, E);
        }
        xcd_barrier(xbar);
        if (PHMASK & (1 << 6)) {
            pg8::Gemm g{HB, layer ? Wdn1 : Wdn0, M, D, FF}; pg8::StaticOrder S; S.init(M, D, G, bx);
            pg8::EpiResid<1> E{Z, Z, ST, ln_g + (2 * layer) * D, ln_b + (2 * layer) * D, nullptr, ALPHA};
            pg8::gemm_phase<pg8::EpiResid<1>, pg8::StaticOrder, true, true>(L, g, S, E);
        }
        xcd_barrier(xbar);
        if (layer == 0) { ln_phase(Z, XN, ST, ln_g + 1 * D, ln_b + 1 * D, nullptr, gw, NGW, lane); xcd_barrier(xbar); }
        else ln_phase(Z, nullptr, ST, ln_g + 3 * D, ln_b + 3 * D, args.out, gw, NGW, lane);
    }
}

extern "C" void kernel_launch(void* const* d_in, const int* in_sizes, int n_in, void* d_out, int out_size, void* d_ws, size_t ws_size, hipStream_t stream) {
    static int grid = 0;
    if (grid == 0) {
        if (n_in != 21 || out_size != M * D || ws_size < WS_END) { fprintf(stderr, "kernel_launch: unexpected shapes (n_in %d out %d ws %zu)\n", n_in, out_size, ws_size); grid = -1; return; }
        int dev = 0, cus = 0, per_cu = 0;
        hipGetDevice(&dev); hipDeviceGetAttribute(&cus, hipDeviceAttributeMultiprocessorCount, dev);
        if (hipFuncSetAttribute((const void*)fwd_kernel, hipFuncAttributeMaxDynamicSharedMemorySize, LDS_BYTES) != hipSuccess) { fprintf(stderr, "kernel_launch: hipFuncSetAttribute failed\n"); grid = -1; return; }
        hipOccupancyMaxActiveBlocksPerMultiprocessor(&per_cu, (const void*)fwd_kernel, NWAVES * 64, LDS_BYTES);
        (void)hipGetLastError();
        grid = cus * (per_cu > 0 ? 1 : 1);
        if (grid > 256) grid = 256;
        grid &= ~7;
        fprintf(stderr, "kernel_launch: cus %d per_cu %d grid %d\n", cus, per_cu, grid);
    }
    if (grid <= 0) return;
    Args a{};
    for (int i = 0; i < 21; ++i) a.in[i] = (const float*)d_in[i];
    a.out = (float*)d_out; a.ws = (unsigned char*)d_ws;
    void* kargs[] = {&a};
    hipError_t e = hipLaunchCooperativeKernel((const void*)fwd_kernel, dim3(grid), dim3(NWAVES * 64), kargs, LDS_BYTES, stream);
    if (e != hipSuccess) fprintf(stderr, "kernel_launch: cooperative launch failed: %s (grid %d)\n", hipGetErrorString(e), grid);
}
```

```cpp
#include <hip/hip_runtime.h>
#include <hip/hip_cooperative_groups.h>
#include <cstdio>
#include <cstdint>
namespace cg = cooperative_groups;
namespace pg8 {
#define PG8_LAS __attribute__((address_space(3)))
typedef unsigned short bf16_t;
typedef short bf16x8 __attribute__((ext_vector_type(8)));
typedef float f32x4 __attribute__((ext_vector_type(4)));
typedef unsigned u32x4 __attribute__((ext_vector_type(4)));
constexpr int BM = 256, BK = 64, HALF = 128, HTB = HALF * BK * 2  , STAGE_BYTES = 8 * HTB, NXCD = 8, WGM = 8;

__host__ __device__ __forceinline__ int lds_byte(int r, int c) { const int st = (r >> 4) * 2 + (c >> 5), rr = r & 15, cc = c & 31, ob = rr * 64 + cc * 2; return st * 1024 + (ob ^ (((ob >> 9) & 1) << 5)); }
__host__ __device__ __forceinline__ void stage_rc(int b, int& R, int& C) { const int st = b / 1024, sb = b % 1024, swz = sb ^ (((sb >> 9) & 1) << 5); R = (st >> 1) * 16 + swz / 64; C = (st & 1) * 32 + (swz % 64) / 2; }
__host__ __device__ __forceinline__ int perm32(int rho) { const int n = rho >> 4, i = rho & 15; return 8 * (i >> 2) + 4 * n + (i & 3); }

struct Unit { int pm, pn; };
struct Gemm { const bf16_t* A; const bf16_t* Bt; int M, N, K; };

struct StaticOrder {
    int nM, nN, nwg, G, c;
    __host__ __device__ void init(int M, int N, int G_, int c_) { nM = M / BM; nN = N / BM; nwg = nM * nN; G = G_; c = c_; }
    __host__ __device__ bool next(int i, Unit& u) const {
        const long L = (long)i * G + c; if (L >= nwg) return false;
        int wgid = (int)L; { const int q = nwg / NXCD, r = nwg % NXCD, xcd = wgid % NXCD, off = wgid / NXCD; wgid = (xcd < r ? xcd * (q + 1) : r * (q + 1) + (xcd - r) * q) + off; }
        const int nig = WGM * nN, gid = wgid / nig, fm = gid * WGM, gsz = (nM - fm) < WGM ? (nM - fm) : WGM;
        u.pm = fm + ((wgid % nig) % gsz); u.pn = (wgid % nig) / gsz; return true;
    }
    __device__ __forceinline__ void a_ready(const Unit&) const {}
    __device__ __forceinline__ void done(const Unit&) const {}
};

__device__ __forceinline__ unsigned cvt_pk_bf16(float lo, float hi) { unsigned r; asm volatile("v_cvt_pk_bf16_f32 %0, %1, %2" : "=v"(r) : "v"(lo), "v"(hi)); return r; }
__device__ __forceinline__ void glds_s(const void* sbase, unsigned voff, unsigned ldsdst) {
    unsigned keep;
    asm volatile("s_mov_b32 %0, m0\n\ts_mov_b32 m0, %3\n\ts_nop 0\n\tglobal_load_lds_dwordx4 %1, %2\n\ts_mov_b32 m0, %0" : "=&s"(keep) : "v"(voff), "s"(sbase), "s"(ldsdst) : "memory");
}
typedef float f32x2 __attribute__((ext_vector_type(2)));
__device__ __forceinline__ f32x2 gelu_pk(f32x2 v) {
    const f32x2 av = __builtin_elementwise_abs(v), d = av * 0.2316418882f + 1.0f;
    f32x2 t; t.x = __builtin_amdgcn_rcpf(d.x); t.y = __builtin_amdgcn_rcpf(d.y);
    f32x2 q = t * 0.5307027145f + (-0.7265760135f); q = q * t + 0.7107068705f; q = q * t + (-0.142248368f); q = q * t + 0.127414796f; q = q * t;
    const f32x2 s = (v * v) * (-0.72134752044f);
    f32x2 e; e.x = __builtin_amdgcn_exp2f(s.x); e.y = __builtin_amdgcn_exp2f(s.y);
    const f32x2 m = v * (q * e), r = v - m;
    f32x2 o; o.x = v.x < 0.f ? m.x : r.x; o.y = v.y < 0.f ? m.y : r.y; return o;
}

template <int ACT  > struct EpiBf16 {
    static constexpr bool PERM = true, AFTER_DRAIN = false; static_assert(ACT == 0 || ACT == 1, "EpiBf16: ACT is 0 (none) or 1 (gelu_pk)");
    bf16_t* O; int ldc; const float* bias; int split_cols; size_t split_stride; float scale0;
    __device__ __forceinline__ void operator()(const f32x4 (&acc)[2][2][4][2], const Unit& u, int wr, int wc, int fr_in, int fq_in) const {
        int fr = fr_in, fq = fq_in; asm volatile("" : "+v"(fr), "+v"(fq));
        const int row0 = u.pm * BM + wr * 64 + fr; int colt = u.pn * BM; bf16_t* base = O;
        float sc = 1.f; if (split_cols) { const int t = colt / split_cols; base += (size_t)t * split_stride; colt -= t * split_cols; if (t == 0) sc = scale0; }
        const int col0 = colt + wc * 32 + 8 * fq, bcol0 = u.pn * BM + wc * 32 + 8 * fq;
        f32x4 bv[2][2];
#pragma unroll
        for (int bj = 0; bj < 2; ++bj)
#pragma unroll
            for (int n = 0; n < 2; ++n) bv[bj][n] = bias ? *(const f32x4*)(bias + bcol0 + bj * HALF + 4 * n) : (f32x4){0.f, 0.f, 0.f, 0.f};
#pragma unroll
        for (int ai = 0; ai < 2; ++ai)
#pragma unroll
            for (int m = 0; m < 4; ++m) { bf16_t* rowp = base + (size_t)(row0 + ai * HALF + m * 16) * ldc + col0;
#pragma unroll
                for (int bj = 0; bj < 2; ++bj) { f32x4 v0 = acc[ai][bj][m][0] + bv[bj][0], v1 = acc[ai][bj][m][1] + bv[bj][1];
                    if (ACT == 1) { f32x2 a = gelu_pk((f32x2){v0[0], v0[1]}), b = gelu_pk((f32x2){v0[2], v0[3]}), c = gelu_pk((f32x2){v1[0], v1[1]}), d = gelu_pk((f32x2){v1[2], v1[3]});
                        v0 = (f32x4){a.x, a.y, b.x, b.y}; v1 = (f32x4){c.x, c.y, d.x, d.y}; }
                    v0 = v0 * sc; v1 = v1 * sc; u32x4 w; w.x = cvt_pk_bf16(v0[0], v0[1]); w.y = cvt_pk_bf16(v0[2], v0[3]); w.z = cvt_pk_bf16(v1[0], v1[1]); w.w = cvt_pk_bf16(v1[2], v1[3]);
                    *(u32x4*)(rowp + bj * HALF) = w; } }
    }
};
__device__ __forceinline__ u32x4 pack8(const f32x4 v0, const f32x4 v1) { u32x4 w; w.x = cvt_pk_bf16(v0[0], v0[1]); w.y = cvt_pk_bf16(v0[2], v0[3]); w.z = cvt_pk_bf16(v1[0], v1[1]); w.w = cvt_pk_bf16(v1[2], v1[3]); return w; }
__device__ __forceinline__ f32x4 sigm4(const f32x4 g) {
    f32x4 r;
#pragma unroll
    for (int i = 0; i < 4; ++i) r[i] = __builtin_amdgcn_rcpf(1.0f + __builtin_amdgcn_exp2f(g[i] * -1.4426950408889634f));
    return r;
}
struct EpiQKV {
    static constexpr bool PERM = true, AFTER_DRAIN = false;
    bf16_t* Q; bf16_t* Kb; bf16_t* V; const float* tab; float qscale;
    __device__ __forceinline__ void operator()(const f32x4 (&acc)[2][2][4][2], const Unit& u, int wr, int wc, int fr_in, int fq_in) const {
        int fr = fr_in, fq = fq_in; asm volatile("" : "+v"(fr), "+v"(fq));
        const int row0 = u.pm * BM + wr * 64 + fr;
        if (u.pn >= 8) {
            const int col0 = (u.pn - 8) * BM + wc * 32 + 8 * fq;
#pragma unroll
            for (int ai = 0; ai < 2; ++ai)
#pragma unroll
                for (int m = 0; m < 4; ++m) { bf16_t* rowp = V + (size_t)(row0 + ai * HALF + m * 16) * 1024 + col0;
#pragma unroll
                    for (int bj = 0; bj < 2; ++bj) *(u32x4*)(rowp + bj * HALF) = pack8(acc[ai][bj][m][0], acc[ai][bj][m][1]); }
        } else {
            bf16_t* dst = (u.pn >> 2) ? Kb : Q; const float sc = (u.pn >> 2) ? 1.0f : qscale;
            const int colbase = 64 * (4 * (u.pn & 3) + wc) + 8 * fq;
#pragma unroll
            for (int ai = 0; ai < 2; ++ai)
#pragma unroll
                for (int m = 0; m < 4; ++m) { const int row = row0 + ai * HALF + m * 16; const float* tp = tab + (size_t)(row & 8191) * 64 + 8 * fq;
                    const f32x4 c0 = *(const f32x4*)(tp), c1 = *(const f32x4*)(tp + 4), s0 = *(const f32x4*)(tp + 32), s1 = *(const f32x4*)(tp + 36);
                    const f32x4 x10 = acc[ai][0][m][0], x11 = acc[ai][0][m][1], x20 = acc[ai][1][m][0], x21 = acc[ai][1][m][1];
                    const f32x4 o10 = (x10 * c0 - x20 * s0) * sc, o11 = (x11 * c1 - x21 * s1) * sc, o20 = (x20 * c0 + x10 * s0) * sc, o21 = (x21 * c1 + x11 * s1) * sc;
                    if (u.pn >> 2) {
                        bf16_t* kp = Kb + ((((size_t)(row >> 13) * 16 + (4 * (u.pn & 3) + wc)) * 128 + ((row & 8191) >> 6)) * 8 + fq) * 512 + (size_t)(row & 63) * 8;
                        *(u32x4*)(kp) = pack8(o10, o11); *(u32x4*)(kp + 2048) = pack8(o20, o21);
                    } else { bf16_t* rowp = dst + (size_t)row * 1024 + colbase;
                        *(u32x4*)(rowp) = pack8(o10, o11); *(u32x4*)(rowp + 32) = pack8(o20, o21); }
                    asm volatile("" ::: "memory"); }
        }
    }
};
struct EpiSwiGLU {
    static constexpr bool PERM = true, AFTER_DRAIN = false;
    bf16_t* H; int ldc;
    __device__ __forceinline__ void operator()(const f32x4 (&acc)[2][2][4][2], const Unit& u, int wr, int wc, int fr_in, int fq_in) const {
        int fr = fr_in, fq = fq_in; asm volatile("" : "+v"(fr), "+v"(fq));
        const int row0 = u.pm * BM + wr * 64 + fr, col0 = u.pn * HALF + wc * 32 + 8 * fq;
#pragma unroll
        for (int ai = 0; ai < 2; ++ai)
#pragma unroll
            for (int m = 0; m < 4; ++m) { bf16_t* rowp = H + (size_t)(row0 + ai * HALF + m * 16) * ldc + col0;
                const f32x4 g0 = acc[ai][0][m][0], g1 = acc[ai][0][m][1];
                const f32x4 h0 = g0 * sigm4(g0) * acc[ai][1][m][0], h1 = g1 * sigm4(g1) * acc[ai][1][m][1];
                *(u32x4*)(rowp) = pack8(h0, h1); __builtin_amdgcn_sched_barrier(0); }
    }
};
struct EpiGLU {
    static constexpr bool PERM = true, AFTER_DRAIN = false;
    bf16_t* G; const float* bias;
    __device__ __forceinline__ void operator()(const f32x4 (&acc)[2][2][4][2], const Unit& u, int wr, int wc, int fr_in, int fq_in) const {
        int fr = fr_in, fq = fq_in; asm volatile("" : "+v"(fr), "+v"(fq));
        const int row0 = u.pm * BM + wr * 64 + fr, col0 = u.pn * HALF + wc * 32 + 8 * fq;
#pragma unroll
        for (int ai = 0; ai < 2; ++ai)
#pragma unroll
            for (int m = 0; m < 4; ++m) { bf16_t* rowp = G + (size_t)(row0 + ai * HALF + m * 16) * 1024 + col0;
                const f32x4 ba0 = *(const f32x4*)(bias + col0), ba1 = *(const f32x4*)(bias + col0 + 4), bg0 = *(const f32x4*)(bias + 1024 + col0), bg1 = *(const f32x4*)(bias + 1024 + col0 + 4);
                const f32x4 h0 = (acc[ai][0][m][0] + ba0) * sigm4(acc[ai][1][m][0] + bg0), h1 = (acc[ai][0][m][1] + ba1) * sigm4(acc[ai][1][m][1] + bg1);
                *(u32x4*)(rowp) = pack8(h0, h1); asm volatile("" ::: "memory"); __builtin_amdgcn_sched_barrier(0); }
    }
};
template <int MODE> struct EpiResid {
    static constexpr bool PERM = false, AFTER_DRAIN = false;
    const float* xin; float* out; const float* st; const float* g; const float* b; const float* bias; float alpha;
    __device__ __forceinline__ void operator()(const f32x4 (&acc)[2][2][4][2], const Unit& u, int wr, int wc, int fr_in, int fq_in) const {
        int fr = fr_in, fq = fq_in; asm volatile("" : "+v"(fr), "+v"(fq));
        const int col0 = u.pn * BM + wc * 32 + 4 * fq;
#pragma unroll
        for (int bj = 0; bj < 2; ++bj)
#pragma unroll
            for (int n = 0; n < 2; ++n) { const int c = col0 + bj * HALF + n * 16;
                const f32x4 cv = bias ? *(const f32x4*)(bias + c) : (f32x4){0.f, 0.f, 0.f, 0.f};
                f32x4 gv = cv, bv = cv; if (MODE == 1) { gv = *(const f32x4*)(g + c); bv = *(const f32x4*)(b + c); }
#pragma unroll
                for (int ai = 0; ai < 2; ++ai)
#pragma unroll
                    for (int m = 0; m < 4; ++m) { const int row = u.pm * BM + ai * HALF + wr * 64 + m * 16 + fr; const size_t off = (size_t)row * 1024 + c;
                        f32x4 xv = *(const f32x4*)(xin + off);
                        if (MODE == 1) { const float mean = st[2 * row], rstd = st[2 * row + 1]; xv = (xv - mean) * rstd * gv + bv; }
                        *(f32x4*)(out + off) = xv * alpha + acc[ai][bj][m][n] + cv;
                        if (m & 1) asm volatile("" ::: "memory"); }
            }
    }
};

template <class Epi, class Sched, bool ALIGN_EPI = false, bool SP2 = false>
__device__ __forceinline__ void gemm_phase(PG8_LAS unsigned char* lds, const Gemm g, const Sched& S, const Epi& E) {
    int tid_l = threadIdx.x; asm volatile("" : "+v"(tid_l));
    const int tid = tid_l, wid = __builtin_amdgcn_readfirstlane(tid >> 6), lane = tid & 63, wr = wid >> 2, wc = wid & 3, fr = lane & 15, fq = lane >> 4;
    const int K = g.K, nt = K / BK;
    unsigned voffA[2], voffB[2];
#pragma unroll
    for (int i = 0; i < 2; ++i) { int R, C; stage_rc(tid * 16 + i * 8192, R, C); const int Rb = Epi::PERM ? ((R & ~31) + perm32(R & 31)) : R;
        voffA[i] = (unsigned)(R * K + C) * 2u; voffB[i] = (unsigned)(Rb * K + C) * 2u; }
    const size_t kstep = (size_t)(BK * 2);
    const size_t hstep = (size_t)HALF * K * 2;
    const size_t tstep = 2 * hstep;
    const unsigned ldsbase_ = (unsigned)(uintptr_t)lds;
    const unsigned ldsw = (unsigned)wid * 1024u;
    const int aoff = lds_byte(wr * 64 + fr, fq * 8), boff = lds_byte(wc * 32 + fr, fq * 8);
#define PG8_SA(b, h) (((b) * 2 + (h)) * HTB)
#define PG8_SB(b, h) ((4 + (b) * 2 + (h)) * HTB)
#define PG8_STAGE(bufoff, gbase, voff) do { _Pragma("unroll") for (int _i = 0; _i < 2; ++_i) \
        glds_s((const void*)(gbase), (voff)[_i], ldsbase_ + (unsigned)(bufoff) + ldsw + (unsigned)_i * 8192u); } while (0)
#define PG8_LDA(dst, b, h) do { _Pragma("unroll") for (int m = 0; m < 4; ++m) _Pragma("unroll") for (int k = 0; k < 2; ++k) dst[m][k] = *(const PG8_LAS bf16x8*)(lds + PG8_SA(b, h) + aoff + m * 2048 + k * 1024); } while (0)
#define PG8_LDB(dst, b, h) do { _Pragma("unroll") for (int n = 0; n < 2; ++n) _Pragma("unroll") for (int k = 0; k < 2; ++k) dst[n][k] = *(const PG8_LAS bf16x8*)(lds + PG8_SB(b, h) + boff + n * 2048 + k * 1024); } while (0)
#define PG8_MMA(ai, bj, At, Bt) do { __builtin_amdgcn_s_setprio(1); _Pragma("unroll") for (int m = 0; m < 4; ++m) _Pragma("unroll") for (int n = 0; n < 2; ++n) _Pragma("unroll") for (int k = 0; k < 2; ++k) \
        acc[ai][bj][m][n] = __builtin_amdgcn_mfma_f32_16x16x32_bf16(Bt[n][k], At[m][k], acc[ai][bj][m][n], 0, 0, 0); __builtin_amdgcn_s_setprio(0); } while (0)
#define PG8_WAIT_V(n) asm volatile("s_waitcnt vmcnt(" #n ")" ::: "memory")
#define PG8_WAIT_L(n) asm volatile("s_waitcnt lgkmcnt(" #n ")" ::: "memory")
#define PG8_BAR __builtin_amdgcn_s_barrier()
#define PG8_SCHED __builtin_amdgcn_sched_barrier(0)
    Unit cur, nxt; int ui = 0;
    if (!S.next(0, cur)) return;
    f32x4 acc[2][2][4][2];
#pragma unroll
    for (int a = 0; a < 2; ++a)
#pragma unroll
        for (int b = 0; b < 2; ++b)
#pragma unroll
            for (int m = 0; m < 4; ++m)
#pragma unroll
                for (int n = 0; n < 2; ++n) acc[a][b][m][n] = (f32x4){0.f, 0.f, 0.f, 0.f};
    bf16x8 At[4][2], B0[2][2], B1[2][2];
    const char* cA = (const char*)g.A + (size_t)cur.pm * tstep; const char* cB = (const char*)g.Bt + (size_t)cur.pn * tstep;
    S.a_ready(cur);
    if constexpr (SP2) {
        PG8_STAGE(PG8_SB(0, 0), cB, voffB); PG8_SCHED; PG8_STAGE(PG8_SB(0, 1), cB + hstep, voffB); PG8_SCHED; PG8_STAGE(PG8_SA(0, 0), cA, voffA); PG8_SCHED; PG8_STAGE(PG8_SA(0, 1), cA + hstep, voffA); PG8_SCHED;
        if (wr == 1) PG8_BAR;
        PG8_WAIT_V(2); PG8_BAR; PG8_SCHED;
        PG8_STAGE(PG8_SB(1, 0), cB + kstep, voffB); PG8_SCHED; PG8_STAGE(PG8_SA(1, 0), cA + kstep, voffA); PG8_SCHED; PG8_STAGE(PG8_SB(1, 1), cB + hstep + kstep, voffB); PG8_SCHED;
        PG8_WAIT_V(6); PG8_BAR; PG8_SCHED;
    } else {
        PG8_STAGE(PG8_SB(0, 0), cB, voffB); PG8_STAGE(PG8_SA(0, 0), cA, voffA); PG8_STAGE(PG8_SB(0, 1), cB + hstep, voffB); PG8_STAGE(PG8_SA(0, 1), cA + hstep, voffA);
        if (wr == 1) PG8_BAR;
        PG8_WAIT_V(4); PG8_BAR;
        PG8_STAGE(PG8_SB(1, 0), cB + kstep, voffB); PG8_STAGE(PG8_SA(1, 0), cA + kstep, voffA); PG8_STAGE(PG8_SB(1, 1), cB + hstep + kstep, voffB);
        PG8_WAIT_V(6); PG8_BAR;
    }
    for (;;) {
        const bool has_next = S.next(ui + 1, nxt);
        const char* nA = has_next ? (const char*)g.A + (size_t)nxt.pm * tstep : cA; const char* nB = has_next ? (const char*)g.Bt + (size_t)nxt.pn * tstep : cB;
        for (int t = 0; t < nt; t += 2) {
            const bool last = (t == nt - 2);
            const char* a1 = cA + (size_t)(t + 1) * kstep;
            const char* a2 = last ? nA : cA + (size_t)(t + 2) * kstep; const char* b2 = last ? nB : cB + (size_t)(t + 2) * kstep;
            const char* a3 = a2 + kstep; const char* b3 = b2 + kstep;
            if (last && has_next) S.a_ready(nxt);
            if constexpr (SP2) {
            PG8_LDB(B0, 0, 0); PG8_LDB(B1, 0, 1); PG8_SCHED; PG8_LDA(At, 0, 0); PG8_STAGE(PG8_SA(1, 1), a1 + hstep, voffA);
            PG8_WAIT_V(8); PG8_WAIT_L(0); PG8_BAR; PG8_MMA(0, 0, At, B0); PG8_MMA(0, 1, At, B1); PG8_BAR; PG8_SCHED;
            PG8_LDA(At, 0, 1); PG8_STAGE(PG8_SB(0, 0), b2, voffB); PG8_STAGE(PG8_SB(0, 1), b2 + hstep, voffB); PG8_STAGE(PG8_SA(0, 0), a2, voffA);
            PG8_WAIT_V(8); PG8_WAIT_L(0); PG8_BAR; PG8_MMA(1, 0, At, B0); PG8_MMA(1, 1, At, B1); PG8_BAR; PG8_SCHED;
            PG8_LDB(B0, 1, 0); PG8_LDB(B1, 1, 1); PG8_SCHED; PG8_LDA(At, 1, 0); PG8_STAGE(PG8_SA(0, 1), a2 + hstep, voffA);
            PG8_WAIT_V(8); PG8_WAIT_L(0); PG8_BAR; PG8_MMA(0, 0, At, B0); PG8_MMA(0, 1, At, B1); PG8_BAR; PG8_SCHED;
            PG8_LDA(At, 1, 1); PG8_STAGE(PG8_SB(1, 0), b3, voffB); PG8_STAGE(PG8_SB(1, 1), b3 + hstep, voffB); PG8_STAGE(PG8_SA(1, 0), a3, voffA);
            PG8_WAIT_V(8); PG8_WAIT_L(0); PG8_BAR; PG8_MMA(1, 0, At, B0); PG8_MMA(1, 1, At, B1); PG8_BAR; PG8_SCHED;
            } else {
            PG8_LDB(B0, 0, 0); PG8_SCHED; PG8_LDA(At, 0, 0); PG8_STAGE(PG8_SA(1, 1), a1 + hstep, voffA);
            PG8_WAIT_L(8); PG8_BAR; PG8_WAIT_L(0); PG8_MMA(0, 0, At, B0); PG8_BAR; PG8_SCHED;
            PG8_LDB(B1, 0, 1); PG8_STAGE(PG8_SB(0, 0), b2, voffB);
            PG8_BAR; PG8_WAIT_L(0); PG8_MMA(0, 1, At, B1); PG8_BAR;
            PG8_LDA(At, 0, 1); PG8_STAGE(PG8_SA(0, 0), a2, voffA);
            PG8_BAR; PG8_WAIT_L(0); PG8_MMA(1, 0, At, B0); PG8_BAR; PG8_SCHED;
            PG8_STAGE(PG8_SB(0, 1), b2 + hstep, voffB);
            PG8_WAIT_V(6); PG8_BAR; PG8_MMA(1, 1, At, B1); PG8_BAR;
            PG8_LDB(B0, 1, 0); PG8_SCHED; PG8_LDA(At, 1, 0); PG8_STAGE(PG8_SA(0, 1), a2 + hstep, voffA);
            PG8_WAIT_L(8); PG8_BAR; PG8_WAIT_L(0); PG8_MMA(0, 0, At, B0); PG8_BAR; PG8_SCHED;
            PG8_LDB(B1, 1, 1); PG8_STAGE(PG8_SB(1, 0), b3, voffB);
            PG8_BAR; PG8_WAIT_L(0); PG8_MMA(0, 1, At, B1); PG8_BAR;
            PG8_LDA(At, 1, 1); PG8_STAGE(PG8_SA(1, 0), a3, voffA);
            PG8_BAR; PG8_WAIT_L(0); PG8_MMA(1, 0, At, B0); PG8_BAR; PG8_SCHED;
            PG8_STAGE(PG8_SB(1, 1), b3 + hstep, voffB);
            PG8_WAIT_V(6); PG8_BAR; PG8_MMA(1, 1, At, B1); PG8_BAR;
            }
        }
        if constexpr (ALIGN_EPI) { if (wr == 0) PG8_BAR; }
        if constexpr (!Epi::AFTER_DRAIN) { E(acc, cur, wr, wc, fr, fq); S.done(cur); }
        if (!has_next) break;
#pragma unroll
        for (int a = 0; a < 2; ++a)
#pragma unroll
            for (int b = 0; b < 2; ++b)
#pragma unroll
                for (int m = 0; m < 4; ++m)
#pragma unroll
                    for (int n = 0; n < 2; ++n) acc[a][b][m][n] = (f32x4){0.f, 0.f, 0.f, 0.f};
        cur = nxt; cA = nA; cB = nB; ++ui;
        if constexpr (ALIGN_EPI) { if (wr == 1) PG8_BAR; }
    }
    PG8_WAIT_V(0);
    if constexpr (!ALIGN_EPI) { if (wr == 0) PG8_BAR; }
    PG8_BAR;
    if constexpr (Epi::AFTER_DRAIN) { E.fused(acc, cur, wr, wc, fr, fq, lds, wid, lane); S.done(cur); }
#undef PG8_SA
#undef PG8_SB
#undef PG8_STAGE
#undef PG8_LDA
#undef PG8_LDB
#undef PG8_MMA
#undef PG8_WAIT_V
#undef PG8_WAIT_L
#undef PG8_BAR
#undef PG8_SCHED
}
}

namespace att {
#define ALAS __attribute__((address_space(3)))
typedef unsigned short bf16_t;
typedef short bf16x8 __attribute__((ext_vector_type(8)));
typedef short s16x4 __attribute__((ext_vector_type(4)));
typedef short v4i16_t __attribute__((ext_vector_type(4)));
typedef float f32x16 __attribute__((ext_vector_type(16)));
typedef float f32x4 __attribute__((ext_vector_type(4)));
typedef unsigned u32x4 __attribute__((ext_vector_type(4)));
constexpr int SEQ = 8192, PITCH = 1024;
constexpr int KBYTES = 8192, VBYTES = 16384, VOFF0 = 3 * KBYTES, WSF_OFF = VOFF0 + 3 * VBYTES, STG_OFF = WSF_OFF + 8 * 64 * 4, LDS_BYTES = STG_OFF + 8 * 8192;
#ifndef ATT_GRP_SHIFT
#define ATT_GRP_SHIFT 2
#endif
__device__ __forceinline__ int crow(int r, int hi) { return (r & 3) + 8 * (r >> 2) + 4 * hi; }
__device__ __forceinline__ unsigned f2bf(float f) { unsigned u = __builtin_bit_cast(unsigned, f); return (u + 0x7fffu + ((u >> 16) & 1u)) >> 16; }
__device__ __forceinline__ s16x4 vtr(const ALAS unsigned char* p) { return __builtin_bit_cast(s16x4, __builtin_amdgcn_ds_read_tr16_b64_v4i16((ALAS v4i16_t*)p)); }
__device__ __forceinline__ float swapsum(float v) { auto rr = __builtin_amdgcn_permlane32_swap(__float_as_uint(v), __float_as_uint(v), false, false); return __uint_as_float(rr[0]) + __uint_as_float(rr[1]); }
__device__ __forceinline__ float swapmax(float v) { auto rr = __builtin_amdgcn_permlane32_swap(__float_as_uint(v), __float_as_uint(v), false, false); return fmaxf(__uint_as_float(rr[0]), __uint_as_float(rr[1])); }
__device__ __forceinline__ float max3f(float a, float b, float c) { float r; asm("v_max3_f32 %0, %1, %2, %3" : "=v"(r) : "v"(a), "v"(b), "v"(c)); return r; }
__device__ __forceinline__ float max2f(float a, float b) { float r; asm("v_max_f32_e32 %0, %1, %2" : "=v"(r) : "v"(a), "v"(b)); return r; }
#define ATT_GLDS(g, l) __builtin_amdgcn_global_load_lds((const unsigned*)(g), (ALAS unsigned*)(l), 16, 0, 0)
#define ATT_LWAIT() asm volatile("s_waitcnt lgkmcnt(0)" ::: "memory")

__device__ __forceinline__ void attn_unit(int b, int h, int qb, const bf16_t* Q, const bf16_t* K, const bf16_t* V, bf16_t* O, float* scr, ALAS unsigned char* shm, float lam, float outscale, const float* subg) {
    int tid_l = threadIdx.x; asm volatile("" : "+v"(tid_l));
    const int tid = tid_l, lane = tid & 63, r32 = lane & 31, hi = lane >> 5; const int wid = __builtin_amdgcn_readfirstlane(tid >> 6);
    const size_t rowbase = (size_t)b * SEQ; const int q0 = qb * 256;
    const int NT = 4 * qb + 4, cw = 4 * qb + (wid >> 1);
    const unsigned shm0 = (unsigned)(uintptr_t)shm;
    ALAS float* wsf = (ALAS float*)(shm + WSF_OFF) + wid * 64;
    float* myscr = scr + ((((rowbase + q0) >> 5) + wid) * 8 + h) * 4096;
    f32x16 o[4];
    for (int m = 0; m < 2; ++m) {
        const bf16_t* Qw = Q + (rowbase + q0 + wid * 32) * PITCH + h * 128 + m * 64;
        const bf16_t* ksrc = K + ((size_t)((b * 16 + h * 2 + m) * 128)) * 4096 + wid * 512;
        const bf16_t* vsrc = V + (rowbase + 16 * (wid & 3)) * PITCH + h * 128 + (wid >> 2) * 32;
        const unsigned koff = (unsigned)lane * 16u, voff = (unsigned)(lane >> 2) * (PITCH * 2) + (unsigned)(lane & 3) * 16u;
        bf16x8 qr[4];
        unsigned qoff = (unsigned)r32 * (PITCH * 2) + (unsigned)hi * 16u; asm volatile("" : "+v"(qoff));
#pragma unroll
        for (int d0 = 0; d0 < 4; ++d0) qr[d0] = *(const bf16x8*)((const char*)Qw + (qoff + (unsigned)d0 * 32u));
        float mhat = 0.f, l = 0.f; f32x16 negm;
#pragma unroll
        for (int r = 0; r < 16; ++r) negm[r] = 0.f;
#pragma unroll
        for (int d0 = 0; d0 < 4; ++d0)
#pragma unroll
            for (int r = 0; r < 16; ++r) o[d0][r] = 0.f;
        bf16x8 pw[4];
#pragma unroll
        for (int ks = 0; ks < 4; ++ks) pw[ks] = (bf16x8){0, 0, 0, 0, 0, 0, 0, 0};
#define ATT_DMA(t, koffs, voffs) do { const size_t go_ = (size_t)(t) * 64 * PITCH; pg8::glds_s(ksrc + go_, koff, shm0 + (unsigned)(koffs) + (unsigned)wid * 1024u); \
            pg8::glds_s(vsrc + go_, voff, shm0 + (unsigned)(voffs) + (unsigned)wid * 1024u); pg8::glds_s(vsrc + go_ + 64, voff, shm0 + (unsigned)(voffs) + (unsigned)(wid + 8) * 1024u); } while (0)
#define ATT_QK(P0, P1, koffs) do { \
            const ALAS unsigned char* kb = shm + (koffs) + hi * 1024 + r32 * 16; \
            bf16x8 kf[8]; \
            _Pragma("unroll") for (int d0 = 0; d0 < 4; ++d0) { kf[2 * d0] = *(const ALAS bf16x8*)(kb + d0 * 2048); kf[2 * d0 + 1] = *(const ALAS bf16x8*)(kb + d0 * 2048 + 512); } \
            P0 = __builtin_amdgcn_mfma_f32_32x32x16_bf16(kf[0], qr[0], negm, 0, 0, 0); P1 = __builtin_amdgcn_mfma_f32_32x32x16_bf16(kf[1], qr[0], negm, 0, 0, 0); \
            _Pragma("unroll") for (int d0 = 1; d0 < 4; ++d0) { P0 = __builtin_amdgcn_mfma_f32_32x32x16_bf16(kf[2 * d0], qr[d0], P0, 0, 0, 0); P1 = __builtin_amdgcn_mfma_f32_32x32x16_bf16(kf[2 * d0 + 1], qr[d0], P1, 0, 0, 0); } \
        } while (0)
#define ATT_FIN(P0, P1) do { \
            float sacc = 0.f; \
            _Pragma("unroll") for (int r = 0; r < 16; ++r) { P1[r] = __builtin_amdgcn_exp2f(P1[r]); sacc += P0[r] + P1[r]; } \
            l += sacc; \
            _Pragma("unroll") for (int ks = 0; ks < 4; ++ks) { u32x4 w; \
                _Pragma("unroll") for (int i = 0; i < 4; ++i) { const int r = 8 * (ks & 1) + 2 * i; const float a = (ks < 2) ? P0[r] : P1[r], c = (ks < 2) ? P0[r + 1] : P1[r + 1]; w[i] = pg8::cvt_pk_bf16(a, c); } \
                pw[ks] = __builtin_bit_cast(bf16x8, w); } \
        } while (0)
#define ATT_PART(P0, P1, j_) do { \
            float rma = max3f(P0[0], P0[1], P1[0]), rmb = max3f(P0[2], P0[3], P1[1]); rma = max3f(rma, P1[2], P1[3]); \
            _Pragma("unroll") for (int r = 4; r < 16; r += 4) { rma = max3f(rma, P0[r], P0[r + 1]); rmb = max3f(rmb, P0[r + 2], P0[r + 3]); rma = max3f(rma, P1[r], P1[r + 1]); rmb = max3f(rmb, P1[r + 2], P1[r + 3]); } \
            float rm = swapmax(max2f(rma, rmb)); \
            const bool first_ = ((j_) == 0); \
            if (first_ || __any(rm > 8.0f)) { \
                const float dl = first_ ? rm : fmaxf(rm, 0.f), f = first_ ? 1.0f : __builtin_amdgcn_exp2f(-dl); mhat += dl; l *= f; \
                _Pragma("unroll") for (int r = 0; r < 16; ++r) { P0[r] -= dl; P1[r] -= dl; negm[r] = -mhat; } \
                ATT_LWAIT(); \
                if (hi == 0) wsf[r32] = f; \
                ATT_LWAIT(); \
                _Pragma("unroll") for (int r = 0; r < 16; ++r) { const float fr_ = wsf[crow(r, hi)]; \
                    _Pragma("unroll") for (int d0 = 0; d0 < 4; ++d0) o[d0][r] *= fr_; } \
                ATT_LWAIT(); \
            } \
            _Pragma("unroll") for (int r = 0; r < 16; ++r) P0[r] = __builtin_amdgcn_exp2f(P0[r]); \
        } while (0)
#define ATT_PV(voffs) do { \
            const ALAS unsigned char* vp = shm + (voffs) + ((lane >> 4) & 1) * 32 + (lane & 3) * 8 + (4 * hi + ((lane & 15) >> 2)) * 64; \
            _Pragma("unroll") for (int ks = 0; ks < 4; ++ks) \
                _Pragma("unroll") for (int d0 = 0; d0 < 4; ++d0) { \
                    const s16x4 lo = vtr(vp + d0 * 4096 + ks * 1024), hh = vtr(vp + d0 * 4096 + ks * 1024 + 512); \
                    const bf16x8 vf = (bf16x8){lo[0], lo[1], lo[2], lo[3], hh[0], hh[1], hh[2], hh[3]}; \
                    o[d0] = __builtin_amdgcn_mfma_f32_32x32x16_bf16(pw[ks], vf, o[d0], 0, 0, 0); } \
        } while (0)
#define ATT_STEP(PC0, PC1, PP0, PP1, j_) do { const int jj = (j_); \
            if (jj + 1 < NT) asm volatile("s_waitcnt vmcnt(3)" ::: "memory"); else if (jj + 1 == NT) asm volatile("s_waitcnt vmcnt(2)" ::: "memory"); else asm volatile("s_waitcnt vmcnt(0)" ::: "memory"); \
            __syncthreads(); \
            if (jj + 2 < NT) { const size_t go_ = (size_t)(jj + 2) * 4096; pg8::glds_s(ksrc + go_, koff, shm0 + (unsigned)(s2 * KBYTES) + (unsigned)wid * 1024u); } \
            if (jj + 1 < NT) { const size_t go_ = (size_t)(jj + 1) * 64 * PITCH; const unsigned vd_ = shm0 + (unsigned)(VOFF0 + s1 * VBYTES); \
                pg8::glds_s(vsrc + go_, voff, vd_ + (unsigned)wid * 1024u); pg8::glds_s(vsrc + go_ + 64, voff, vd_ + (unsigned)(wid + 8) * 1024u); } \
            if (jj <= cw) ATT_QK(PC0, PC1, s0 * KBYTES); \
            if (jj >= 1 && jj - 1 <= cw) { ATT_FIN(PP0, PP1); ATT_PV(VOFF0 + s2 * VBYTES); } \
            if (jj <= cw) ATT_PART(PC0, PC1, jj); \
            { const int t_ = s0; s0 = s1; s1 = s2; s2 = t_; } \
        } while (0)
        {
            asm volatile("s_waitcnt vmcnt(0)" ::: "memory");
            pg8::glds_s(ksrc, koff, shm0 + (unsigned)wid * 1024u);
            pg8::glds_s(ksrc + (size_t)4096, koff, shm0 + (unsigned)KBYTES + (unsigned)wid * 1024u);
            pg8::glds_s(vsrc, voff, shm0 + (unsigned)VOFF0 + (unsigned)wid * 1024u); pg8::glds_s(vsrc + 64, voff, shm0 + (unsigned)VOFF0 + (unsigned)(wid + 8) * 1024u);
        }
        int s0 = 0, s1 = 1, s2 = 2;
        f32x16 pA0, pA1, pB0, pB1;
#pragma unroll
        for (int r = 0; r < 16; ++r) { pA0[r] = 0.f; pA1[r] = 0.f; pB0[r] = 0.f; pB1[r] = 0.f; }
        for (int j = 0; j <= NT; j += 2) {
            ATT_STEP(pA0, pA1, pB0, pB1, j);
            if (j + 1 <= NT) ATT_STEP(pB0, pB1, pA0, pA1, j + 1);
        }
        __syncthreads();
#undef ATT_QK
#undef ATT_FIN
#undef ATT_PART
#undef ATT_PV
#undef ATT_STEP
#undef ATT_DMA
        const float lt = swapsum(l);
        ATT_LWAIT();
        if (hi == 0) wsf[32 + r32] = 1.0f / lt;
        ATT_LWAIT();
        float rli[16];
#pragma unroll
        for (int r = 0; r < 16; ++r) rli[r] = wsf[32 + crow(r, hi)];
        ATT_LWAIT();
        int lane2 = lane; asm volatile("" : "+v"(lane2));
        float* sp = (float*)((char*)myscr + (unsigned)lane2 * 16u);
        if (m == 0) {
#pragma unroll
            for (int d0 = 0; d0 < 4; ++d0) {
#pragma unroll
                for (int r4 = 0; r4 < 4; ++r4) { f32x4 v;
#pragma unroll
                    for (int i = 0; i < 4; ++i) v[i] = o[d0][4 * r4 + i] * rli[4 * r4 + i];
                    *(f32x4*)(sp + (d0 * 4 + r4) * 256) = v; }
                asm volatile("" ::: "memory"); }
        } else {
            float ss[16];
#pragma unroll
            for (int r = 0; r < 16; ++r) ss[r] = 0.f;
#pragma unroll
            for (int d0 = 0; d0 < 4; ++d0) {
#pragma unroll
                for (int r4 = 0; r4 < 4; ++r4) { const f32x4 v0 = *(const f32x4*)(sp + (d0 * 4 + r4) * 256);
#pragma unroll
                    for (int i = 0; i < 4; ++i) { const int r = 4 * r4 + i; const float v = v0[i] - lam * (o[d0][r] * rli[r]); o[d0][r] = v; ss[r] += v * v; } }
                asm volatile("" ::: "memory"); }
#pragma unroll
            for (int r = 0; r < 16; ++r) {
#pragma unroll
                for (int k = 1; k < 32; k <<= 1) ss[r] += __shfl_xor(ss[r], k);
                ss[r] = __builtin_amdgcn_rsqf(ss[r] * (1.0f / 128.0f) + 1e-5f) * outscale;
            }
            ALAS unsigned char* stw = shm + STG_OFF + wid * 8192;
            ALAS unsigned short* stg = (ALAS unsigned short*)stw + (4 * hi) * 128 + r32;
#pragma unroll
            for (int d0 = 0; d0 < 4; ++d0) { const float gg = subg[32 * d0 + (lane2 & 31)];
#pragma unroll
                for (int r = 0; r < 16; ++r) stg[((r & 3) + 8 * (r >> 2)) * 128 + 32 * d0] = (unsigned short)f2bf(o[d0][r] * ss[r] * gg); }
            ATT_LWAIT();
            bf16_t* Ow = (bf16_t*)((char*)(O + (rowbase + q0 + wid * 32) * PITCH + h * 128) + ((unsigned)(lane2 >> 4) * (PITCH * 2) + (unsigned)(lane2 & 15) * 16u));
#pragma unroll
            for (int i = 0; i < 8; ++i) { const u32x4 v = *(const ALAS u32x4*)(stw + i * 1024 + lane2 * 16); *(u32x4*)(Ow + (size_t)i * 4 * PITCH) = v; }
            ATT_LWAIT();
        }
    }
}
}

#ifndef PHMASK
#define PHMASK 0xFFFF
#endif
constexpr int NWAVES = 8;
constexpr int M = 32768, D = 1024, FF = 2816, SEQ = 8192;
constexpr float LN_EPS = 1e-5f;
constexpr float ALPHA = 1.4142135623730951f;
constexpr size_t MiB = 1u << 20;
constexpr size_t WS_BAR = 0;
constexpr size_t WS_ST = 1 * MiB;
constexpr size_t WS_TAB = 2 * MiB;
constexpr size_t WS_WQKV = 4 * MiB, WS_WO = 10 * MiB, WS_PW1 = 12 * MiB, WS_PW2 = 16 * MiB, WS_GU0 = 18 * MiB, WS_GU1 = 29 * MiB, WS_DN0 = 40 * MiB, WS_DN1 = 46 * MiB;
constexpr size_t WS_PAR = 52 * MiB;
constexpr int PO_LQ1 = 0, PO_LK1 = 64, PO_LQ2 = 128, PO_LK2 = 192, PO_SUBG = 256, PO_BPW1 = 384, PO_WDW = 2432, PO_BDW = 34176, PO_CLNG = 35200, PO_CLNB = 36224, PO_BPW2 = 37248, PO_LNG = 38272, PO_LNB = 42368, PO_END = 46464;
constexpr size_t WS_XN = 64 * MiB;
constexpr size_t WS_Q = 128 * MiB, WS_K = 192 * MiB, WS_V = 256 * MiB;
constexpr size_t WS_H = 128 * MiB;
constexpr size_t WS_G = 128 * MiB, WS_C = 192 * MiB;
constexpr size_t WS_Z = 320 * MiB;
constexpr size_t WS_END = 448 * MiB;
constexpr int LDS_BYTES = 147456;

#define LAS __attribute__((address_space(3)))
typedef unsigned short bf16;
typedef unsigned v4u __attribute__((ext_vector_type(4)));
typedef unsigned v2u __attribute__((ext_vector_type(2)));
typedef float f32x4 __attribute__((ext_vector_type(4)));
#define LDS_WAIT() asm volatile("s_waitcnt lgkmcnt(0)" ::: "memory")
__device__ __forceinline__ unsigned f2bf(float f) { unsigned u = __builtin_bit_cast(unsigned, f); return (u + 0x7fffu + ((u >> 16) & 1u)) >> 16; }
__device__ __forceinline__ unsigned pk2(float lo, float hi) { return f2bf(lo) | (f2bf(hi) << 16); }
__device__ __forceinline__ float wave_sum(float v) {
#pragma unroll
    for (int o = 1; o < 64; o <<= 1) v += __shfl_xor(v, o);
    return v;
}
__device__ __forceinline__ int map_row(int mode, int n) {
    if (mode == 1) {
        if (n >= 2048) return n;
        const int region = n >> 10, within = n & 1023, slice = within >> 6, d = within & 63;
        return 256 * (region * 4 + (slice >> 2)) + 128 * (d >> 5) + 32 * (slice & 3) + (d & 31);
    }
    if (mode == 2) { const int half = n >> 10, j = n & 1023; return 256 * (j >> 7) + 128 * half + (j & 127); }
    if (mode == 3) return 256 * (n >> 7) + (n & 127);
    if (mode == 4) return 256 * (n >> 7) + 128 + (n & 127);
    return n;
}
__device__ __forceinline__ void transpose_item(const float* W, int K, int N, bf16* WT, int mode, LAS float* scr, int item, int lane) {
    const int nblk = N / 64, kb = item / nblk, nb = item % nblk, k0 = 64 * kb, n0 = 64 * nb;
    const float* src = W + (size_t)(k0 + (lane >> 4)) * N + n0 + 4 * (lane & 15);
    f32x4 v[16];
#pragma unroll
    for (int i = 0; i < 16; ++i) v[i] = *(const f32x4*)(src + (size_t)(4 * i) * N);
    LAS float* sw = scr + (lane >> 4) * 65 + 4 * (lane & 15);
#pragma unroll
    for (int i = 0; i < 16; ++i) { sw[(4 * i) * 65 + 0] = v[i].x; sw[(4 * i) * 65 + 1] = v[i].y; sw[(4 * i) * 65 + 2] = v[i].z; sw[(4 * i) * 65 + 3] = v[i].w; }
    LDS_WAIT(); asm volatile("" ::: "memory");
    const int c = lane & 7;
#pragma unroll
    for (int j = 0; j < 8; ++j) { const int n = (lane >> 3) + 8 * j; const LAS float* s = scr + (8 * c) * 65 + n;
        v4u o; o.x = pk2(s[0 * 65], s[1 * 65]); o.y = pk2(s[2 * 65], s[3 * 65]); o.z = pk2(s[4 * 65], s[5 * 65]); o.w = pk2(s[6 * 65], s[7 * 65]);
        *(v4u*)(WT + (size_t)map_row(mode, n0 + n) * K + k0 + 8 * c) = o; }
    LDS_WAIT(); asm volatile("" ::: "memory");
}

#define XB_TMO      128
#define XB_XCNT(j)  (256  + 64 * (j))
#define XB_XSUB(j)  (1280 + 64 * (j))
#define XB_XGEN(j)  (2304 + 64 * (j))
#define XB_TOP      3328
#define XB_TOPGEN   3392
#define XCD_BAR_WORDS 3456
#define XB_SPIN_CAP (1u << 18)

__device__ __forceinline__ unsigned xb_ld(unsigned* p)              { return __hip_atomic_load(p, __ATOMIC_RELAXED, __HIP_MEMORY_SCOPE_AGENT); }
__device__ __forceinline__ unsigned xb_add(unsigned* p, unsigned v) { return __hip_atomic_fetch_add(p, v, __ATOMIC_RELAXED, __HIP_MEMORY_SCOPE_AGENT); }
__device__ __forceinline__ unsigned xb_xcc_id() { return (unsigned)__builtin_amdgcn_s_getreg((3 << 11) | 20) & 0xFu; }
#define XB_SPIN(cond, bar) do { unsigned _sp = 0; while (cond) { __builtin_amdgcn_s_sleep(1); \
    if ((++_sp & 255u) == 0u) { if (xb_ld(&(bar)[XB_TMO])) break; if (_sp > XB_SPIN_CAP) { atomicAdd(&(bar)[XB_TMO], 1u); break; } } } } while (0)

struct XcdBarrier {
    unsigned* bar; unsigned x;
    volatile LAS unsigned* st;
};

__device__ __forceinline__ XcdBarrier xcd_barrier_post(unsigned* bar, volatile LAS unsigned* st) {
    XcdBarrier b; b.bar = bar; b.x = xb_xcc_id(); b.st = st;
    if (threadIdx.x == 0) (void)xb_add(&bar[XB_XCNT(b.x)], 1u);
    return b;
}
__device__ __forceinline__ void xcd_barrier_complete(unsigned* bar, unsigned x, unsigned& nloc, unsigned& nx) {
    const unsigned G = gridDim.x * gridDim.y * gridDim.z;
    unsigned sum, cnt, mine, sp = 0u;
    for (;;) {
        sum = 0u; cnt = 0u; mine = 0u;
#pragma unroll
        for (unsigned j = 0; j < 16; ++j) { const unsigned c = xb_ld(&bar[XB_XCNT(j)]); sum += c; cnt += (c > 0u) ? 1u : 0u; mine = (j == x) ? c : mine; }
        if (sum == G) break;
        __builtin_amdgcn_s_sleep(1);
        if ((++sp & 255u) == 0u) { if (xb_ld(&bar[XB_TMO])) break; if (sp > XB_SPIN_CAP) { atomicAdd(&bar[XB_TMO], 1u); break; } }
    }
    nloc = mine > 0u ? mine : 1u; nx = cnt > 0u ? cnt : 1u;
}

__device__ __forceinline__ void xcd_barrier(const XcdBarrier& b) {
    asm volatile("s_waitcnt vmcnt(0)" ::: "memory");
    __syncthreads();
    if (threadIdx.x == 0) {
        unsigned* bar = b.bar;
        __builtin_amdgcn_s_waitcnt(0);
        unsigned nloc = b.st[0], nx = b.st[1];
        if (nloc == 0u) { xcd_barrier_complete(bar, b.x, nloc, nx); b.st[0] = nloc; b.st[1] = nx; }
        const unsigned old = xb_add(&bar[XB_XSUB(b.x)], 1u);
        const unsigned gen = old / nloc;
        if (old + 1u == (gen + 1u) * nloc) {
            __builtin_amdgcn_fence(__ATOMIC_RELEASE, "agent");
            asm volatile("s_waitcnt vmcnt(0)" ::: "memory");
            const unsigned og = xb_add(&bar[XB_TOP], 1u);
            const unsigned tg = og / nx;
            if (og + 1u == (tg + 1u) * nx) xb_add(&bar[XB_TOPGEN], 1u);
            else XB_SPIN(xb_ld(&bar[XB_TOPGEN]) == tg, bar);
            __builtin_amdgcn_fence(__ATOMIC_ACQUIRE, "agent");
            xb_add(&bar[XB_XGEN(b.x)], 1u);
            asm volatile("s_waitcnt vmcnt(0)" ::: "memory");
        } else {
            XB_SPIN(xb_ld(&bar[XB_XGEN(b.x)]) == gen, bar);
            __builtin_amdgcn_fence(__ATOMIC_ACQUIRE, "agent");
            asm volatile("s_waitcnt vmcnt(0)" ::: "memory");
        }
    }
    __syncthreads();
}

struct Args { const float* in[21]; float* out; unsigned char* ws; };

__device__ __forceinline__ void ln_phase(const float* Z, bf16* XN, float* ST, const float* g, const float* b, float* OUT, int gw, int NGW, int lane) {
    asm volatile("" : "+v"(lane));
    f32x4 gv[4], bv[4];
#pragma unroll
    for (int j = 0; j < 4; ++j) { gv[j] = *((const f32x4*)g + lane + 64 * j); bv[j] = *((const f32x4*)b + lane + 64 * j); }
    for (int row0 = gw; row0 < M; row0 += 2 * NGW) {
        f32x4 v[2][4]; float mean[2], rstd[2];
#pragma unroll
        for (int q = 0; q < 2; ++q) { const f32x4* zr = (const f32x4*)(Z + (size_t)(row0 + q * NGW) * D) + lane;
#pragma unroll
            for (int j = 0; j < 4; ++j) v[q][j] = zr[64 * j]; }
#pragma unroll
        for (int q = 0; q < 2; ++q) { float s = 0.f;
#pragma unroll
            for (int j = 0; j < 4; ++j) s += (v[q][j].x + v[q][j].y) + (v[q][j].z + v[q][j].w);
            mean[q] = wave_sum(s) * (1.f / D); float s2 = 0.f;
#pragma unroll
            for (int j = 0; j < 4; ++j) { v[q][j] = v[q][j] - mean[q]; s2 += (v[q][j].x * v[q][j].x + v[q][j].y * v[q][j].y) + (v[q][j].z * v[q][j].z + v[q][j].w * v[q][j].w); }
            rstd[q] = 1.f / sqrtf(wave_sum(s2) * (1.f / D) + LN_EPS); }
#pragma unroll
        for (int q = 0; q < 2; ++q) { const int row = row0 + q * NGW;
            if (OUT) {
                f32x4* orow = (f32x4*)(OUT + (size_t)row * D) + lane;
#pragma unroll
                for (int j = 0; j < 4; ++j) orow[64 * j] = v[q][j] * rstd[q] * gv[j] + bv[j];
            } else {
                if (lane == 0) { ST[2 * row] = mean[q]; ST[2 * row + 1] = rstd[q]; }
                v2u* o8 = (v2u*)(XN + (size_t)row * D) + lane;
#pragma unroll
                for (int j = 0; j < 4; ++j) { const f32x4 y = v[q][j] * rstd[q] * gv[j] + bv[j]; v2u w; w.x = pk2(y.x, y.y); w.y = pk2(y.z, y.w); o8[64 * j] = w; }
            } }
    }
}

__global__ void __launch_bounds__(NWAVES * 64, 2) fwd_kernel(Args args) {
    extern __shared__ __attribute__((aligned(16))) unsigned char lds[];
    cg::grid_group grid = cg::this_grid();
    LAS unsigned char* L = (LAS unsigned char*)lds;
    const int tid = threadIdx.x, lane = tid & 63, wave = __builtin_amdgcn_readfirstlane(tid >> 6);
    const int G = gridDim.x, bx = blockIdx.x;
    const int vcu = (G % 8 == 0) ? (bx % 8) * (G / 8) + bx / 8 : bx;
    const int gw = vcu * NWAVES + wave, NGW = G * NWAVES;
    unsigned char* ws = args.ws;
    const float* x = args.in[0];
    const float *w_qkv = args.in[1], *w_o = args.in[2], *w_pw1 = args.in[8], *w_pw2 = args.in[14], *w_gate = args.in[16], *w_up = args.in[17], *w_down = args.in[18];
    float* PARW = (float*)(ws + WS_PAR); const float* PAR = PARW;
    const float *lq1 = PAR + PO_LQ1, *lk1 = PAR + PO_LK1, *lq2 = PAR + PO_LQ2, *lk2 = PAR + PO_LK2, *subln_g = PAR + PO_SUBG, *b_pw1 = PAR + PO_BPW1, *w_dw = PAR + PO_WDW, *b_dw = PAR + PO_BDW;
    const float *cln_g = PAR + PO_CLNG, *cln_b = PAR + PO_CLNB, *b_pw2 = PAR + PO_BPW2, *ln_g = PAR + PO_LNG, *ln_b = PAR + PO_LNB;
    float* ST = (float*)(ws + WS_ST); float* TAB = (float*)(ws + WS_TAB);
    bf16 *Wqkv_t = (bf16*)(ws + WS_WQKV), *Wo_t = (bf16*)(ws + WS_WO), *Wpw1_t = (bf16*)(ws + WS_PW1), *Wpw2_t = (bf16*)(ws + WS_PW2);
    bf16 *Wgu0 = (bf16*)(ws + WS_GU0), *Wgu1 = (bf16*)(ws + WS_GU1), *Wdn0 = (bf16*)(ws + WS_DN0), *Wdn1 = (bf16*)(ws + WS_DN1);
    bf16 *XN = (bf16*)(ws + WS_XN), *QB = (bf16*)(ws + WS_Q), *KB = (bf16*)(ws + WS_K), *VB = (bf16*)(ws + WS_V), *HB = (bf16*)(ws + WS_H), *GB = (bf16*)(ws + WS_G), *CB = (bf16*)(ws + WS_C);
    float* Z = (float*)(ws + WS_Z);

    volatile LAS unsigned* xbst = (volatile LAS unsigned*)(L + LDS_BYTES - 64);
    if (tid < 2) xbst[tid] = 0u;
    if (bx == 0) for (int u = tid; u < XCD_BAR_WORDS; u += NWAVES * 64) __hip_atomic_store((unsigned*)(ws + WS_BAR) + u, 0u, __ATOMIC_RELAXED, __HIP_MEMORY_SCOPE_AGENT);
    __syncthreads();
    {
        LAS float* scr = (LAS float*)(L + wave * 16640);
        constexpr int I_QKV = 16 * 48, I_O = 16 * 16, I_PW1 = 16 * 32, I_PW2 = 16 * 16, I_GU = 16 * 44, I_DN = 44 * 16;
        constexpr int NITEMS = I_QKV + I_O + I_PW1 + I_PW2 + 4 * I_GU + 2 * I_DN;
        for (int it = gw; it < NITEMS; it += NGW) {
            int r = it;
            if (r < I_QKV) { transpose_item(w_qkv, D, 3 * D, Wqkv_t, 1, scr, r, lane); continue; } r -= I_QKV;
            if (r < I_O) { transpose_item(w_o, D, D, Wo_t, 0, scr, r, lane); continue; } r -= I_O;
            if (r < I_PW1) { transpose_item(w_pw1, D, 2 * D, Wpw1_t, 2, scr, r, lane); continue; } r -= I_PW1;
            if (r < I_PW2) { transpose_item(w_pw2, D, D, Wpw2_t, 0, scr, r, lane); continue; } r -= I_PW2;
            if (r < I_GU) { transpose_item(w_gate, D, FF, Wgu0, 3, scr, r, lane); continue; } r -= I_GU;
            if (r < I_GU) { transpose_item(w_up, D, FF, Wgu0, 4, scr, r, lane); continue; } r -= I_GU;
            if (r < I_GU) { transpose_item(w_gate + (size_t)D * FF, D, FF, Wgu1, 3, scr, r, lane); continue; } r -= I_GU;
            if (r < I_GU) { transpose_item(w_up + (size_t)D * FF, D, FF, Wgu1, 4, scr, r, lane); continue; } r -= I_GU;
            if (r < I_DN) { transpose_item(w_down, FF, D, Wdn0, 0, scr, r, lane); continue; } r -= I_DN;
            transpose_item(w_down + (size_t)FF * D, FF, D, Wdn1, 0, scr, r, lane);
        }
        for (int row = gw; row < M; row += 4 * NGW) {
            f32x4 y[4][4];
#pragma unroll
            for (int q = 0; q < 4; ++q) { const f32x4* xr = (const f32x4*)(x + (size_t)(row + q * NGW) * D) + 2 * lane;
                y[q][0] = xr[0]; y[q][1] = xr[1]; y[q][2] = xr[128]; y[q][3] = xr[129]; }
#pragma unroll
            for (int q = 0; q < 4; ++q) { v4u* o16 = (v4u*)(XN + (size_t)(row + q * NGW) * D) + lane;
                v4u w0, w1; w0.x = pk2(y[q][0].x, y[q][0].y); w0.y = pk2(y[q][0].z, y[q][0].w); w0.z = pk2(y[q][1].x, y[q][1].y); w0.w = pk2(y[q][1].z, y[q][1].w);
                w1.x = pk2(y[q][2].x, y[q][2].y); w1.y = pk2(y[q][2].z, y[q][2].w); w1.z = pk2(y[q][3].x, y[q][3].y); w1.w = pk2(y[q][3].z, y[q][3].w);
                o16[0] = w0; o16[64] = w1; }
        }
        for (int e = bx * (NWAVES * 64) + tid; e < PO_END; e += G * NWAVES * 64) {
            float v;
            if (e < PO_LK1) v = args.in[3][e - PO_LQ1]; else if (e < PO_LQ2) v = args.in[4][e - PO_LK1]; else if (e < PO_LK2) v = args.in[5][e - PO_LQ2]; else if (e < PO_SUBG) v = args.in[6][e - PO_LK2];
            else if (e < PO_BPW1) v = args.in[7][e - PO_SUBG]; else if (e < PO_WDW) v = args.in[9][e - PO_BPW1]; else if (e < PO_BDW) v = args.in[10][e - PO_WDW]; else if (e < PO_CLNG) v = args.in[11][e - PO_BDW];
            else if (e < PO_CLNB) v = args.in[12][e - PO_CLNG]; else if (e < PO_BPW2) v = args.in[13][e - PO_CLNB]; else if (e < PO_LNG) v = args.in[15][e - PO_BPW2]; else if (e < PO_LNB) v = args.in[19][e - PO_LNG];
            else v = args.in[20][e - PO_LNB];
            PARW[e] = v;
        }
        for (int e = bx * (NWAVES * 64) + tid; e < SEQ * 32; e += G * NWAVES * 64) {
            const int pos = e >> 5, i = e & 31, i8 = i & 7, i3 = i >> 3;
            double c = (i8 == 0) ? 1.0 : (i8 == 1) ? 0.7498942093324559 : (i8 == 2) ? 0.5623413251903491 : (i8 == 3) ? 0.4216965034285822 : (i8 == 4) ? 0.31622776601683794 : (i8 == 5) ? 0.23713737056616552 : (i8 == 6) ? 0.1778279410038923 : 0.1333521432163324;
            c *= (i3 == 0) ? 1.0 : (i3 == 1) ? 0.1 : (i3 == 2) ? 0.01 : 0.001;
            const double rev = (double)pos * c * 0.15915494309189535;
            const float fr = (float)(rev - __builtin_floor(rev));
            TAB[pos * 64 + i] = __builtin_amdgcn_cosf(fr); TAB[pos * 64 + 32 + i] = __builtin_amdgcn_sinf(fr);
        }
    }
    grid.sync();
    const XcdBarrier xbar = xcd_barrier_post((unsigned*)(ws + WS_BAR), xbst);

    if (PHMASK & (1 << 1)) {
        pg8::Gemm g{XN, Wqkv_t, M, 3 * D, D}; pg8::StaticOrder S; S.init(M, 3 * D, G, bx);
        pg8::EpiQKV E{QB, KB, VB, TAB, 0.125f * 1.4426950408889634f};
        pg8::gemm_phase<pg8::EpiQKV, pg8::StaticOrder, true, true>(L, g, S, E);
    }
    xcd_barrier(xbar);

    if (PHMASK & (1 << 2)) {
        const float d1 = wave_sum(lq1[lane] * lk1[lane]), d2 = wave_sum(lq2[lane] * lk2[lane]);
        const float lam = __expf(d1) - __expf(d2) + 0.2f;
        for (int idx = vcu; idx < 1024; idx += G) {
            const int v = idx & 255, i = idx >> 8, bh = v >> 3, s = v & 7;
            const int qb = (i == 0) ? 31 - s : (i == 1) ? 16 + s : (i == 2) ? 15 - s : s;
            att::attn_unit(bh >> 3, bh & 7, qb, QB, KB, VB, XN, Z, L, lam, 0.8f, subln_g);
        }
    }
    xcd_barrier(xbar);

    if (PHMASK & (1 << 3)) {
        pg8::Gemm g{XN, Wo_t, M, D, D}; pg8::StaticOrder S; S.init(M, D, G, bx);
        pg8::EpiResid<0> E{x, Z, nullptr, nullptr, nullptr, nullptr, ALPHA};
        pg8::gemm_phase<pg8::EpiResid<0>, pg8::StaticOrder, true, true>(L, g, S, E);
    }
    xcd_barrier(xbar);
    ln_phase(Z, XN, ST, ln_g, ln_b, nullptr, gw, NGW, lane);
    xcd_barrier(xbar);

    for (int layer = 0; layer < 2; ++layer) {
        if (layer == 1) {
            if (PHMASK & (1 << 8)) {
                pg8::Gemm g{XN, Wpw1_t, M, 2 * D, D}; pg8::StaticOrder S; S.init(M, 2 * D, G, bx);
                pg8::EpiGLU E{GB, b_pw1};
                pg8::gemm_phase<pg8::EpiGLU, pg8::StaticOrder, true, true>(L, g, S, E);
            }
            xcd_barrier(xbar);
            if (PHMASK & (1 << 9)) {
                int ctid = threadIdx.x; asm volatile("" : "+v"(ctid));
                const int clane = ctid & 63, cwave = __builtin_amdgcn_readfirstlane(ctid >> 6);
                LAS unsigned* tile = (LAS unsigned*)L;
                LAS float* red = (LAS float*)(L + 126976);
                LAS float* stat = red + 512;
                const unsigned L0 = (unsigned)(uintptr_t)L;
                for (int unit = vcu; unit < M / 32; unit += G) {
                    const int row0 = unit * 32, s0 = row0 & (SEQ - 1);
                    int c2 = ctid; asm volatile("" : "+v"(c2));
                    float w0[31], w1[31];
#pragma unroll
                    for (int t = 0; t < 31; ++t) { const float2 wv = *(const float2*)(w_dw + t * D + 2 * c2); w0[t] = wv.x; w1[t] = wv.y; }
                    const float bd0 = b_dw[2 * c2], bd1 = b_dw[2 * c2 + 1];
                    for (int p = cwave; p < 124; p += NWAVES) { const int rr = p >> 1;
                        if (s0 == 0 && rr < 30) *(LAS v4u*)(L + p * 1024 + clane * 16) = (v4u){0u, 0u, 0u, 0u};
                        else pg8::glds_s(GB + (size_t)(row0 - 30 + rr) * D + (p & 1) * 512, (unsigned)clane * 16u, L0 + (unsigned)p * 1024u); }
                    asm volatile("s_waitcnt vmcnt(0)" ::: "memory");
                    __syncthreads();
                    float y0[32], y1[32];
#pragma unroll
                    for (int r = 0; r < 32; ++r) { y0[r] = bd0; y1[r] = bd1; }
#pragma unroll
                    for (int k = 0; k < 62; ++k) { const unsigned xk = tile[k * 512 + c2]; const float a0 = __uint_as_float(xk << 16), a1 = __uint_as_float(xk & 0xffff0000u);
#pragma unroll
                        for (int r = 0; r < 32; ++r) { const int t = k - r; if (t >= 0 && t <= 30) { y0[r] += w0[t] * a0; y1[r] += w1[t] * a1; } } }
                    float vals[64];
#pragma unroll
                    for (int r = 0; r < 32; ++r) { vals[2 * r] = y0[r] + y1[r]; vals[2 * r + 1] = y0[r] * y0[r] + y1[r] * y1[r]; }
#define CONV_BFLY(MK) do { const bool up = (clane & (MK)) != 0; _Pragma("unroll") for (int k = 0; k < (MK); ++k) { const float a = vals[k], b = vals[k + (MK)]; const float snd = up ? a : b, kp = up ? b : a; vals[k] = kp + __shfl_xor(snd, (MK)); } } while (0)
                    CONV_BFLY(32); CONV_BFLY(16); CONV_BFLY(8); CONV_BFLY(4); CONV_BFLY(2); CONV_BFLY(1);
#undef CONV_BFLY
                    red[cwave * 64 + clane] = vals[0];
                    __syncthreads();
                    if (ctid < 32) { float sm = 0.f, q = 0.f;
#pragma unroll
                        for (int w = 0; w < 8; ++w) { sm += red[w * 64 + 2 * ctid]; q += red[w * 64 + 2 * ctid + 1]; }
                        const float mean = sm * (1.f / D), var = q * (1.f / D) - mean * mean;
                        stat[2 * ctid] = mean; stat[2 * ctid + 1] = 1.f / sqrtf(fmaxf(var, 0.f) + LN_EPS); }
                    __syncthreads();
                    int c3 = ctid; asm volatile("" : "+v"(c3));
                    const float g0 = cln_g[2 * c3], g1 = cln_g[2 * c3 + 1], bb0 = cln_b[2 * c3], bb1 = cln_b[2 * c3 + 1];
                    unsigned* op = (unsigned*)(CB + (size_t)row0 * D) + c3;
#pragma unroll
                    for (int r = 0; r < 32; ++r) {
                        const float mean = stat[2 * r], rstd = stat[2 * r + 1];
                        float n0 = (y0[r] - mean) * rstd * g0 + bb0, n1 = (y1[r] - mean) * rstd * g1 + bb1;
                        n0 = n0 * __builtin_amdgcn_rcpf(1.0f + __builtin_amdgcn_exp2f(n0 * -1.4426950408889634f));
                        n1 = n1 * __builtin_amdgcn_rcpf(1.0f + __builtin_amdgcn_exp2f(n1 * -1.4426950408889634f));
                        op[r * 512] = pk2(n0, n1);
                    }
                }
                __syncthreads();
            }
            xcd_barrier(xbar);
            if (PHMASK & (1 << 10)) {
                pg8::Gemm g{CB, Wpw2_t, M, D, D}; pg8::StaticOrder S; S.init(M, D, G, bx);
                pg8::EpiResid<1> E{Z, Z, ST, ln_g + 1 * D, ln_b + 1 * D, b_pw2, ALPHA};
                pg8::gemm_phase<pg8::EpiResid<1>, pg8::StaticOrder, true, true>(L, g, S, E);
            }
            xcd_barrier(xbar);
            ln_phase(Z, XN, ST, ln_g + 2 * D, ln_b + 2 * D, nullptr, gw, NGW, lane);
            xcd_barrier(xbar);
        }
        if (PHMASK & (1 << 5)) {
            pg8::Gemm g{XN, layer ? Wgu1 : Wgu0, M, 2 * FF, D}; pg8::StaticOrder S; S.init(M, 2 * FF, G, bx);
            pg8::EpiSwiGLU E{HB, FF};
            pg8::gemm_phase<pg8::EpiSwiGLU, pg8::StaticOrder, true, true>(L, g, S, E);
        }
        xcd_barrier(xbar);
        if (PHMASK & (1 << 6)) {
            pg8::Gemm g{HB, layer ? Wdn1 : Wdn0, M, D, FF}; pg8::StaticOrder S; S.init(M, D, G, bx);
            pg8::EpiResid<1> E{Z, Z, ST, ln_g + (2 * layer) * D, ln_b + (2 * layer) * D, nullptr, ALPHA};
            pg8::gemm_phase<pg8::EpiResid<1>, pg8::StaticOrder, true, true>(L, g, S, E);
        }
        xcd_barrier(xbar);
        if (layer == 0) { ln_phase(Z, XN, ST, ln_g + 1 * D, ln_b + 1 * D, nullptr, gw, NGW, lane); xcd_barrier(xbar); }
        else ln_phase(Z, nullptr, ST, ln_g + 3 * D, ln_b + 3 * D, args.out, gw, NGW, lane);
    }
}

extern "C" void kernel_launch(void* const* d_in, const int* in_sizes, int n_in, void* d_out, int out_size, void* d_ws, size_t ws_size, hipStream_t stream) {
    static int grid = 0;
    if (grid == 0) {
        if (n_in != 21 || out_size != M * D || ws_size < WS_END) { fprintf(stderr, "kernel_launch: unexpected shapes (n_in %d out %d ws %zu)\n", n_in, out_size, ws_size); grid = -1; return; }
        int dev = 0, cus = 0, per_cu = 0;
        hipGetDevice(&dev); hipDeviceGetAttribute(&cus, hipDeviceAttributeMultiprocessorCount, dev);
        if (hipFuncSetAttribute((const void*)fwd_kernel, hipFuncAttributeMaxDynamicSharedMemorySize, LDS_BYTES) != hipSuccess) { fprintf(stderr, "kernel_launch: hipFuncSetAttribute failed\n"); grid = -1; return; }
        hipOccupancyMaxActiveBlocksPerMultiprocessor(&per_cu, (const void*)fwd_kernel, NWAVES * 64, LDS_BYTES);
        (void)hipGetLastError();
        grid = cus * (per_cu > 0 ? 1 : 1);
        if (grid > 256) grid = 256;
        grid &= ~7;
        fprintf(stderr, "kernel_launch: cus %d per_cu %d grid %d\n", cus, per_cu, grid);
    }
    if (grid <= 0) return;
    Args a{};
    for (int i = 0; i < 21; ++i) a.in[i] = (const float*)d_in[i];
    a.out = (float*)d_out; a.ws = (unsigned char*)d_ws;
    void* kargs[] = {&a};
    hipError_t e = hipLaunchCooperativeKernel((const void*)fwd_kernel, dim3(grid), dim3(NWAVES * 64), kargs, LDS_BYTES, stream);
    if (e != hipSuccess) fprintf(stderr, "kernel_launch: cooperative launch failed: %s (grid %d)\n", hipGetErrorString(e), grid);
}
```

```cpp
#include <hip/hip_runtime.h>
#include <hip/hip_cooperative_groups.h>
#include <cstdio>
#include <cstdint>
namespace cg = cooperative_groups;
namespace pg8 {
#define PG8_LAS __attribute__((address_space(3)))
typedef unsigned short bf16_t;
typedef short bf16x8 __attribute__((ext_vector_type(8)));
typedef float f32x4 __attribute__((ext_vector_type(4)));
typedef unsigned u32x4 __attribute__((ext_vector_type(4)));
constexpr int BM = 256, BK = 64, HALF = 128, HTB = HALF * BK * 2  , STAGE_BYTES = 8 * HTB, NXCD = 8, WGM = 8;

__host__ __device__ __forceinline__ int lds_byte(int r, int c) { const int st = (r >> 4) * 2 + (c >> 5), rr = r & 15, cc = c & 31, ob = rr * 64 + cc * 2; return st * 1024 + (ob ^ (((ob >> 9) & 1) << 5)); }
__host__ __device__ __forceinline__ void stage_rc(int b, int& R, int& C) { const int st = b / 1024, sb = b % 1024, swz = sb ^ (((sb >> 9) & 1) << 5); R = (st >> 1) * 16 + swz / 64; C = (st & 1) * 32 + (swz % 64) / 2; }
__host__ __device__ __forceinline__ int perm32(int rho) { const int n = rho >> 4, i = rho & 15; return 8 * (i >> 2) + 4 * n + (i & 3); }

struct Unit { int pm, pn; };
struct Gemm { const bf16_t* A; const bf16_t* Bt; int M, N, K; };

struct StaticOrder {
    int nM, nN, nwg, G, c;
    __host__ __device__ void init(int M, int N, int G_, int c_) { nM = M / BM; nN = N / BM; nwg = nM * nN; G = G_; c = c_; }
    __host__ __device__ bool next(int i, Unit& u) const {
        const long L = (long)i * G + c; if (L >= nwg) return false;
        int wgid = (int)L; { const int q = nwg / NXCD, r = nwg % NXCD, xcd = wgid % NXCD, off = wgid / NXCD; wgid = (xcd < r ? xcd * (q + 1) : r * (q + 1) + (xcd - r) * q) + off; }
        const int nig = WGM * nN, gid = wgid / nig, fm = gid * WGM, gsz = (nM - fm) < WGM ? (nM - fm) : WGM;
        u.pm = fm + ((wgid % nig) % gsz); u.pn = (wgid % nig) / gsz; return true;
    }
    __device__ __forceinline__ void a_ready(const Unit&) const {}
    __device__ __forceinline__ void done(const Unit&) const {}
};

__device__ __forceinline__ unsigned cvt_pk_bf16(float lo, float hi) { unsigned r; asm volatile("v_cvt_pk_bf16_f32 %0, %1, %2" : "=v"(r) : "v"(lo), "v"(hi)); return r; }
__device__ __forceinline__ void glds_s(const void* sbase, unsigned voff, unsigned ldsdst) {
    unsigned keep;
    asm volatile("s_mov_b32 %0, m0\n\ts_mov_b32 m0, %3\n\ts_nop 0\n\tglobal_load_lds_dwordx4 %1, %2\n\ts_mov_b32 m0, %0" : "=&s"(keep) : "v"(voff), "s"(sbase), "s"(ldsdst) : "memory");
}
typedef float f32x2 __attribute__((ext_vector_type(2)));
__device__ __forceinline__ f32x2 gelu_pk(f32x2 v) {
    const f32x2 av = __builtin_elementwise_abs(v), d = av * 0.2316418882f + 1.0f;
    f32x2 t; t.x = __builtin_amdgcn_rcpf(d.x); t.y = __builtin_amdgcn_rcpf(d.y);
    f32x2 q = t * 0.5307027145f + (-0.7265760135f); q = q * t + 0.7107068705f; q = q * t + (-0.142248368f); q = q * t + 0.127414796f; q = q * t;
    const f32x2 s = (v * v) * (-0.72134752044f);
    f32x2 e; e.x = __builtin_amdgcn_exp2f(s.x); e.y = __builtin_amdgcn_exp2f(s.y);
    const f32x2 m = v * (q * e), r = v - m;
    f32x2 o; o.x = v.x < 0.f ? m.x : r.x; o.y = v.y < 0.f ? m.y : r.y; return o;
}

template <int ACT  > struct EpiBf16 {
    static constexpr bool PERM = true, AFTER_DRAIN = false; static_assert(ACT == 0 || ACT == 1, "EpiBf16: ACT is 0 (none) or 1 (gelu_pk)");
    bf16_t* O; int ldc; const float* bias; int split_cols; size_t split_stride; float scale0;
    __device__ __forceinline__ void operator()(const f32x4 (&acc)[2][2][4][2], const Unit& u, int wr, int wc, int fr_in, int fq_in) const {
        int fr = fr_in, fq = fq_in; asm volatile("" : "+v"(fr), "+v"(fq));
        const int row0 = u.pm * BM + wr * 64 + fr; int colt = u.pn * BM; bf16_t* base = O;
        float sc = 1.f; if (split_cols) { const int t = colt / split_cols; base += (size_t)t * split_stride; colt -= t * split_cols; if (t == 0) sc = scale0; }
        const int col0 = colt + wc * 32 + 8 * fq, bcol0 = u.pn * BM + wc * 32 + 8 * fq;
        f32x4 bv[2][2];
#pragma unroll
        for (int bj = 0; bj < 2; ++bj)
#pragma unroll
            for (int n = 0; n < 2; ++n) bv[bj][n] = bias ? *(const f32x4*)(bias + bcol0 + bj * HALF + 4 * n) : (f32x4){0.f, 0.f, 0.f, 0.f};
#pragma unroll
        for (int ai = 0; ai < 2; ++ai)
#pragma unroll
            for (int m = 0; m < 4; ++m) { bf16_t* rowp = base + (size_t)(row0 + ai * HALF + m * 16) * ldc + col0;
#pragma unroll
                for (int bj = 0; bj < 2; ++bj) { f32x4 v0 = acc[ai][bj][m][0] + bv[bj][0], v1 = acc[ai][bj][m][1] + bv[bj][1];
                    if (ACT == 1) { f32x2 a = gelu_pk((f32x2){v0[0], v0[1]}), b = gelu_pk((f32x2){v0[2], v0[3]}), c = gelu_pk((f32x2){v1[0], v1[1]}), d = gelu_pk((f32x2){v1[2], v1[3]});
                        v0 = (f32x4){a.x, a.y, b.x, b.y}; v1 = (f32x4){c.x, c.y, d.x, d.y}; }
                    v0 = v0 * sc; v1 = v1 * sc; u32x4 w; w.x = cvt_pk_bf16(v0[0], v0[1]); w.y = cvt_pk_bf16(v0[2], v0[3]); w.z = cvt_pk_bf16(v1[0], v1[1]); w.w = cvt_pk_bf16(v1[2], v1[3]);
                    *(u32x4*)(rowp + bj * HALF) = w; } }
    }
};
__device__ __forceinline__ u32x4 pack8(const f32x4 v0, const f32x4 v1) { u32x4 w; w.x = cvt_pk_bf16(v0[0], v0[1]); w.y = cvt_pk_bf16(v0[2], v0[3]); w.z = cvt_pk_bf16(v1[0], v1[1]); w.w = cvt_pk_bf16(v1[2], v1[3]); return w; }
__device__ __forceinline__ f32x4 sigm4(const f32x4 g) {
    f32x4 r;
#pragma unroll
    for (int i = 0; i < 4; ++i) r[i] = __builtin_amdgcn_rcpf(1.0f + __builtin_amdgcn_exp2f(g[i] * -1.4426950408889634f));
    return r;
}
struct EpiQKV {
    static constexpr bool PERM = true, AFTER_DRAIN = false;
    bf16_t* Q; bf16_t* Kb; bf16_t* V; const float* tab; float qscale;
    __device__ __forceinline__ void operator()(const f32x4 (&acc)[2][2][4][2], const Unit& u, int wr, int wc, int fr_in, int fq_in) const {
        int fr = fr_in, fq = fq_in; asm volatile("" : "+v"(fr), "+v"(fq));
        const int row0 = u.pm * BM + wr * 64 + fr;
        if (u.pn >= 8) {
            const int col0 = (u.pn - 8) * BM + wc * 32 + 8 * fq;
#pragma unroll
            for (int ai = 0; ai < 2; ++ai)
#pragma unroll
                for (int m = 0; m < 4; ++m) { const int row = row0 + ai * HALF + m * 16;
                    bf16_t* vp = V + ((((size_t)(row >> 13) * 8 + 2 * (u.pn - 8)) * 128 + ((row & 8191) >> 6)) * 16 + (wc * 4 + ((row & 63) >> 4))) * 512 + (size_t)(row & 15) * 32 + 8 * fq;
#pragma unroll
                    for (int bj = 0; bj < 2; ++bj) *(u32x4*)(vp + (size_t)bj * (128 * 16 * 512)) = pack8(acc[ai][bj][m][0], acc[ai][bj][m][1]); }
        } else {
            bf16_t* dst = (u.pn >> 2) ? Kb : Q; const float sc = (u.pn >> 2) ? 1.0f : qscale;
            const int colbase = 64 * (4 * (u.pn & 3) + wc) + 8 * fq;
#pragma unroll
            for (int ai = 0; ai < 2; ++ai)
#pragma unroll
                for (int m = 0; m < 4; ++m) { const int row = row0 + ai * HALF + m * 16; const float* tp = tab + (size_t)(row & 8191) * 64 + 8 * fq;
                    const f32x4 c0 = *(const f32x4*)(tp), c1 = *(const f32x4*)(tp + 4), s0 = *(const f32x4*)(tp + 32), s1 = *(const f32x4*)(tp + 36);
                    const f32x4 x10 = acc[ai][0][m][0], x11 = acc[ai][0][m][1], x20 = acc[ai][1][m][0], x21 = acc[ai][1][m][1];
                    const f32x4 o10 = (x10 * c0 - x20 * s0) * sc, o11 = (x11 * c1 - x21 * s1) * sc, o20 = (x20 * c0 + x10 * s0) * sc, o21 = (x21 * c1 + x11 * s1) * sc;
                    if (u.pn >> 2) {
                        bf16_t* kp = Kb + ((((size_t)(row >> 13) * 16 + (4 * (u.pn & 3) + wc)) * 128 + ((row & 8191) >> 6)) * 8 + fq) * 512 + (size_t)(row & 63) * 8;
                        *(u32x4*)(kp) = pack8(o10, o11); *(u32x4*)(kp + 2048) = pack8(o20, o21);
                    } else { bf16_t* rowp = dst + (size_t)row * 1024 + colbase;
                        *(u32x4*)(rowp) = pack8(o10, o11); *(u32x4*)(rowp + 32) = pack8(o20, o21); }
                    asm volatile("" ::: "memory"); }
        }
    }
};
struct EpiSwiGLU {
    static constexpr bool PERM = true, AFTER_DRAIN = false;
    bf16_t* H; int ldc;
    __device__ __forceinline__ void operator()(const f32x4 (&acc)[2][2][4][2], const Unit& u, int wr, int wc, int fr_in, int fq_in) const {
        int fr = fr_in, fq = fq_in; asm volatile("" : "+v"(fr), "+v"(fq));
        const int row0 = u.pm * BM + wr * 64 + fr, col0 = u.pn * HALF + wc * 32 + 8 * fq;
#pragma unroll
        for (int ai = 0; ai < 2; ++ai)
#pragma unroll
            for (int m = 0; m < 4; ++m) { bf16_t* rowp = H + (size_t)(row0 + ai * HALF + m * 16) * ldc + col0;
                const f32x4 g0 = acc[ai][0][m][0], g1 = acc[ai][0][m][1];
                const f32x4 h0 = g0 * sigm4(g0) * acc[ai][1][m][0], h1 = g1 * sigm4(g1) * acc[ai][1][m][1];
                *(u32x4*)(rowp) = pack8(h0, h1); __builtin_amdgcn_sched_barrier(0); }
    }
};
struct EpiGLU {
    static constexpr bool PERM = true, AFTER_DRAIN = false;
    bf16_t* G; const float* bias;
    __device__ __forceinline__ void operator()(const f32x4 (&acc)[2][2][4][2], const Unit& u, int wr, int wc, int fr_in, int fq_in) const {
        int fr = fr_in, fq = fq_in; asm volatile("" : "+v"(fr), "+v"(fq));
        const int row0 = u.pm * BM + wr * 64 + fr, col0 = u.pn * HALF + wc * 32 + 8 * fq;
#pragma unroll
        for (int ai = 0; ai < 2; ++ai)
#pragma unroll
            for (int m = 0; m < 4; ++m) { bf16_t* rowp = G + (size_t)(row0 + ai * HALF + m * 16) * 1024 + col0;
                const f32x4 ba0 = *(const f32x4*)(bias + col0), ba1 = *(const f32x4*)(bias + col0 + 4), bg0 = *(const f32x4*)(bias + 1024 + col0), bg1 = *(const f32x4*)(bias + 1024 + col0 + 4);
                const f32x4 h0 = (acc[ai][0][m][0] + ba0) * sigm4(acc[ai][1][m][0] + bg0), h1 = (acc[ai][0][m][1] + ba1) * sigm4(acc[ai][1][m][1] + bg1);
                *(u32x4*)(rowp) = pack8(h0, h1); asm volatile("" ::: "memory"); __builtin_amdgcn_sched_barrier(0); }
    }
};
template <int MODE> struct EpiResid {
    static constexpr bool PERM = false, AFTER_DRAIN = false;
    const float* xin; float* out; const float* st; const float* g; const float* b; const float* bias; float alpha;
    __device__ __forceinline__ void operator()(const f32x4 (&acc)[2][2][4][2], const Unit& u, int wr, int wc, int fr_in, int fq_in) const {
        int fr = fr_in, fq = fq_in; asm volatile("" : "+v"(fr), "+v"(fq));
        const int col0 = u.pn * BM + wc * 32 + 4 * fq;
#pragma unroll
        for (int bj = 0; bj < 2; ++bj)
#pragma unroll
            for (int n = 0; n < 2; ++n) { const int c = col0 + bj * HALF + n * 16;
                const f32x4 cv = bias ? *(const f32x4*)(bias + c) : (f32x4){0.f, 0.f, 0.f, 0.f};
                f32x4 gv = cv, bv = cv; if (MODE == 1) { gv = *(const f32x4*)(g + c); bv = *(const f32x4*)(b + c); }
#pragma unroll
                for (int ai = 0; ai < 2; ++ai)
#pragma unroll
                    for (int m = 0; m < 4; ++m) { const int row = u.pm * BM + ai * HALF + wr * 64 + m * 16 + fr; const size_t off = (size_t)row * 1024 + c;
                        f32x4 xv = *(const f32x4*)(xin + off);
                        if (MODE == 1) { const float mean = st[2 * row], rstd = st[2 * row + 1]; xv = (xv - mean) * rstd * gv + bv; }
                        *(f32x4*)(out + off) = xv * alpha + acc[ai][bj][m][n] + cv;
                        if (m & 1) asm volatile("" ::: "memory"); }
            }
    }
};

template <class Epi, class Sched, bool ALIGN_EPI = false, bool SP2 = false>
__device__ __forceinline__ void gemm_phase(PG8_LAS unsigned char* lds, const Gemm g, const Sched& S, const Epi& E) {
    int tid_l = threadIdx.x; asm volatile("" : "+v"(tid_l));
    const int tid = tid_l, wid = __builtin_amdgcn_readfirstlane(tid >> 6), lane = tid & 63, wr = wid >> 2, wc = wid & 3, fr = lane & 15, fq = lane >> 4;
    const int K = g.K, nt = K / BK;
    unsigned voffA[2], voffB[2];
#pragma unroll
    for (int i = 0; i < 2; ++i) { int R, C; stage_rc(tid * 16 + i * 8192, R, C); const int Rb = Epi::PERM ? ((R & ~31) + perm32(R & 31)) : R;
        voffA[i] = (unsigned)(R * K + C) * 2u; voffB[i] = (unsigned)(Rb * K + C) * 2u; }
    const size_t kstep = (size_t)(BK * 2);
    const size_t hstep = (size_t)HALF * K * 2;
    const size_t tstep = 2 * hstep;
    const unsigned ldsbase_ = (unsigned)(uintptr_t)lds;
    const unsigned ldsw = (unsigned)wid * 1024u;
    const int aoff = lds_byte(wr * 64 + fr, fq * 8), boff = lds_byte(wc * 32 + fr, fq * 8);
#define PG8_SA(b, h) (((b) * 2 + (h)) * HTB)
#define PG8_SB(b, h) ((4 + (b) * 2 + (h)) * HTB)
#define PG8_STAGE(bufoff, gbase, voff) do { _Pragma("unroll") for (int _i = 0; _i < 2; ++_i) \
        glds_s((const void*)(gbase), (voff)[_i], ldsbase_ + (unsigned)(bufoff) + ldsw + (unsigned)_i * 8192u); } while (0)
#define PG8_LDA(dst, b, h) do { _Pragma("unroll") for (int m = 0; m < 4; ++m) _Pragma("unroll") for (int k = 0; k < 2; ++k) dst[m][k] = *(const PG8_LAS bf16x8*)(lds + PG8_SA(b, h) + aoff + m * 2048 + k * 1024); } while (0)
#define PG8_LDB(dst, b, h) do { _Pragma("unroll") for (int n = 0; n < 2; ++n) _Pragma("unroll") for (int k = 0; k < 2; ++k) dst[n][k] = *(const PG8_LAS bf16x8*)(lds + PG8_SB(b, h) + boff + n * 2048 + k * 1024); } while (0)
#define PG8_MMA(ai, bj, At, Bt) do { __builtin_amdgcn_s_setprio(1); _Pragma("unroll") for (int m = 0; m < 4; ++m) _Pragma("unroll") for (int n = 0; n < 2; ++n) _Pragma("unroll") for (int k = 0; k < 2; ++k) \
        acc[ai][bj][m][n] = __builtin_amdgcn_mfma_f32_16x16x32_bf16(Bt[n][k], At[m][k], acc[ai][bj][m][n], 0, 0, 0); __builtin_amdgcn_s_setprio(0); } while (0)
#define PG8_WAIT_V(n) asm volatile("s_waitcnt vmcnt(" #n ")" ::: "memory")
#define PG8_WAIT_L(n) asm volatile("s_waitcnt lgkmcnt(" #n ")" ::: "memory")
#define PG8_BAR __builtin_amdgcn_s_barrier()
#define PG8_SCHED __builtin_amdgcn_sched_barrier(0)
    Unit cur, nxt; int ui = 0;
    if (!S.next(0, cur)) return;
    f32x4 acc[2][2][4][2];
#pragma unroll
    for (int a = 0; a < 2; ++a)
#pragma unroll
        for (int b = 0; b < 2; ++b)
#pragma unroll
            for (int m = 0; m < 4; ++m)
#pragma unroll
                for (int n = 0; n < 2; ++n) acc[a][b][m][n] = (f32x4){0.f, 0.f, 0.f, 0.f};
    bf16x8 At[4][2], B0[2][2], B1[2][2];
    const char* cA = (const char*)g.A + (size_t)cur.pm * tstep; const char* cB = (const char*)g.Bt + (size_t)cur.pn * tstep;
    S.a_ready(cur);
    if constexpr (SP2) {
        PG8_STAGE(PG8_SB(0, 0), cB, voffB); PG8_SCHED; PG8_STAGE(PG8_SB(0, 1), cB + hstep, voffB); PG8_SCHED; PG8_STAGE(PG8_SA(0, 0), cA, voffA); PG8_SCHED; PG8_STAGE(PG8_SA(0, 1), cA + hstep, voffA); PG8_SCHED;
        if (wr == 1) PG8_BAR;
        PG8_WAIT_V(2); PG8_BAR; PG8_SCHED;
        PG8_STAGE(PG8_SB(1, 0), cB + kstep, voffB); PG8_SCHED; PG8_STAGE(PG8_SA(1, 0), cA + kstep, voffA); PG8_SCHED; PG8_STAGE(PG8_SB(1, 1), cB + hstep + kstep, voffB); PG8_SCHED;
        PG8_WAIT_V(6); PG8_BAR; PG8_SCHED;
    } else {
        PG8_STAGE(PG8_SB(0, 0), cB, voffB); PG8_STAGE(PG8_SA(0, 0), cA, voffA); PG8_STAGE(PG8_SB(0, 1), cB + hstep, voffB); PG8_STAGE(PG8_SA(0, 1), cA + hstep, voffA);
        if (wr == 1) PG8_BAR;
        PG8_WAIT_V(4); PG8_BAR;
        PG8_STAGE(PG8_SB(1, 0), cB + kstep, voffB); PG8_STAGE(PG8_SA(1, 0), cA + kstep, voffA); PG8_STAGE(PG8_SB(1, 1), cB + hstep + kstep, voffB);
        PG8_WAIT_V(6); PG8_BAR;
    }
    for (;;) {
        const bool has_next = S.next(ui + 1, nxt);
        const char* nA = has_next ? (const char*)g.A + (size_t)nxt.pm * tstep : cA; const char* nB = has_next ? (const char*)g.Bt + (size_t)nxt.pn * tstep : cB;
        for (int t = 0; t < nt; t += 2) {
            const bool last = (t == nt - 2);
            const char* a1 = cA + (size_t)(t + 1) * kstep;
            const char* a2 = last ? nA : cA + (size_t)(t + 2) * kstep; const char* b2 = last ? nB : cB + (size_t)(t + 2) * kstep;
            const char* a3 = a2 + kstep; const char* b3 = b2 + kstep;
            if (last && has_next) S.a_ready(nxt);
            if constexpr (SP2) {
            PG8_LDB(B0, 0, 0); PG8_LDB(B1, 0, 1); PG8_SCHED; PG8_LDA(At, 0, 0); PG8_STAGE(PG8_SA(1, 1), a1 + hstep, voffA);
            PG8_WAIT_V(8); PG8_WAIT_L(0); PG8_BAR; PG8_MMA(0, 0, At, B0); PG8_MMA(0, 1, At, B1); PG8_BAR; PG8_SCHED;
            PG8_LDA(At, 0, 1); PG8_STAGE(PG8_SB(0, 0), b2, voffB); PG8_STAGE(PG8_SB(0, 1), b2 + hstep, voffB); PG8_STAGE(PG8_SA(0, 0), a2, voffA);
            PG8_WAIT_V(8); PG8_WAIT_L(0); PG8_BAR; PG8_MMA(1, 0, At, B0); PG8_MMA(1, 1, At, B1); PG8_BAR; PG8_SCHED;
            PG8_LDB(B0, 1, 0); PG8_LDB(B1, 1, 1); PG8_SCHED; PG8_LDA(At, 1, 0); PG8_STAGE(PG8_SA(0, 1), a2 + hstep, voffA);
            PG8_WAIT_V(8); PG8_WAIT_L(0); PG8_BAR; PG8_MMA(0, 0, At, B0); PG8_MMA(0, 1, At, B1); PG8_BAR; PG8_SCHED;
            PG8_LDA(At, 1, 1); PG8_STAGE(PG8_SB(1, 0), b3, voffB); PG8_STAGE(PG8_SB(1, 1), b3 + hstep, voffB); PG8_STAGE(PG8_SA(1, 0), a3, voffA);
            PG8_WAIT_V(8); PG8_WAIT_L(0); PG8_BAR; PG8_MMA(1, 0, At, B0); PG8_MMA(1, 1, At, B1); PG8_BAR; PG8_SCHED;
            } else {
            PG8_LDB(B0, 0, 0); PG8_SCHED; PG8_LDA(At, 0, 0); PG8_STAGE(PG8_SA(1, 1), a1 + hstep, voffA);
            PG8_WAIT_L(8); PG8_BAR; PG8_WAIT_L(0); PG8_MMA(0, 0, At, B0); PG8_BAR; PG8_SCHED;
            PG8_LDB(B1, 0, 1); PG8_STAGE(PG8_SB(0, 0), b2, voffB);
            PG8_BAR; PG8_WAIT_L(0); PG8_MMA(0, 1, At, B1); PG8_BAR;
            PG8_LDA(At, 0, 1); PG8_STAGE(PG8_SA(0, 0), a2, voffA);
            PG8_BAR; PG8_WAIT_L(0); PG8_MMA(1, 0, At, B0); PG8_BAR; PG8_SCHED;
            PG8_STAGE(PG8_SB(0, 1), b2 + hstep, voffB);
            PG8_WAIT_V(6); PG8_BAR; PG8_MMA(1, 1, At, B1); PG8_BAR;
            PG8_LDB(B0, 1, 0); PG8_SCHED; PG8_LDA(At, 1, 0); PG8_STAGE(PG8_SA(0, 1), a2 + hstep, voffA);
            PG8_WAIT_L(8); PG8_BAR; PG8_WAIT_L(0); PG8_MMA(0, 0, At, B0); PG8_BAR; PG8_SCHED;
            PG8_LDB(B1, 1, 1); PG8_STAGE(PG8_SB(1, 0), b3, voffB);
            PG8_BAR; PG8_WAIT_L(0); PG8_MMA(0, 1, At, B1); PG8_BAR;
            PG8_LDA(At, 1, 1); PG8_STAGE(PG8_SA(1, 0), a3, voffA);
            PG8_BAR; PG8_WAIT_L(0); PG8_MMA(1, 0, At, B0); PG8_BAR; PG8_SCHED;
            PG8_STAGE(PG8_SB(1, 1), b3 + hstep, voffB);
            PG8_WAIT_V(6); PG8_BAR; PG8_MMA(1, 1, At, B1); PG8_BAR;
            }
        }
        if constexpr (ALIGN_EPI) { if (wr == 0) PG8_BAR; }
        if constexpr (!Epi::AFTER_DRAIN) { E(acc, cur, wr, wc, fr, fq); S.done(cur); }
        if (!has_next) break;
#pragma unroll
        for (int a = 0; a < 2; ++a)
#pragma unroll
            for (int b = 0; b < 2; ++b)
#pragma unroll
                for (int m = 0; m < 4; ++m)
#pragma unroll
                    for (int n = 0; n < 2; ++n) acc[a][b][m][n] = (f32x4){0.f, 0.f, 0.f, 0.f};
        cur = nxt; cA = nA; cB = nB; ++ui;
        if constexpr (ALIGN_EPI) { if (wr == 1) PG8_BAR; }
    }
    PG8_WAIT_V(0);
    if constexpr (!ALIGN_EPI) { if (wr == 0) PG8_BAR; }
    PG8_BAR;
    if constexpr (Epi::AFTER_DRAIN) { E.fused(acc, cur, wr, wc, fr, fq, lds, wid, lane); S.done(cur); }
#undef PG8_SA
#undef PG8_SB
#undef PG8_STAGE
#undef PG8_LDA
#undef PG8_LDB
#undef PG8_MMA
#undef PG8_WAIT_V
#undef PG8_WAIT_L
#undef PG8_BAR
#undef PG8_SCHED
}
}

namespace att {
#define ALAS __attribute__((address_space(3)))
typedef unsigned short bf16_t;
typedef short bf16x8 __attribute__((ext_vector_type(8)));
typedef short s16x4 __attribute__((ext_vector_type(4)));
typedef short v4i16_t __attribute__((ext_vector_type(4)));
typedef float f32x16 __attribute__((ext_vector_type(16)));
typedef float f32x4 __attribute__((ext_vector_type(4)));
typedef unsigned u32x4 __attribute__((ext_vector_type(4)));
constexpr int SEQ = 8192, PITCH = 1024;
constexpr int KBYTES = 8192, VBYTES = 16384, VOFF0 = 3 * KBYTES, WSF_OFF = VOFF0 + 3 * VBYTES, STG_OFF = WSF_OFF + 8 * 64 * 4, LDS_BYTES = STG_OFF + 8 * 8192;
#ifndef ATT_GRP_SHIFT
#define ATT_GRP_SHIFT 2
#endif
__device__ __forceinline__ int crow(int r, int hi) { return (r & 3) + 8 * (r >> 2) + 4 * hi; }
__device__ __forceinline__ unsigned f2bf(float f) { unsigned u = __builtin_bit_cast(unsigned, f); return (u + 0x7fffu + ((u >> 16) & 1u)) >> 16; }
__device__ __forceinline__ s16x4 vtr(const ALAS unsigned char* p) { return __builtin_bit_cast(s16x4, __builtin_amdgcn_ds_read_tr16_b64_v4i16((ALAS v4i16_t*)p)); }
__device__ __forceinline__ float swapsum(float v) { auto rr = __builtin_amdgcn_permlane32_swap(__float_as_uint(v), __float_as_uint(v), false, false); return __uint_as_float(rr[0]) + __uint_as_float(rr[1]); }
__device__ __forceinline__ float swapmax(float v) { auto rr = __builtin_amdgcn_permlane32_swap(__float_as_uint(v), __float_as_uint(v), false, false); return fmaxf(__uint_as_float(rr[0]), __uint_as_float(rr[1])); }
__device__ __forceinline__ float max3f(float a, float b, float c) { float r; asm("v_max3_f32 %0, %1, %2, %3" : "=v"(r) : "v"(a), "v"(b), "v"(c)); return r; }
__device__ __forceinline__ float max2f(float a, float b) { float r; asm("v_max_f32_e32 %0, %1, %2" : "=v"(r) : "v"(a), "v"(b)); return r; }
#define ATT_GLDS(g, l) __builtin_amdgcn_global_load_lds((const unsigned*)(g), (ALAS unsigned*)(l), 16, 0, 0)
#define ATT_LWAIT() asm volatile("s_waitcnt lgkmcnt(0)" ::: "memory")

__device__ __forceinline__ void attn_unit(int b, int h, int qb, const bf16_t* Q, const bf16_t* K, const bf16_t* V, bf16_t* O, float* scr, ALAS unsigned char* shm, float lam, float outscale, const float* subg) {
    int tid_l = threadIdx.x; asm volatile("" : "+v"(tid_l));
    const int tid = tid_l, lane = tid & 63, r32 = lane & 31, hi = lane >> 5; const int wid = __builtin_amdgcn_readfirstlane(tid >> 6);
    const size_t rowbase = (size_t)b * SEQ; const int q0 = qb * 256;
    const int NT = 4 * qb + 4, cw = 4 * qb + (wid >> 1);
    const unsigned shm0 = (unsigned)(uintptr_t)shm;
    ALAS float* wsf = (ALAS float*)(shm + WSF_OFF) + wid * 64;
    float* myscr = scr + ((((rowbase + q0) >> 5) + wid) * 8 + h) * 4096;
    f32x16 o[4];
    for (int m = 0; m < 2; ++m) {
        const bf16_t* Qw = Q + (rowbase + q0 + wid * 32) * PITCH + h * 128 + m * 64;
        const bf16_t* ksrc = K + ((size_t)((b * 16 + h * 2 + m) * 128)) * 4096 + wid * 512;
        const bf16_t* vsrc = V + ((size_t)((b * 8 + h) * 128)) * 8192 + wid * 512;
        const unsigned koff = (unsigned)lane * 16u, voff = (unsigned)lane * 16u;
        bf16x8 qr[4];
        unsigned qoff = (unsigned)r32 * (PITCH * 2) + (unsigned)hi * 16u; asm volatile("" : "+v"(qoff));
#pragma unroll
        for (int d0 = 0; d0 < 4; ++d0) qr[d0] = *(const bf16x8*)((const char*)Qw + (qoff + (unsigned)d0 * 32u));
        float mhat = 0.f, l = 0.f; f32x16 negm;
#pragma unroll
        for (int r = 0; r < 16; ++r) negm[r] = 0.f;
#pragma unroll
        for (int d0 = 0; d0 < 4; ++d0)
#pragma unroll
            for (int r = 0; r < 16; ++r) o[d0][r] = 0.f;
        bf16x8 pw[4];
#pragma unroll
        for (int ks = 0; ks < 4; ++ks) pw[ks] = (bf16x8){0, 0, 0, 0, 0, 0, 0, 0};
#define ATT_DMA(t, koffs, voffs) do { const size_t go_ = (size_t)(t) * 64 * PITCH; pg8::glds_s(ksrc + go_, koff, shm0 + (unsigned)(koffs) + (unsigned)wid * 1024u); \
            pg8::glds_s(vsrc + go_, voff, shm0 + (unsigned)(voffs) + (unsigned)wid * 1024u); pg8::glds_s(vsrc + go_ + 64, voff, shm0 + (unsigned)(voffs) + (unsigned)(wid + 8) * 1024u); } while (0)
#define ATT_QK(P0, P1, koffs) do { \
            const ALAS unsigned char* kb = shm + (koffs) + hi * 1024 + r32 * 16; \
            bf16x8 kf[8]; \
            _Pragma("unroll") for (int d0 = 0; d0 < 4; ++d0) { kf[2 * d0] = *(const ALAS bf16x8*)(kb + d0 * 2048); kf[2 * d0 + 1] = *(const ALAS bf16x8*)(kb + d0 * 2048 + 512); } \
            P0 = __builtin_amdgcn_mfma_f32_32x32x16_bf16(kf[0], qr[0], negm, 0, 0, 0); P1 = __builtin_amdgcn_mfma_f32_32x32x16_bf16(kf[1], qr[0], negm, 0, 0, 0); \
            _Pragma("unroll") for (int d0 = 1; d0 < 4; ++d0) { P0 = __builtin_amdgcn_mfma_f32_32x32x16_bf16(kf[2 * d0], qr[d0], P0, 0, 0, 0); P1 = __builtin_amdgcn_mfma_f32_32x32x16_bf16(kf[2 * d0 + 1], qr[d0], P1, 0, 0, 0); } \
        } while (0)
#define ATT_FIN(P0, P1) do { \
            float sacc = 0.f; \
            _Pragma("unroll") for (int r = 0; r < 16; ++r) { P1[r] = __builtin_amdgcn_exp2f(P1[r]); sacc += P0[r] + P1[r]; } \
            l += sacc; \
            _Pragma("unroll") for (int ks = 0; ks < 4; ++ks) { u32x4 w; \
                _Pragma("unroll") for (int i = 0; i < 4; ++i) { const int r = 8 * (ks & 1) + 2 * i; const float a = (ks < 2) ? P0[r] : P1[r], c = (ks < 2) ? P0[r + 1] : P1[r + 1]; w[i] = pg8::cvt_pk_bf16(a, c); } \
                pw[ks] = __builtin_bit_cast(bf16x8, w); } \
        } while (0)
#define ATT_PART(P0, P1, j_) do { \
            float rma = max3f(P0[0], P0[1], P1[0]), rmb = max3f(P0[2], P0[3], P1[1]); rma = max3f(rma, P1[2], P1[3]); \
            _Pragma("unroll") for (int r = 4; r < 16; r += 4) { rma = max3f(rma, P0[r], P0[r + 1]); rmb = max3f(rmb, P0[r + 2], P0[r + 3]); rma = max3f(rma, P1[r], P1[r + 1]); rmb = max3f(rmb, P1[r + 2], P1[r + 3]); } \
            float rm = swapmax(max2f(rma, rmb)); \
            const bool first_ = ((j_) == 0); \
            if (first_ || __any(rm > 8.0f)) { \
                const float dl = first_ ? rm : fmaxf(rm, 0.f), f = first_ ? 1.0f : __builtin_amdgcn_exp2f(-dl); mhat += dl; l *= f; \
                _Pragma("unroll") for (int r = 0; r < 16; ++r) { P0[r] -= dl; P1[r] -= dl; negm[r] = -mhat; } \
                ATT_LWAIT(); \
                if (hi == 0) wsf[r32] = f; \
                ATT_LWAIT(); \
                _Pragma("unroll") for (int r = 0; r < 16; ++r) { const float fr_ = wsf[crow(r, hi)]; \
                    _Pragma("unroll") for (int d0 = 0; d0 < 4; ++d0) o[d0][r] *= fr_; } \
                ATT_LWAIT(); \
            } \
            _Pragma("unroll") for (int r = 0; r < 16; ++r) P0[r] = __builtin_amdgcn_exp2f(P0[r]); \
        } while (0)
#define ATT_PV(voffs) do { \
            const ALAS unsigned char* vp = shm + (voffs) + ((lane >> 4) & 1) * 32 + (lane & 3) * 8 + (4 * hi + ((lane & 15) >> 2)) * 64; \
            _Pragma("unroll") for (int ks = 0; ks < 4; ++ks) \
                _Pragma("unroll") for (int d0 = 0; d0 < 4; ++d0) { \
                    const s16x4 lo = vtr(vp + d0 * 4096 + ks * 1024), hh = vtr(vp + d0 * 4096 + ks * 1024 + 512); \
                    const bf16x8 vf = (bf16x8){lo[0], lo[1], lo[2], lo[3], hh[0], hh[1], hh[2], hh[3]}; \
                    o[d0] = __builtin_amdgcn_mfma_f32_32x32x16_bf16(pw[ks], vf, o[d0], 0, 0, 0); } \
        } while (0)
#define ATT_STEP(PC0, PC1, PP0, PP1, j_) do { const int jj = (j_); \
            if (jj + 1 < NT) asm volatile("s_waitcnt vmcnt(3)" ::: "memory"); else if (jj + 1 == NT) asm volatile("s_waitcnt vmcnt(2)" ::: "memory"); else asm volatile("s_waitcnt vmcnt(0)" ::: "memory"); \
            __syncthreads(); \
            if (jj + 2 < NT) { const size_t go_ = (size_t)(jj + 2) * 4096; pg8::glds_s(ksrc + go_, koff, shm0 + (unsigned)(s2 * KBYTES) + (unsigned)wid * 1024u); } \
            if (jj + 1 < NT) { const size_t go_ = (size_t)(jj + 1) * 8192; const unsigned vd_ = shm0 + (unsigned)(VOFF0 + s1 * VBYTES); \
                pg8::glds_s(vsrc + go_, voff, vd_ + (unsigned)wid * 1024u); pg8::glds_s(vsrc + go_ + 4096, voff, vd_ + (unsigned)(wid + 8) * 1024u); } \
            if (jj <= cw) ATT_QK(PC0, PC1, s0 * KBYTES); \
            if (jj >= 1 && jj - 1 <= cw) { ATT_FIN(PP0, PP1); ATT_PV(VOFF0 + s2 * VBYTES); } \
            if (jj <= cw) ATT_PART(PC0, PC1, jj); \
            { const int t_ = s0; s0 = s1; s1 = s2; s2 = t_; } \
        } while (0)
        {
            asm volatile("s_waitcnt vmcnt(0)" ::: "memory");
            pg8::glds_s(ksrc, koff, shm0 + (unsigned)wid * 1024u);
            pg8::glds_s(ksrc + (size_t)4096, koff, shm0 + (unsigned)KBYTES + (unsigned)wid * 1024u);
            pg8::glds_s(vsrc, voff, shm0 + (unsigned)VOFF0 + (unsigned)wid * 1024u); pg8::glds_s(vsrc + 4096, voff, shm0 + (unsigned)VOFF0 + (unsigned)(wid + 8) * 1024u);
        }
        int s0 = 0, s1 = 1, s2 = 2;
        f32x16 pA0, pA1, pB0, pB1;
#pragma unroll
        for (int r = 0; r < 16; ++r) { pA0[r] = 0.f; pA1[r] = 0.f; pB0[r] = 0.f; pB1[r] = 0.f; }
        for (int j = 0; j <= NT; j += 2) {
            ATT_STEP(pA0, pA1, pB0, pB1, j);
            if (j + 1 <= NT) ATT_STEP(pB0, pB1, pA0, pA1, j + 1);
        }
        __syncthreads();
#undef ATT_QK
#undef ATT_FIN
#undef ATT_PART
#undef ATT_PV
#undef ATT_STEP
#undef ATT_DMA
        const float lt = swapsum(l);
        ATT_LWAIT();
        if (hi == 0) wsf[32 + r32] = 1.0f / lt;
        ATT_LWAIT();
        float rli[16];
#pragma unroll
        for (int r = 0; r < 16; ++r) rli[r] = wsf[32 + crow(r, hi)];
        ATT_LWAIT();
        int lane2 = lane; asm volatile("" : "+v"(lane2));
        float* sp = (float*)((char*)myscr + (unsigned)lane2 * 16u);
        if (m == 0) {
#pragma unroll
            for (int d0 = 0; d0 < 4; ++d0) {
#pragma unroll
                for (int r4 = 0; r4 < 4; ++r4) { f32x4 v;
#pragma unroll
                    for (int i = 0; i < 4; ++i) v[i] = o[d0][4 * r4 + i] * rli[4 * r4 + i];
                    *(f32x4*)(sp + (d0 * 4 + r4) * 256) = v; }
                asm volatile("" ::: "memory"); }
        } else {
            float ss[16];
#pragma unroll
            for (int r = 0; r < 16; ++r) ss[r] = 0.f;
#pragma unroll
            for (int d0 = 0; d0 < 4; ++d0) {
#pragma unroll
                for (int r4 = 0; r4 < 4; ++r4) { const f32x4 v0 = *(const f32x4*)(sp + (d0 * 4 + r4) * 256);
#pragma unroll
                    for (int i = 0; i < 4; ++i) { const int r = 4 * r4 + i; const float v = v0[i] - lam * (o[d0][r] * rli[r]); o[d0][r] = v; ss[r] += v * v; } }
                asm volatile("" ::: "memory"); }
#pragma unroll
            for (int r = 0; r < 16; ++r) {
#pragma unroll
                for (int k = 1; k < 32; k <<= 1) ss[r] += __shfl_xor(ss[r], k);
                ss[r] = __builtin_amdgcn_rsqf(ss[r] * (1.0f / 128.0f) + 1e-5f) * outscale;
            }
            ALAS unsigned char* stw = shm + STG_OFF + wid * 8192;
            ALAS unsigned short* stg = (ALAS unsigned short*)stw + (4 * hi) * 128 + r32;
#pragma unroll
            for (int d0 = 0; d0 < 4; ++d0) { const float gg = subg[32 * d0 + (lane2 & 31)];
#pragma unroll
                for (int r = 0; r < 16; ++r) stg[((r & 3) + 8 * (r >> 2)) * 128 + 32 * d0] = (unsigned short)f2bf(o[d0][r] * ss[r] * gg); }
            ATT_LWAIT();
            bf16_t* Ow = (bf16_t*)((char*)(O + (rowbase + q0 + wid * 32) * PITCH + h * 128) + ((unsigned)(lane2 >> 4) * (PITCH * 2) + (unsigned)(lane2 & 15) * 16u));
#pragma unroll
            for (int i = 0; i < 8; ++i) { const u32x4 v = *(const ALAS u32x4*)(stw + i * 1024 + lane2 * 16); *(u32x4*)(Ow + (size_t)i * 4 * PITCH) = v; }
            ATT_LWAIT();
        }
    }
}
}

#ifndef PHMASK
#define PHMASK 0xFFFF
#endif
constexpr int NWAVES = 8;
constexpr int M = 32768, D = 1024, FF = 2816, SEQ = 8192;
constexpr float LN_EPS = 1e-5f;
constexpr float ALPHA = 1.4142135623730951f;
constexpr size_t MiB = 1u << 20;
constexpr size_t WS_BAR = 0;
constexpr size_t WS_ST = 1 * MiB;
constexpr size_t WS_TAB = 2 * MiB;
constexpr size_t WS_WQKV = 4 * MiB, WS_WO = 10 * MiB, WS_PW1 = 12 * MiB, WS_PW2 = 16 * MiB, WS_GU0 = 18 * MiB, WS_GU1 = 29 * MiB, WS_DN0 = 40 * MiB, WS_DN1 = 46 * MiB;
constexpr size_t WS_PAR = 52 * MiB;
constexpr int PO_LQ1 = 0, PO_LK1 = 64, PO_LQ2 = 128, PO_LK2 = 192, PO_SUBG = 256, PO_BPW1 = 384, PO_WDW = 2432, PO_BDW = 34176, PO_CLNG = 35200, PO_CLNB = 36224, PO_BPW2 = 37248, PO_LNG = 38272, PO_LNB = 42368, PO_END = 46464;
constexpr size_t WS_XN = 64 * MiB;
constexpr size_t WS_Q = 128 * MiB, WS_K = 192 * MiB, WS_V = 256 * MiB;
constexpr size_t WS_H = 128 * MiB;
constexpr size_t WS_G = 128 * MiB, WS_C = 192 * MiB;
constexpr size_t WS_Z = 320 * MiB;
constexpr size_t WS_END = 448 * MiB;
constexpr int LDS_BYTES = 147456;

#define LAS __attribute__((address_space(3)))
typedef unsigned short bf16;
typedef unsigned v4u __attribute__((ext_vector_type(4)));
typedef unsigned v2u __attribute__((ext_vector_type(2)));
typedef float f32x4 __attribute__((ext_vector_type(4)));
#define LDS_WAIT() asm volatile("s_waitcnt lgkmcnt(0)" ::: "memory")
__device__ __forceinline__ unsigned f2bf(float f) { unsigned u = __builtin_bit_cast(unsigned, f); return (u + 0x7fffu + ((u >> 16) & 1u)) >> 16; }
__device__ __forceinline__ unsigned pk2(float lo, float hi) { return f2bf(lo) | (f2bf(hi) << 16); }
__device__ __forceinline__ float wave_sum(float v) {
#pragma unroll
    for (int o = 1; o < 64; o <<= 1) v += __shfl_xor(v, o);
    return v;
}
__device__ __forceinline__ int map_row(int mode, int n) {
    if (mode == 1) {
        if (n >= 2048) return n;
        const int region = n >> 10, within = n & 1023, slice = within >> 6, d = within & 63;
        return 256 * (region * 4 + (slice >> 2)) + 128 * (d >> 5) + 32 * (slice & 3) + (d & 31);
    }
    if (mode == 2) { const int half = n >> 10, j = n & 1023; return 256 * (j >> 7) + 128 * half + (j & 127); }
    if (mode == 3) return 256 * (n >> 7) + (n & 127);
    if (mode == 4) return 256 * (n >> 7) + 128 + (n & 127);
    return n;
}
__device__ __forceinline__ void transpose_item(const float* W, int K, int N, bf16* WT, int mode, LAS float* scr, int item, int lane) {
    const int nblk = N / 64, kb = item / nblk, nb = item % nblk, k0 = 64 * kb, n0 = 64 * nb;
    const float* src = W + (size_t)(k0 + (lane >> 4)) * N + n0 + 4 * (lane & 15);
    f32x4 v[16];
#pragma unroll
    for (int i = 0; i < 16; ++i) v[i] = *(const f32x4*)(src + (size_t)(4 * i) * N);
    LAS float* sw = scr + (lane >> 4) * 65 + 4 * (lane & 15);
#pragma unroll
    for (int i = 0; i < 16; ++i) { sw[(4 * i) * 65 + 0] = v[i].x; sw[(4 * i) * 65 + 1] = v[i].y; sw[(4 * i) * 65 + 2] = v[i].z; sw[(4 * i) * 65 + 3] = v[i].w; }
    LDS_WAIT(); asm volatile("" ::: "memory");
    const int c = lane & 7;
#pragma unroll
    for (int j = 0; j < 8; ++j) { const int n = (lane >> 3) + 8 * j; const LAS float* s = scr + (8 * c) * 65 + n;
        v4u o; o.x = pk2(s[0 * 65], s[1 * 65]); o.y = pk2(s[2 * 65], s[3 * 65]); o.z = pk2(s[4 * 65], s[5 * 65]); o.w = pk2(s[6 * 65], s[7 * 65]);
        *(v4u*)(WT + (size_t)map_row(mode, n0 + n) * K + k0 + 8 * c) = o; }
    LDS_WAIT(); asm volatile("" ::: "memory");
}

#define XB_TMO      128
#define XB_XCNT(j)  (256  + 64 * (j))
#define XB_XSUB(j)  (1280 + 64 * (j))
#define XB_XGEN(j)  (2304 + 64 * (j))
#define XB_TOP      3328
#define XB_TOPGEN   3392
#define XCD_BAR_WORDS 3456
#define XB_SPIN_CAP (1u << 18)

__device__ __forceinline__ unsigned xb_ld(unsigned* p)              { return __hip_atomic_load(p, __ATOMIC_RELAXED, __HIP_MEMORY_SCOPE_AGENT); }
__device__ __forceinline__ unsigned xb_add(unsigned* p, unsigned v) { return __hip_atomic_fetch_add(p, v, __ATOMIC_RELAXED, __HIP_MEMORY_SCOPE_AGENT); }
__device__ __forceinline__ unsigned xb_xcc_id() { return (unsigned)__builtin_amdgcn_s_getreg((3 << 11) | 20) & 0xFu; }
#define XB_SPIN(cond, bar) do { unsigned _sp = 0; while (cond) { __builtin_amdgcn_s_sleep(1); \
    if ((++_sp & 255u) == 0u) { if (xb_ld(&(bar)[XB_TMO])) break; if (_sp > XB_SPIN_CAP) { atomicAdd(&(bar)[XB_TMO], 1u); break; } } } } while (0)

struct XcdBarrier {
    unsigned* bar; unsigned x;
    volatile LAS unsigned* st;
};

__device__ __forceinline__ XcdBarrier xcd_barrier_post(unsigned* bar, volatile LAS unsigned* st) {
    XcdBarrier b; b.bar = bar; b.x = xb_xcc_id(); b.st = st;
    if (threadIdx.x == 0) (void)xb_add(&bar[XB_XCNT(b.x)], 1u);
    return b;
}
__device__ __forceinline__ void xcd_barrier_complete(unsigned* bar, unsigned x, unsigned& nloc, unsigned& nx) {
    const unsigned G = gridDim.x * gridDim.y * gridDim.z;
    unsigned sum, cnt, mine, sp = 0u;
    for (;;) {
        sum = 0u; cnt = 0u; mine = 0u;
#pragma unroll
        for (unsigned j = 0; j < 16; ++j) { const unsigned c = xb_ld(&bar[XB_XCNT(j)]); sum += c; cnt += (c > 0u) ? 1u : 0u; mine = (j == x) ? c : mine; }
        if (sum == G) break;
        __builtin_amdgcn_s_sleep(1);
        if ((++sp & 255u) == 0u) { if (xb_ld(&bar[XB_TMO])) break; if (sp > XB_SPIN_CAP) { atomicAdd(&bar[XB_TMO], 1u); break; } }
    }
    nloc = mine > 0u ? mine : 1u; nx = cnt > 0u ? cnt : 1u;
}

__device__ __forceinline__ void xcd_barrier(const XcdBarrier& b) {
    asm volatile("s_waitcnt vmcnt(0)" ::: "memory");
    __syncthreads();
    if (threadIdx.x == 0) {
        unsigned* bar = b.bar;
        __builtin_amdgcn_s_waitcnt(0);
        unsigned nloc = b.st[0], nx = b.st[1];
        if (nloc == 0u) { xcd_barrier_complete(bar, b.x, nloc, nx); b.st[0] = nloc; b.st[1] = nx; }
        const unsigned old = xb_add(&bar[XB_XSUB(b.x)], 1u);
        const unsigned gen = old / nloc;
        if (old + 1u == (gen + 1u) * nloc) {
            __builtin_amdgcn_fence(__ATOMIC_RELEASE, "agent");
            asm volatile("s_waitcnt vmcnt(0)" ::: "memory");
            const unsigned og = xb_add(&bar[XB_TOP], 1u);
            const unsigned tg = og / nx;
            if (og + 1u == (tg + 1u) * nx) xb_add(&bar[XB_TOPGEN], 1u);
            else XB_SPIN(xb_ld(&bar[XB_TOPGEN]) == tg, bar);
            __builtin_amdgcn_fence(__ATOMIC_ACQUIRE, "agent");
            xb_add(&bar[XB_XGEN(b.x)], 1u);
            asm volatile("s_waitcnt vmcnt(0)" ::: "memory");
        } else {
            XB_SPIN(xb_ld(&bar[XB_XGEN(b.x)]) == gen, bar);
            __builtin_amdgcn_fence(__ATOMIC_ACQUIRE, "agent");
            asm volatile("s_waitcnt vmcnt(0)" ::: "memory");
        }
    }
    __syncthreads();
}

struct Args { const float* in[21]; float* out; unsigned char* ws; };

__device__ __forceinline__ void ln_phase(const float* Z, bf16* XN, float* ST, const float* g, const float* b, float* OUT, int gw, int NGW, int lane) {
    asm volatile("" : "+v"(lane));
    f32x4 gv[4], bv[4];
#pragma unroll
    for (int j = 0; j < 4; ++j) { gv[j] = *((const f32x4*)g + lane + 64 * j); bv[j] = *((const f32x4*)b + lane + 64 * j); }
    for (int row0 = gw; row0 < M; row0 += 2 * NGW) {
        f32x4 v[2][4]; float mean[2], rstd[2];
#pragma unroll
        for (int q = 0; q < 2; ++q) { const f32x4* zr = (const f32x4*)(Z + (size_t)(row0 + q * NGW) * D) + lane;
#pragma unroll
            for (int j = 0; j < 4; ++j) v[q][j] = zr[64 * j]; }
#pragma unroll
        for (int q = 0; q < 2; ++q) { float s = 0.f;
#pragma unroll
            for (int j = 0; j < 4; ++j) s += (v[q][j].x + v[q][j].y) + (v[q][j].z + v[q][j].w);
            mean[q] = wave_sum(s) * (1.f / D); float s2 = 0.f;
#pragma unroll
            for (int j = 0; j < 4; ++j) { v[q][j] = v[q][j] - mean[q]; s2 += (v[q][j].x * v[q][j].x + v[q][j].y * v[q][j].y) + (v[q][j].z * v[q][j].z + v[q][j].w * v[q][j].w); }
            rstd[q] = 1.f / sqrtf(wave_sum(s2) * (1.f / D) + LN_EPS); }
#pragma unroll
        for (int q = 0; q < 2; ++q) { const int row = row0 + q * NGW;
            if (OUT) {
                f32x4* orow = (f32x4*)(OUT + (size_t)row * D) + lane;
#pragma unroll
                for (int j = 0; j < 4; ++j) orow[64 * j] = v[q][j] * rstd[q] * gv[j] + bv[j];
            } else {
                if (lane == 0) { ST[2 * row] = mean[q]; ST[2 * row + 1] = rstd[q]; }
                v2u* o8 = (v2u*)(XN + (size_t)row * D) + lane;
#pragma unroll
                for (int j = 0; j < 4; ++j) { const f32x4 y = v[q][j] * rstd[q] * gv[j] + bv[j]; v2u w; w.x = pk2(y.x, y.y); w.y = pk2(y.z, y.w); o8[64 * j] = w; }
            } }
    }
}

__global__ void __launch_bounds__(NWAVES * 64, 2) fwd_kernel(Args args) {
    extern __shared__ __attribute__((aligned(16))) unsigned char lds[];
    cg::grid_group grid = cg::this_grid();
    LAS unsigned char* L = (LAS unsigned char*)lds;
    const int tid = threadIdx.x, lane = tid & 63, wave = __builtin_amdgcn_readfirstlane(tid >> 6);
    const int G = gridDim.x, bx = blockIdx.x;
    const int vcu = (G % 8 == 0) ? (bx % 8) * (G / 8) + bx / 8 : bx;
    const int gw = vcu * NWAVES + wave, NGW = G * NWAVES;
    unsigned char* ws = args.ws;
    const float* x = args.in[0];
    const float *w_qkv = args.in[1], *w_o = args.in[2], *w_pw1 = args.in[8], *w_pw2 = args.in[14], *w_gate = args.in[16], *w_up = args.in[17], *w_down = args.in[18];
    float* PARW = (float*)(ws + WS_PAR); const float* PAR = PARW;
    const float *lq1 = PAR + PO_LQ1, *lk1 = PAR + PO_LK1, *lq2 = PAR + PO_LQ2, *lk2 = PAR + PO_LK2, *subln_g = PAR + PO_SUBG, *b_pw1 = PAR + PO_BPW1, *w_dw = PAR + PO_WDW, *b_dw = PAR + PO_BDW;
    const float *cln_g = PAR + PO_CLNG, *cln_b = PAR + PO_CLNB, *b_pw2 = PAR + PO_BPW2, *ln_g = PAR + PO_LNG, *ln_b = PAR + PO_LNB;
    float* ST = (float*)(ws + WS_ST); float* TAB = (float*)(ws + WS_TAB);
    bf16 *Wqkv_t = (bf16*)(ws + WS_WQKV), *Wo_t = (bf16*)(ws + WS_WO), *Wpw1_t = (bf16*)(ws + WS_PW1), *Wpw2_t = (bf16*)(ws + WS_PW2);
    bf16 *Wgu0 = (bf16*)(ws + WS_GU0), *Wgu1 = (bf16*)(ws + WS_GU1), *Wdn0 = (bf16*)(ws + WS_DN0), *Wdn1 = (bf16*)(ws + WS_DN1);
    bf16 *XN = (bf16*)(ws + WS_XN), *QB = (bf16*)(ws + WS_Q), *KB = (bf16*)(ws + WS_K), *VB = (bf16*)(ws + WS_V), *HB = (bf16*)(ws + WS_H), *GB = (bf16*)(ws + WS_G), *CB = (bf16*)(ws + WS_C);
    float* Z = (float*)(ws + WS_Z);

    volatile LAS unsigned* xbst = (volatile LAS unsigned*)(L + LDS_BYTES - 64);
    if (tid < 2) xbst[tid] = 0u;
    if (bx == 0) for (int u = tid; u < XCD_BAR_WORDS; u += NWAVES * 64) __hip_atomic_store((unsigned*)(ws + WS_BAR) + u, 0u, __ATOMIC_RELAXED, __HIP_MEMORY_SCOPE_AGENT);
    __syncthreads();
    {
        LAS float* scr = (LAS float*)(L + wave * 16640);
        constexpr int I_QKV = 16 * 48, I_O = 16 * 16, I_PW1 = 16 * 32, I_PW2 = 16 * 16, I_GU = 16 * 44, I_DN = 44 * 16;
        constexpr int NITEMS = I_QKV + I_O + I_PW1 + I_PW2 + 4 * I_GU + 2 * I_DN;
        for (int it = gw; it < NITEMS; it += NGW) {
            int r = it;
            if (r < I_QKV) { transpose_item(w_qkv, D, 3 * D, Wqkv_t, 1, scr, r, lane); continue; } r -= I_QKV;
            if (r < I_O) { transpose_item(w_o, D, D, Wo_t, 0, scr, r, lane); continue; } r -= I_O;
            if (r < I_PW1) { transpose_item(w_pw1, D, 2 * D, Wpw1_t, 2, scr, r, lane); continue; } r -= I_PW1;
            if (r < I_PW2) { transpose_item(w_pw2, D, D, Wpw2_t, 0, scr, r, lane); continue; } r -= I_PW2;
            if (r < I_GU) { transpose_item(w_gate, D, FF, Wgu0, 3, scr, r, lane); continue; } r -= I_GU;
            if (r < I_GU) { transpose_item(w_up, D, FF, Wgu0, 4, scr, r, lane); continue; } r -= I_GU;
            if (r < I_GU) { transpose_item(w_gate + (size_t)D * FF, D, FF, Wgu1, 3, scr, r, lane); continue; } r -= I_GU;
            if (r < I_GU) { transpose_item(w_up + (size_t)D * FF, D, FF, Wgu1, 4, scr, r, lane); continue; } r -= I_GU;
            if (r < I_DN) { transpose_item(w_down, FF, D, Wdn0, 0, scr, r, lane); continue; } r -= I_DN;
            transpose_item(w_down + (size_t)FF * D, FF, D, Wdn1, 0, scr, r, lane);
        }
        for (int row = gw; row < M; row += 4 * NGW) {
            f32x4 y[4][4];
#pragma unroll
            for (int q = 0; q < 4; ++q) { const f32x4* xr = (const f32x4*)(x + (size_t)(row + q * NGW) * D) + 2 * lane;
                y[q][0] = xr[0]; y[q][1] = xr[1]; y[q][2] = xr[128]; y[q][3] = xr[129]; }
#pragma unroll
            for (int q = 0; q < 4; ++q) { v4u* o16 = (v4u*)(XN + (size_t)(row + q * NGW) * D) + lane;
                v4u w0, w1; w0.x = pk2(y[q][0].x, y[q][0].y); w0.y = pk2(y[q][0].z, y[q][0].w); w0.z = pk2(y[q][1].x, y[q][1].y); w0.w = pk2(y[q][1].z, y[q][1].w);
                w1.x = pk2(y[q][2].x, y[q][2].y); w1.y = pk2(y[q][2].z, y[q][2].w); w1.z = pk2(y[q][3].x, y[q][3].y); w1.w = pk2(y[q][3].z, y[q][3].w);
                o16[0] = w0; o16[64] = w1; }
        }
        for (int e = bx * (NWAVES * 64) + tid; e < PO_END; e += G * NWAVES * 64) {
            float v;
            if (e < PO_LK1) v = args.in[3][e - PO_LQ1]; else if (e < PO_LQ2) v = args.in[4][e - PO_LK1]; else if (e < PO_LK2) v = args.in[5][e - PO_LQ2]; else if (e < PO_SUBG) v = args.in[6][e - PO_LK2];
            else if (e < PO_BPW1) v = args.in[7][e - PO_SUBG]; else if (e < PO_WDW) v = args.in[9][e - PO_BPW1]; else if (e < PO_BDW) v = args.in[10][e - PO_WDW]; else if (e < PO_CLNG) v = args.in[11][e - PO_BDW];
            else if (e < PO_CLNB) v = args.in[12][e - PO_CLNG]; else if (e < PO_BPW2) v = args.in[13][e - PO_CLNB]; else if (e < PO_LNG) v = args.in[15][e - PO_BPW2]; else if (e < PO_LNB) v = args.in[19][e - PO_LNG];
            else v = args.in[20][e - PO_LNB];
            PARW[e] = v;
        }
        for (int e = bx * (NWAVES * 64) + tid; e < SEQ * 32; e += G * NWAVES * 64) {
            const int pos = e >> 5, i = e & 31, i8 = i & 7, i3 = i >> 3;
            double c = (i8 == 0) ? 1.0 : (i8 == 1) ? 0.7498942093324559 : (i8 == 2) ? 0.5623413251903491 : (i8 == 3) ? 0.4216965034285822 : (i8 == 4) ? 0.31622776601683794 : (i8 == 5) ? 0.23713737056616552 : (i8 == 6) ? 0.1778279410038923 : 0.1333521432163324;
            c *= (i3 == 0) ? 1.0 : (i3 == 1) ? 0.1 : (i3 == 2) ? 0.01 : 0.001;
            const double rev = (double)pos * c * 0.15915494309189535;
            const float fr = (float)(rev - __builtin_floor(rev));
            TAB[pos * 64 + i] = __builtin_amdgcn_cosf(fr); TAB[pos * 64 + 32 + i] = __builtin_amdgcn_sinf(fr);
        }
    }
    grid.sync();
    const XcdBarrier xbar = xcd_barrier_post((unsigned*)(ws + WS_BAR), xbst);

    if (PHMASK & (1 << 1)) {
        pg8::Gemm g{XN, Wqkv_t, M, 3 * D, D}; pg8::StaticOrder S; S.init(M, 3 * D, G, bx);
        pg8::EpiQKV E{QB, KB, VB, TAB, 0.125f * 1.4426950408889634f};
        pg8::gemm_phase<pg8::EpiQKV, pg8::StaticOrder, true, true>(L, g, S, E);
    }
    xcd_barrier(xbar);

    if (PHMASK & (1 << 2)) {
        const float d1 = wave_sum(lq1[lane] * lk1[lane]), d2 = wave_sum(lq2[lane] * lk2[lane]);
        const float lam = __expf(d1) - __expf(d2) + 0.2f;
        for (int idx = vcu; idx < 1024; idx += G) {
            const int v = idx & 255, i = idx >> 8, bh = v >> 3, s = v & 7;
            const int qb = (i == 0) ? 31 - s : (i == 1) ? 16 + s : (i == 2) ? 15 - s : s;
            att::attn_unit(bh >> 3, bh & 7, qb, QB, KB, VB, XN, Z, L, lam, 0.8f, subln_g);
        }
    }
    xcd_barrier(xbar);

    if (PHMASK & (1 << 3)) {
        pg8::Gemm g{XN, Wo_t, M, D, D}; pg8::StaticOrder S; S.init(M, D, G, bx);
        pg8::EpiResid<0> E{x, Z, nullptr, nullptr, nullptr, nullptr, ALPHA};
        pg8::gemm_phase<pg8::EpiResid<0>, pg8::StaticOrder, true, true>(L, g, S, E);
    }
    xcd_barrier(xbar);
    ln_phase(Z, XN, ST, ln_g, ln_b, nullptr, gw, NGW, lane);
    xcd_barrier(xbar);

    for (int layer = 0; layer < 2; ++layer) {
        if (layer == 1) {
            if (PHMASK & (1 << 8)) {
                pg8::Gemm g{XN, Wpw1_t, M, 2 * D, D}; pg8::StaticOrder S; S.init(M, 2 * D, G, bx);
                pg8::EpiGLU E{GB, b_pw1};
                pg8::gemm_phase<pg8::EpiGLU, pg8::StaticOrder, true, true>(L, g, S, E);
            }
            xcd_barrier(xbar);
            if (PHMASK & (1 << 9)) {
                int ctid = threadIdx.x; asm volatile("" : "+v"(ctid));
                const int clane = ctid & 63, cwave = __builtin_amdgcn_readfirstlane(ctid >> 6);
                LAS unsigned* tile = (LAS unsigned*)L;
                LAS float* red = (LAS float*)(L + 126976);
                LAS float* stat = red + 512;
                const unsigned L0 = (unsigned)(uintptr_t)L;
                for (int unit = vcu; unit < M / 32; unit += G) {
                    const int row0 = unit * 32, s0 = row0 & (SEQ - 1);
                    int c2 = ctid; asm volatile("" : "+v"(c2));
                    float w0[31], w1[31];
#pragma unroll
                    for (int t = 0; t < 31; ++t) { const float2 wv = *(const float2*)(w_dw + t * D + 2 * c2); w0[t] = wv.x; w1[t] = wv.y; }
                    const float bd0 = b_dw[2 * c2], bd1 = b_dw[2 * c2 + 1];
                    for (int p = cwave; p < 124; p += NWAVES) { const int rr = p >> 1;
                        if (s0 == 0 && rr < 30) *(LAS v4u*)(L + p * 1024 + clane * 16) = (v4u){0u, 0u, 0u, 0u};
                        else pg8::glds_s(GB + (size_t)(row0 - 30 + rr) * D + (p & 1) * 512, (unsigned)clane * 16u, L0 + (unsigned)p * 1024u); }
                    asm volatile("s_waitcnt vmcnt(0)" ::: "memory");
                    __syncthreads();
                    float y0[32], y1[32];
#pragma unroll
                    for (int r = 0; r < 32; ++r) { y0[r] = bd0; y1[r] = bd1; }
#pragma unroll
                    for (int k = 0; k < 62; ++k) { const unsigned xk = tile[k * 512 + c2]; const float a0 = __uint_as_float(xk << 16), a1 = __uint_as_float(xk & 0xffff0000u);
#pragma unroll
                        for (int r = 0; r < 32; ++r) { const int t = k - r; if (t >= 0 && t <= 30) { y0[r] += w0[t] * a0; y1[r] += w1[t] * a1; } } }
                    float vals[64];
#pragma unroll
                    for (int r = 0; r < 32; ++r) { vals[2 * r] = y0[r] + y1[r]; vals[2 * r + 1] = y0[r] * y0[r] + y1[r] * y1[r]; }
#define CONV_BFLY(MK) do { const bool up = (clane & (MK)) != 0; _Pragma("unroll") for (int k = 0; k < (MK); ++k) { const float a = vals[k], b = vals[k + (MK)]; const float snd = up ? a : b, kp = up ? b : a; vals[k] = kp + __shfl_xor(snd, (MK)); } } while (0)
                    CONV_BFLY(32); CONV_BFLY(16); CONV_BFLY(8); CONV_BFLY(4); CONV_BFLY(2); CONV_BFLY(1);
#undef CONV_BFLY
                    red[cwave * 64 + clane] = vals[0];
                    __syncthreads();
                    if (ctid < 32) { float sm = 0.f, q = 0.f;
#pragma unroll
                        for (int w = 0; w < 8; ++w) { sm += red[w * 64 + 2 * ctid]; q += red[w * 64 + 2 * ctid + 1]; }
                        const float mean = sm * (1.f / D), var = q * (1.f / D) - mean * mean;
                        stat[2 * ctid] = mean; stat[2 * ctid + 1] = 1.f / sqrtf(fmaxf(var, 0.f) + LN_EPS); }
                    __syncthreads();
                    int c3 = ctid; asm volatile("" : "+v"(c3));
                    const float g0 = cln_g[2 * c3], g1 = cln_g[2 * c3 + 1], bb0 = cln_b[2 * c3], bb1 = cln_b[2 * c3 + 1];
                    unsigned* op = (unsigned*)(CB + (size_t)row0 * D) + c3;
#pragma unroll
                    for (int r = 0; r < 32; ++r) {
                        const float mean = stat[2 * r], rstd = stat[2 * r + 1];
                        float n0 = (y0[r] - mean) * rstd * g0 + bb0, n1 = (y1[r] - mean) * rstd * g1 + bb1;
                        n0 = n0 * __builtin_amdgcn_rcpf(1.0f + __builtin_amdgcn_exp2f(n0 * -1.4426950408889634f));
                        n1 = n1 * __builtin_amdgcn_rcpf(1.0f + __builtin_amdgcn_exp2f(n1 * -1.4426950408889634f));
                        op[r * 512] = pk2(n0, n1);
                    }
                }
                __syncthreads();
            }
            xcd_barrier(xbar);
            if (PHMASK & (1 << 10)) {
                pg8::Gemm g{CB, Wpw2_t, M, D, D}; pg8::StaticOrder S; S.init(M, D, G, bx);
                pg8::EpiResid<1> E{Z, Z, ST, ln_g + 1 * D, ln_b + 1 * D, b_pw2, ALPHA};
                pg8::gemm_phase<pg8::EpiResid<1>, pg8::StaticOrder, true, true>(L, g, S, E);
            }
            xcd_barrier(xbar);
            ln_phase(Z, XN, ST, ln_g + 2 * D, ln_b + 2 * D, nullptr, gw, NGW, lane);
            xcd_barrier(xbar);
        }
        if (PHMASK & (1 << 5)) {
            pg8::Gemm g{XN, layer ? Wgu1 : Wgu0, M, 2 * FF, D}; pg8::StaticOrder S; S.init(M, 2 * FF, G, bx);
            pg8::EpiSwiGLU E{HB, FF};
            pg8::gemm_phase<pg8::EpiSwiGLU, pg8::StaticOrder, true, true>(L, g, S, E);
        }
        xcd_barrier(xbar);
        if (PHMASK & (1 << 6)) {
            pg8::Gemm g{HB, layer ? Wdn1 : Wdn0, M, D, FF}; pg8::StaticOrder S; S.init(M, D, G, bx);
            pg8::EpiResid<1> E{Z, Z, ST, ln_g + (2 * layer) * D, ln_b + (2 * layer) * D, nullptr, ALPHA};
            pg8::gemm_phase<pg8::EpiResid<1>, pg8::StaticOrder, true, true>(L, g, S, E);
        }
        xcd_barrier(xbar);
        if (layer == 0) { ln_phase(Z, XN, ST, ln_g + 1 * D, ln_b + 1 * D, nullptr, gw, NGW, lane); xcd_barrier(xbar); }
        else ln_phase(Z, nullptr, ST, ln_g + 3 * D, ln_b + 3 * D, args.out, gw, NGW, lane);
    }
}

extern "C" void kernel_launch(void* const* d_in, const int* in_sizes, int n_in, void* d_out, int out_size, void* d_ws, size_t ws_size, hipStream_t stream) {
    static int grid = 0;
    if (grid == 0) {
        if (n_in != 21 || out_size != M * D || ws_size < WS_END) { fprintf(stderr, "kernel_launch: unexpected shapes (n_in %d out %d ws %zu)\n", n_in, out_size, ws_size); grid = -1; return; }
        int dev = 0, cus = 0, per_cu = 0;
        hipGetDevice(&dev); hipDeviceGetAttribute(&cus, hipDeviceAttributeMultiprocessorCount, dev);
        if (hipFuncSetAttribute((const void*)fwd_kernel, hipFuncAttributeMaxDynamicSharedMemorySize, LDS_BYTES) != hipSuccess) { fprintf(stderr, "kernel_launch: hipFuncSetAttribute failed\n"); grid = -1; return; }
        hipOccupancyMaxActiveBlocksPerMultiprocessor(&per_cu, (const void*)fwd_kernel, NWAVES * 64, LDS_BYTES);
        (void)hipGetLastError();
        grid = cus * (per_cu > 0 ? 1 : 1);
        if (grid > 256) grid = 256;
        grid &= ~7;
        fprintf(stderr, "kernel_launch: cus %d per_cu %d grid %d\n", cus, per_cu, grid);
    }
    if (grid <= 0) return;
    Args a{};
    for (int i = 0; i < 21; ++i) a.in[i] = (const float*)d_in[i];
    a.out = (float*)d_out; a.ws = (unsigned char*)d_ws;
    void* kargs[] = {&a};
    hipError_t e = hipLaunchCooperativeKernel((const void*)fwd_kernel, dim3(grid), dim3(NWAVES * 64), kargs, LDS_BYTES, stream);
    if (e != hipSuccess) fprintf(stderr, "kernel_launch: cooperative launch failed: %s (grid %d)\n", hipGetErrorString(e), grid);
}
```
